# Optimizing an MI355X kernel written in HIP

```python
import jax, jax.numpy as jnp
from jax import lax
import numpy as np

D_MODEL = 2048
BATCH = 1
SEQ = 8192
DEPTH = 4

GRID_W = 64
CTX_LEN = 256
RMS_EPS = 1e-6
N_BRANCH = 3
BRANCH_WIDTH = D_MODEL // 2

A_HEAD_DIM = 64
A_HEADS = BRANCH_WIDTH // A_HEAD_DIM
A_WIDTH = A_HEADS * A_HEAD_DIM
LORA_W = 96
LORA_A = 96
LORA_G = 256
GN_EPS = 64e-5
RWKV_COLS = 3 * A_WIDTH + 2 * LORA_W + 2 * LORA_A + LORA_G

QK_NOPE = 128
QK_ROPE = 64
V_DIM = 128
B_HEADS = BRANCH_WIDTH // V_DIM
Q_LORA = 448
KV_LORA = 128
MLA_COLS = Q_LORA + KV_LORA + QK_ROPE
MLA_SCALE = (QK_NOPE + QK_ROPE) ** -0.5
ROPE_BASE = 10000.0

C_HEAD_DIM = 64
C_HEADS = BRANCH_WIDTH // C_HEAD_DIM
C_WIDTH = C_HEADS * C_HEAD_DIM
WIN_ROWS = 8
WIN_COLS = 16
NA_COLS = 3 * C_WIDTH
NA_SCALE = C_HEAD_DIM ** -0.5

GATE_COLS = N_BRANCH * D_MODEL
IN_COLS = RWKV_COLS + MLA_COLS + NA_COLS + GATE_COLS
D_FF = 4 * D_MODEL
Q_BLOCK = 128

kernel_name = "hybrid_rwkv7_mla_natten_dit"


def split_cols(u, sizes):
    out, start = [], 0
    for s in sizes:
        out.append(u[..., start:start + s])
        start += s
    return out


def rms_norm(x, g):
    xf = x.astype(jnp.float32)
    y = xf * lax.rsqrt(jnp.mean(xf * xf, axis=-1, keepdims=True) + RMS_EPS)
    return (y * g.astype(jnp.float32)).astype(x.dtype)


def modulate(h, shift, scale):
    return h * (1.0 + scale) + shift


def sq_relu_mlp(h, w1, w2):
    return jnp.square(jax.nn.relu(h @ w1)) @ w2


def axial_angles(seq):
    t = jnp.arange(seq)
    row = (t // GRID_W).astype(jnp.float32)
    col = (t % GRID_W).astype(jnp.float32)
    n_freq = QK_ROPE // 4
    inv = ROPE_BASE ** (-jnp.arange(n_freq, dtype=jnp.float32) / n_freq)
    return row[:, None] * inv[None, :], col[:, None] * inv[None, :]


def rotate_half(x, ang):
    n = x.shape[-1] // 2
    cos, sin = jnp.cos(ang).astype(x.dtype), jnp.sin(ang).astype(x.dtype)
    x1, x2 = x[..., :n], x[..., n:]
    return jnp.concatenate([x1 * cos - x2 * sin, x1 * sin + x2 * cos], axis=-1)


def rope_2d(x, ang_row, ang_col):
    h = QK_ROPE // 2
    return jnp.concatenate([rotate_half(x[..., :h], ang_row), rotate_half(x[..., h:], ang_col)], axis=-1)


def blocked_attention(q, k, v, scale):
    B, Tq, H, dq = q.shape
    nb = Tq // Q_BLOCK
    qb = jnp.moveaxis(q.reshape(B, nb, Q_BLOCK, H, dq), 1, 0)

    def one_block(qi):
        s = jnp.einsum("bqhd,bkhd->bhqk", qi, k).astype(jnp.float32) * scale
        p = jax.nn.softmax(s, axis=-1).astype(v.dtype)
        return jnp.einsum("bhqk,bkhd->bqhd", p, v)

    o = lax.map(one_block, qb)
    return jnp.moveaxis(o, 0, 1).reshape(B, Tq, H * v.shape[-1])


def dw_conv3(u, w):
    up = jnp.pad(u, ((0, 0), (1, 1), (0, 0)))
    return w[0] * up[:, :-2] + w[1] * up[:, 1:-1] + w[2] * up[:, 2:]


def heads_a(t):
    return t.reshape(*t.shape[:-1], A_HEADS, A_HEAD_DIM)


def rwkv_prepare(u, lp):
    B, T, _ = u.shape
    f32 = jnp.float32
    u = dw_conv3(u, lp["rwkv_conv"])
    r, k, v, wd, ad, gd = split_cols(u, (A_WIDTH, A_WIDTH, A_WIDTH, 2 * LORA_W, 2 * LORA_A, LORA_G))
    wd = wd.reshape(B, T, 2, LORA_W)
    ad = ad.reshape(B, T, 2, LORA_A)
    z = (lp["rwkv_w0"] + jnp.einsum("btzl,zlc->btzc", jnp.tanh(wd), lp["rwkv_w_up"])).astype(f32)
    decay = jnp.exp(-jnp.exp(-jax.nn.softplus(-z) - 0.5))
    a = jax.nn.sigmoid((lp["rwkv_a0"] + jnp.einsum("btzl,zlc->btzc", ad, lp["rwkv_a_up"])).astype(f32))
    kf = k.astype(f32)
    kk = heads_a(kf * lp["rwkv_k_k"].astype(f32))
    kk = kk / jnp.maximum(jnp.sqrt(jnp.sum(kk * kk, axis=-1, keepdims=True)), 1e-12)
    k_dir = kf[:, :, None, :] * (1.0 + (a - 1.0) * lp["rwkv_k_a"].astype(f32))
    return {"r": heads_a(r.astype(f32)), "k": heads_a(k_dir), "v": heads_a(v.astype(f32)),
            "kk": kk, "w": heads_a(decay), "a": heads_a(a), "gd": gd}


def rwkv7_scan(s0, p, d, reverse, with_outputs):
    w, k, a = p["w"][:, :, d], p["k"][:, :, d], p["a"][:, :, d]
    kk, v = p["kk"], p["v"]
    xs = (w, k, v, kk, kk * a) + ((p["r"],) if with_outputs else ())
    xs = tuple(jnp.moveaxis(t, 1, 0) for t in xs)

    def step(S, inp):
        w_t, k_t, v_t, kk_t, b_t = inp[:5]
        sa = jnp.einsum("bhvk,bhk->bhv", S, kk_t)
        S = S * w_t[:, :, None, :] - sa[..., None] * b_t[:, :, None, :] + v_t[..., None] * k_t[:, :, None, :]
        y = jnp.einsum("bhvk,bhk->bhv", S, inp[5]) if with_outputs else None
        return S, y

    s_fin, ys = lax.scan(step, s0, xs, reverse=reverse)
    return s_fin, (jnp.moveaxis(ys, 0, 1) if with_outputs else None)


def rwkv_readout(y, p, lp):
    B, T = y.shape[:2]
    mu = jnp.mean(y, axis=-1, keepdims=True)
    var = jnp.mean(jnp.square(y - mu), axis=-1, keepdims=True)
    yn = ((y - mu) * lax.rsqrt(var + GN_EPS)).reshape(B, T, A_WIDTH) * lp["rwkv_ln_g"] + lp["rwkv_ln_b"]
    k_mean = 0.5 * (p["k"][:, :, 0] + p["k"][:, :, 1])
    bonus = (jnp.sum(p["r"] * k_mean * lp["rwkv_r_k"], axis=-1, keepdims=True) * p["v"]).reshape(B, T, A_WIDTH)
    g = jax.nn.sigmoid(p["gd"]) @ lp["rwkv_g_up"]
    return (yn + bonus) * g


def rwkv_mixer(u, u_c, lp, need_ctx_out):
    p, pc = rwkv_prepare(u, lp), rwkv_prepare(u_c, lp)
    s0 = jnp.zeros((u.shape[0], A_HEADS, A_HEAD_DIM, A_HEAD_DIM), jnp.float32)
    ys, ys_c = [], []
    for d, reverse in enumerate((False, True)):
        s_ctx, y_c = rwkv7_scan(s0, pc, d, reverse, need_ctx_out)
        _, y_l = rwkv7_scan(s_ctx, p, d, reverse, True)
        ys.append(y_l)
        ys_c.append(y_c)
    out = rwkv_readout(ys[0] + ys[1], p, lp).astype(u.dtype)
    out_c = rwkv_readout(ys_c[0] + ys_c[1], pc, lp).astype(u.dtype) if need_ctx_out else None
    return out, out_c


def mla_queries(u, lp, ang_row, ang_col, rotate):
    B, T, _ = u.shape
    q = (rms_norm(u[..., :Q_LORA], lp["mla_q_norm_g"]) @ lp["mla_w_uq"]).reshape(B, T, B_HEADS, QK_NOPE + QK_ROPE)
    if rotate:
        q = jnp.concatenate([q[..., :QK_NOPE], rope_2d(q[..., QK_NOPE:], ang_row[:, None], ang_col[:, None])], axis=-1)
    return q


def mla_keys(u, lp, ang_row, ang_col, rotate):
    B, T, _ = u.shape
    _, kvd, kr = split_cols(u, (Q_LORA, KV_LORA, QK_ROPE))
    kv = (rms_norm(kvd, lp["mla_kv_norm_g"]) @ lp["mla_w_ukv"]).reshape(B, T, B_HEADS, QK_NOPE + V_DIM)
    k_pe = rope_2d(kr, ang_row, ang_col) if rotate else kr
    k = jnp.concatenate([kv[..., :QK_NOPE], jnp.broadcast_to(k_pe[:, :, None, :], (B, T, B_HEADS, QK_ROPE))], axis=-1)
    return k, kv[..., QK_NOPE:]


def mla_mixer(u, u_c, lp, ang_row, ang_col, need_ctx_out):
    k_c, v_c = mla_keys(u_c, lp, None, None, False)
    k_l, v_l = mla_keys(u, lp, ang_row, ang_col, True)
    q_l = mla_queries(u, lp, ang_row, ang_col, True)
    k_all = jnp.concatenate([k_c, k_l], axis=1)
    v_all = jnp.concatenate([v_c, v_l], axis=1)
    out = blocked_attention(q_l, k_all, v_all, MLA_SCALE)
    out_c = blocked_attention(mla_queries(u_c, lp, None, None, False), k_c, v_c, MLA_SCALE) if need_ctx_out else None
    return out, out_c


def na_mixer(u, u_c, rpb, need_ctx_out):
    B, T, _ = u.shape
    L = u_c.shape[1]
    rows = T // GRID_W
    wr = min(WIN_ROWS, rows)
    q, k, v = [t.reshape(B, rows, GRID_W, C_HEADS, C_HEAD_DIM) for t in split_cols(u, (C_WIDTH,) * 3)]
    qc, kc, vc = [t.reshape(B, L, C_HEADS, C_HEAD_DIM) for t in split_cols(u_c, (C_WIDTH,) * 3)]
    cols = jnp.arange(GRID_W)
    col_idx = jnp.clip(cols - WIN_COLS // 2, 0, GRID_W - WIN_COLS)[:, None] + jnp.arange(WIN_COLS)
    rpb_cols = rpb[:, :, col_idx - cols[:, None] + WIN_COLS - 1]
    n_win = wr * WIN_COLS

    def one_row(i):
        r0 = jnp.clip(i - wr // 2, 0, rows - wr)
        q_i = lax.dynamic_index_in_dim(q, i, axis=1, keepdims=False)
        k_win = lax.dynamic_slice_in_dim(k, r0, wr, axis=1)[:, :, col_idx]
        v_win = lax.dynamic_slice_in_dim(v, r0, wr, axis=1)[:, :, col_idx]
        bias = jnp.take(rpb_cols, r0 + jnp.arange(wr) - i + WIN_ROWS - 1, axis=1)
        s_win = (jnp.einsum("bqhd,brqchd->bhqrc", q_i, k_win).astype(jnp.float32) * NA_SCALE
                 + jnp.transpose(bias, (0, 2, 1, 3))[None].astype(jnp.float32))
        s_ctx = jnp.einsum("bqhd,bkhd->bhqk", q_i, kc).astype(jnp.float32) * NA_SCALE
        s = jnp.concatenate([s_win.reshape(B, C_HEADS, GRID_W, n_win), s_ctx], axis=-1)
        p = jax.nn.softmax(s, axis=-1).astype(v.dtype)
        p_win = p[..., :n_win].reshape(B, C_HEADS, GRID_W, wr, WIN_COLS)
        return (jnp.einsum("bhqrc,brqchd->bqhd", p_win, v_win)
                + jnp.einsum("bhqk,bkhd->bqhd", p[..., n_win:], vc))

    o = lax.map(one_row, jnp.arange(rows))
    out = jnp.moveaxis(o, 0, 1).reshape(B, T, C_WIDTH)
    out_c = blocked_attention(qc, kc, vc, NA_SCALE) if need_ctx_out else None
    return out, out_c


def merge_branches(ys, ug, w_branch, w_out):
    gates = jax.nn.sigmoid(ug.astype(jnp.float32)).astype(ug.dtype)
    merged = gates[..., :D_MODEL] * (ys[0] @ w_branch[0])
    for i in range(1, N_BRANCH):
        merged = merged + gates[..., i * D_MODEL:(i + 1) * D_MODEL] * (ys[i] @ w_branch[i])
    return merged @ w_out


def token_mixers(h, hc, lp, ang_row, ang_col, need_ctx_out):
    sizes = (RWKV_COLS, MLA_COLS, NA_COLS, GATE_COLS)
    ua, ub, uc, ug = split_cols(h @ lp["w_in"], sizes)
    ua_c, ub_c, uc_c, ug_c = split_cols(hc @ lp["w_in"], sizes)
    ya, ya_c = rwkv_mixer(ua, ua_c, lp, need_ctx_out)
    yb, yb_c = mla_mixer(ub, ub_c, lp, ang_row, ang_col, need_ctx_out)
    yc, yc_c = na_mixer(uc, uc_c, lp["na_rpb"], need_ctx_out)
    out = merge_branches((ya, yb, yc), ug, lp["w_branch"], lp["w_out"])
    out_c = merge_branches((ya_c, yb_c, yc_c), ug_c, lp["w_branch"], lp["w_out"]) if need_ctx_out else None
    return out, out_c


def trunk_layer(x, xc, mod_lat, mod_ctx, lp, ang_row, ang_col, need_ctx_out):
    sh_a, sc_a, g_a, sh_m, sc_m, g_m = jnp.split(mod_lat, 6, axis=-1)
    csh_a, csc_a, cg_a, csh_m, csc_m, cg_m = jnp.split(mod_ctx, 6, axis=-1)
    h = modulate(rms_norm(x, lp["norm_mix_g"]), sh_a, sc_a)
    hc = modulate(rms_norm(xc, lp["norm_mix_g"]), csh_a, csc_a)
    mix, mix_c = token_mixers(h, hc, lp, ang_row, ang_col, need_ctx_out)
    x = x + g_a * mix
    x = x + g_m * sq_relu_mlp(modulate(rms_norm(x, lp["norm_mlp_g"]), sh_m, sc_m), lp["mlp_w1"], lp["mlp_w2"])
    if not need_ctx_out:
        return x, None
    xc = xc + cg_a * mix_c
    xc = xc + cg_m * sq_relu_mlp(modulate(rms_norm(xc, lp["norm_mlp_g"]), csh_m, csc_m), lp["mlp_w1"], lp["mlp_w2"])
    return x, xc


def setup_inputs(seed: int = 0) -> dict:
    key = jax.random.key(seed)
    ks = iter(jax.random.split(key, 40))

    def nrm(shape, scale):
        return scale * jax.random.normal(next(ks), shape, jnp.float32)

    L = DEPTH
    return {
        "x": nrm((BATCH, SEQ, D_MODEL), 1.0),
        "c": nrm((BATCH, D_MODEL), 1.0),
        "ctx": nrm((BATCH, CTX_LEN, D_MODEL), 1.0),
        "c_ctx": nrm((D_MODEL,), 1.0),
        "ada_w": nrm((L, D_MODEL, 6 * D_MODEL), 0.5 * D_MODEL ** -0.5),
        "ada_b": nrm((L, 6 * D_MODEL), 0.02),
        "norm_mix_g": 1.0 + nrm((L, D_MODEL), 0.05),
        "norm_mlp_g": 1.0 + nrm((L, D_MODEL), 0.05),
        "w_in": nrm((L, D_MODEL, IN_COLS), D_MODEL ** -0.5),
        "rwkv_conv": jnp.array([0.25, 0.5, 0.25], jnp.float32)[None, :, None] + nrm((L, 3, RWKV_COLS), 0.05),
        "rwkv_w0": -2.5 + nrm((L, 2, A_WIDTH), 1.5),
        "rwkv_w_up": nrm((L, 2, LORA_W, A_WIDTH), 0.5 * LORA_W ** -0.5),
        "rwkv_a0": nrm((L, 2, A_WIDTH), 0.5),
        "rwkv_a_up": nrm((L, 2, LORA_A, A_WIDTH), 0.5 * LORA_A ** -0.5),
        "rwkv_g_up": nrm((L, LORA_G, A_WIDTH), LORA_G ** -0.5),
        "rwkv_k_k": 0.85 + nrm((L, A_WIDTH), 0.05),
        "rwkv_k_a": 1.0 + nrm((L, A_WIDTH), 0.05),
        "rwkv_r_k": nrm((L, A_HEADS, A_HEAD_DIM), 0.1),
        "rwkv_ln_g": 1.0 + nrm((L, A_WIDTH), 0.05),
        "rwkv_ln_b": nrm((L, A_WIDTH), 0.02),
        "mla_q_norm_g": 1.0 + nrm((L, Q_LORA), 0.05),
        "mla_w_uq": nrm((L, Q_LORA, B_HEADS * (QK_NOPE + QK_ROPE)), Q_LORA ** -0.5),
        "mla_kv_norm_g": 1.0 + nrm((L, KV_LORA), 0.05),
        "mla_w_ukv": nrm((L, KV_LORA, B_HEADS * (QK_NOPE + V_DIM)), KV_LORA ** -0.5),
        "na_rpb": nrm((L, C_HEADS, 2 * WIN_ROWS - 1, 2 * WIN_COLS - 1), 0.1),
        "w_branch": nrm((L, N_BRANCH, BRANCH_WIDTH, D_MODEL), BRANCH_WIDTH ** -0.5),
        "w_out": nrm((L, D_MODEL, D_MODEL), D_MODEL ** -0.5),
        "mlp_w1": nrm((L, D_MODEL, D_FF), D_MODEL ** -0.5),
        "mlp_w2": nrm((L, D_FF, D_MODEL), D_FF ** -0.5),
        "final_norm_g": 1.0 + nrm((D_MODEL,), 0.05),
    }


def reference(x, c, ctx, c_ctx, ada_w, ada_b, norm_mix_g, norm_mlp_g, w_in, rwkv_conv, rwkv_w0, rwkv_w_up,
              rwkv_a0, rwkv_a_up, rwkv_g_up, rwkv_k_k, rwkv_k_a, rwkv_r_k, rwkv_ln_g, rwkv_ln_b,
              mla_q_norm_g, mla_w_uq, mla_kv_norm_g, mla_w_ukv, na_rpb, w_branch, w_out, mlp_w1, mlp_w2,
              final_norm_g):
    ang_row, ang_col = axial_angles(x.shape[1])
    s_lat = jax.nn.silu(c)
    s_ctx = jax.nn.silu(c_ctx)
    xc = ctx
    for l in range(DEPTH):
        lp = {
            "norm_mix_g": norm_mix_g[l], "norm_mlp_g": norm_mlp_g[l], "w_in": w_in[l],
            "rwkv_conv": rwkv_conv[l], "rwkv_w0": rwkv_w0[l], "rwkv_w_up": rwkv_w_up[l],
            "rwkv_a0": rwkv_a0[l], "rwkv_a_up": rwkv_a_up[l], "rwkv_g_up": rwkv_g_up[l],
            "rwkv_k_k": rwkv_k_k[l], "rwkv_k_a": rwkv_k_a[l], "rwkv_r_k": rwkv_r_k[l],
            "rwkv_ln_g": rwkv_ln_g[l], "rwkv_ln_b": rwkv_ln_b[l],
            "mla_q_norm_g": mla_q_norm_g[l], "mla_w_uq": mla_w_uq[l],
            "mla_kv_norm_g": mla_kv_norm_g[l], "mla_w_ukv": mla_w_ukv[l],
            "na_rpb": na_rpb[l], "w_branch": w_branch[l], "w_out": w_out[l],
            "mlp_w1": mlp_w1[l], "mlp_w2": mlp_w2[l],
        }
        mod_lat = (s_lat @ ada_w[l] + ada_b[l])[:, None, :]
        mod_ctx = s_ctx @ ada_w[l] + ada_b[l]
        x, xc = trunk_layer(x, xc, mod_lat, mod_ctx, lp, ang_row, ang_col, need_ctx_out=(l < DEPTH - 1))
    return rms_norm(x, final_norm_g)
```

```cpp
#include <hip/hip_runtime.h>
#include <cstdio>
#include <cstdint>

#define LAS __attribute__((address_space(3)))
typedef unsigned short bf16_t;
typedef short bf16x8 __attribute__((ext_vector_type(8)));
typedef short bf16x4 __attribute__((ext_vector_type(4)));
typedef float f32x4 __attribute__((ext_vector_type(4)));
typedef float f32x2 __attribute__((ext_vector_type(2)));
typedef unsigned u32x4 __attribute__((ext_vector_type(4)));
typedef unsigned u32x2 __attribute__((ext_vector_type(2)));

constexpr int D = 2048, SEQ = 8192, CTXL = 256, MROWS = SEQ + CTXL, DEPTH = 4, GRIDW = 64;
constexpr int IN_COLS = 13568, RWKV_COLS = 3712, MLA_OFF = 3712, NA_OFF = 4352, GATE_OFF = 7424, DFF = 8192;
constexpr int AW = 1024;
constexpr int QLORA = 448, KVLORA = 128, QKROPE = 64, QKNOPE = 128, VDIM = 128, BHEADS = 8, QHD = 192;
constexpr float RMS_EPS = 1e-6f, GN_EPS = 64e-5f;
constexpr float LOG2E = 1.4426950408889634f;

constexpr size_t al256(size_t x) { return (x + 255) & ~(size_t)255; }
constexpr size_t WS_CTL = 0;
constexpr size_t CTL_BYTES = 65536;
constexpr size_t WS_MOD = WS_CTL + CTL_BYTES;
constexpr size_t WS_LBIAS = al256(WS_MOD + (size_t)DEPTH * 2 * 6 * D * 4);
constexpr size_t WS_ROPE = al256(WS_LBIAS + (size_t)DEPTH * 5 * AW * 4);
constexpr size_t WS_X = al256(WS_ROPE + (size_t)SEQ * 32 * 2 * 4);
constexpr size_t WS_H = al256(WS_X + (size_t)MROWS * D * 4);
constexpr size_t WS_U = al256(WS_H + (size_t)MROWS * D * 2);
constexpr size_t WS_WIN = al256(WS_U + (size_t)MROWS * IN_COLS * 2);
constexpr size_t WS_W1 = al256(WS_WIN + (size_t)DEPTH * IN_COLS * D * 2);
constexpr size_t WS_W2 = al256(WS_W1 + (size_t)DEPTH * DFF * D * 2);
constexpr size_t WS_WB = al256(WS_W2 + (size_t)DEPTH * DFF * D * 2);
constexpr size_t WS_WO = al256(WS_WB + (size_t)DEPTH * D * 3072 * 2);
constexpr size_t WS_WUQ = al256(WS_WO + (size_t)DEPTH * D * D * 2);
constexpr size_t WS_WUKV = al256(WS_WUQ + (size_t)DEPTH * 1536 * 512 * 2);
constexpr size_t WS_WLORA = al256(WS_WUKV + (size_t)DEPTH * 2048 * 256 * 2);
constexpr size_t WS_RF = al256(WS_WLORA + (size_t)DEPTH * 5120 * 256 * 2);
constexpr size_t WS_KF = al256(WS_RF + (size_t)MROWS * AW * 4);
constexpr size_t WS_VF = al256(WS_KF + (size_t)MROWS * AW * 4);
constexpr size_t WS_WD = al256(WS_VF + (size_t)MROWS * AW * 4);
constexpr size_t WS_AD = al256(WS_WD + (size_t)2 * MROWS * AW * 4);
constexpr size_t WS_G = al256(WS_AD + (size_t)2 * MROWS * AW * 4);
constexpr size_t WS_Y = al256(WS_G + (size_t)MROWS * AW * 4);
constexpr size_t WS_LA = al256(WS_Y + (size_t)2 * MROWS * AW * 4);
constexpr size_t WS_QL = al256(WS_LA + (size_t)MROWS * 1280 * 2);
constexpr size_t WS_KVL = al256(WS_QL + (size_t)MROWS * 512 * 2);
constexpr size_t WS_KPE = al256(WS_KVL + (size_t)MROWS * 256 * 2);
constexpr size_t WS_Q = WS_KPE;
constexpr size_t WS_KC = al256(WS_Q + (size_t)MROWS * 1536 * 2);
constexpr size_t WS_VC = al256(WS_KC + (size_t)MROWS * 1536 * 2);
constexpr size_t WS_YCAT = al256(WS_VC + (size_t)MROWS * 1024 * 2);
constexpr size_t WS_MRG = WS_RF;
constexpr size_t WS_MRGB = al256(WS_YCAT + (size_t)MROWS * 3072 * 2);
constexpr size_t WS_MN = al256(WS_MRGB + (size_t)MROWS * D * 2);
constexpr size_t WS_RY = al256(WS_MN + (size_t)4224 * 2 * 4096 * 4);
constexpr size_t WS_SC = al256(WS_RY + (size_t)4224 * 4096 * 2);
constexpr size_t WS_CSCR = al256(WS_SC + (size_t)4224 * 4096 * 2);
constexpr size_t WS_PM = WS_MN;
constexpr size_t WS_PO = WS_PM + (size_t)12 * CTXL * D * 4;
constexpr size_t WS_P2 = WS_PO + (size_t)8 * CTXL * D * 4;
static_assert(WS_P2 + (size_t)32 * CTXL * D * 4 <= WS_RY, "partial slabs must fit the MN buffer");
constexpr size_t WS_END = al256(WS_CSCR + (size_t)64 * 65536 * 2);
static_assert(WS_KF == WS_RF + (size_t)MROWS * AW * 4, "MRG alias needs r|k contiguous");

constexpr int LDS_BYTES = 147456;
constexpr int LDS_BAR_OFF = LDS_BYTES - 16;
constexpr int NTHREADS = 512;

typedef __bf16 bf16x2n __attribute__((ext_vector_type(2)));
__device__ __forceinline__ unsigned cvt_pk_bf16(float lo, float hi) { return __builtin_bit_cast(unsigned, __builtin_convertvector((f32x2){lo, hi}, bf16x2n)); }
__device__ __forceinline__ bf16_t f2bf(float f) { return __builtin_bit_cast(bf16_t, (__bf16)f); }
__device__ __forceinline__ float bf2f(bf16_t h) { return __uint_as_float(((unsigned)h) << 16); }
__device__ __forceinline__ float bflo(unsigned w) { return __uint_as_float(w << 16); }
__device__ __forceinline__ float bfhi(unsigned w) { return __uint_as_float(w & 0xFFFF0000u); }
__device__ __forceinline__ float sigmoidf_(float x) { return __builtin_amdgcn_rcpf(1.0f + __expf(-x)); }
__device__ __forceinline__ void unpack8(const u32x4 w, float (&f)[8]) { f[0] = bflo(w.x); f[1] = bfhi(w.x); f[2] = bflo(w.y); f[3] = bfhi(w.y); f[4] = bflo(w.z); f[5] = bfhi(w.z); f[6] = bflo(w.w); f[7] = bfhi(w.w); }
__device__ __forceinline__ u32x4 pack8(const float (&f)[8]) { u32x4 w; w.x = cvt_pk_bf16(f[0], f[1]); w.y = cvt_pk_bf16(f[2], f[3]); w.z = cvt_pk_bf16(f[4], f[5]); w.w = cvt_pk_bf16(f[6], f[7]); return w; }

__device__ __forceinline__ void lds_barrier() { asm volatile("s_waitcnt lgkmcnt(0)\n\ts_barrier" ::: "memory"); }
__device__ __forceinline__ f32x4 zero4v() { f32x4 z = (f32x4){0.f, 0.f, 0.f, 0.f}; asm volatile("" : "+v"(z)); return z; }
__device__ __forceinline__ float shx(float v, int m, int lane) { return __int_as_float(__builtin_amdgcn_ds_bpermute((lane ^ m) << 2, __float_as_int(v))); }
__device__ __forceinline__ float rows_max(float x) {
    const auto r = __builtin_amdgcn_permlane16_swap(__float_as_uint(x), __float_as_uint(x), false, false); x = fmaxf(__uint_as_float(r[0]), __uint_as_float(r[1]));
    const auto q = __builtin_amdgcn_permlane32_swap(__float_as_uint(x), __float_as_uint(x), false, false); return fmaxf(__uint_as_float(q[0]), __uint_as_float(q[1]));
}
__device__ __forceinline__ float rows_sum(float x) {
    const auto r = __builtin_amdgcn_permlane16_swap(__float_as_uint(x), __float_as_uint(x), false, false); x = __uint_as_float(r[0]) + __uint_as_float(r[1]);
    const auto q = __builtin_amdgcn_permlane32_swap(__float_as_uint(x), __float_as_uint(x), false, false); return __uint_as_float(q[0]) + __uint_as_float(q[1]);
}
__device__ __forceinline__ float wave_sum(float x, int  ) {
    x += __int_as_float(__builtin_amdgcn_update_dpp(0, __float_as_int(x), 0xB1, 0xF, 0xF, true));
    x += __int_as_float(__builtin_amdgcn_update_dpp(0, __float_as_int(x), 0x4E, 0xF, 0xF, true));
    x += __int_as_float(__builtin_amdgcn_update_dpp(0, __float_as_int(x), 0x141, 0xF, 0xF, true));
    x += __int_as_float(__builtin_amdgcn_update_dpp(0, __float_as_int(x), 0x140, 0xF, 0xF, true));
    const int xi = __float_as_int(x);
    return (__int_as_float(__builtin_amdgcn_readlane(xi, 0)) + __int_as_float(__builtin_amdgcn_readlane(xi, 16))) +
           (__int_as_float(__builtin_amdgcn_readlane(xi, 32)) + __int_as_float(__builtin_amdgcn_readlane(xi, 48)));
}

#define XB_TMO      128
#define XB_XCNT(j)  (256  + 64 * (j))
#define XB_XSUB(j)  (1280 + 64 * (j))
#define XB_XGEN(j)  (2304 + 64 * (j))
#define XB_TOP      3328
#define XB_TOPGEN   3392
#define XCD_BAR_WORDS 3456
#define XB_SPIN_CAP (1u << 22)

__device__ __forceinline__ unsigned xb_ld(unsigned* p)              { return __hip_atomic_load(p, __ATOMIC_RELAXED, __HIP_MEMORY_SCOPE_AGENT); }
__device__ __forceinline__ unsigned xb_add(unsigned* p, unsigned v) { return __hip_atomic_fetch_add(p, v, __ATOMIC_RELAXED, __HIP_MEMORY_SCOPE_AGENT); }
__device__ __forceinline__ unsigned xb_xcc_id() { return (unsigned)__builtin_amdgcn_s_getreg((3 << 11) | 20) & 0xFu; }
#define XB_SPIN(cond, bar) do { unsigned _sp = 0; while (cond) { __builtin_amdgcn_s_sleep(1); \
    if ((++_sp & 255u) == 0u) { if (xb_ld(&(bar)[XB_TMO])) break; if (_sp > XB_SPIN_CAP) { atomicAdd(&(bar)[XB_TMO], 1u); break; } } } } while (0)

struct XcdBarrier { unsigned* bar; unsigned x; volatile LAS unsigned* st; };

__device__ __forceinline__ XcdBarrier xcd_barrier_post(unsigned* bar, volatile LAS unsigned* st) {
    XcdBarrier b; b.bar = bar; b.x = xb_xcc_id(); b.st = st;
    if (threadIdx.x == 0) (void)xb_add(&bar[XB_XCNT(b.x)], 1u);
    return b;
}
__device__ __forceinline__ void xcd_barrier_complete(unsigned* bar, unsigned x, unsigned& nloc, unsigned& nx) {
    const unsigned G = gridDim.x * gridDim.y * gridDim.z;
    unsigned sum, cnt, mine, sp = 0u;
    for (;;) {
        sum = 0u; cnt = 0u; mine = 0u;
#pragma unroll
        for (unsigned j = 0; j < 16; ++j) { const unsigned c = xb_ld(&bar[XB_XCNT(j)]); sum += c; cnt += (c > 0u) ? 1u : 0u; mine = (j == x) ? c : mine; }
        if (sum == G) break;
        __builtin_amdgcn_s_sleep(1);
        if ((++sp & 255u) == 0u) { if (xb_ld(&bar[XB_TMO])) break; if (sp > XB_SPIN_CAP) { atomicAdd(&bar[XB_TMO], 1u); break; } }
    }
    nloc = mine > 0u ? mine : 1u; nx = cnt > 0u ? cnt : 1u;
}
__device__ __forceinline__ void xcd_barrier(const XcdBarrier& b) {
    asm volatile("s_waitcnt vmcnt(0)" ::: "memory");
    __syncthreads();
    if (threadIdx.x == 0) {
        unsigned* bar = b.bar;
        __builtin_amdgcn_s_waitcnt(0);
        unsigned nloc = b.st[0], nx = b.st[1];
        if (nloc == 0u) { xcd_barrier_complete(bar, b.x, nloc, nx); b.st[0] = nloc; b.st[1] = nx; }
        const unsigned old = xb_add(&bar[XB_XSUB(b.x)], 1u);
        const unsigned gen = old / nloc;
        if (old + 1u == (gen + 1u) * nloc) {
            __builtin_amdgcn_fence(__ATOMIC_RELEASE, "agent");
            asm volatile("s_waitcnt vmcnt(0)" ::: "memory");
            const unsigned og = xb_add(&bar[XB_TOP], 1u);
            const unsigned tg = og / nx;
            if (og + 1u == (tg + 1u) * nx) xb_add(&bar[XB_TOPGEN], 1u);
            else XB_SPIN(xb_ld(&bar[XB_TOPGEN]) == tg, bar);
            __builtin_amdgcn_fence(__ATOMIC_ACQUIRE, "agent");
            xb_add(&bar[XB_XGEN(b.x)], 1u);
            asm volatile("s_waitcnt vmcnt(0)" ::: "memory");
        } else {
            XB_SPIN(xb_ld(&bar[XB_XGEN(b.x)]) == gen, bar);
            __builtin_amdgcn_fence(__ATOMIC_ACQUIRE, "agent");
            asm volatile("s_waitcnt vmcnt(0)" ::: "memory");
        }
    }
    __syncthreads();
}

namespace pg8 {
constexpr int BM = 256, BK = 64, HALF = 128, HTB = HALF * BK * 2, STAGE_BYTES = 8 * HTB, NXCD = 8, WGM = 4;
__host__ __device__ __forceinline__ int lds_byte(int r, int c) { const int st = (r >> 4) * 2 + (c >> 5), rr = r & 15, cc = c & 31, ob = rr * 64 + cc * 2; return st * 1024 + (ob ^ (((ob >> 9) & 1) << 5)); }
__host__ __device__ __forceinline__ void stage_rc(int b, int& R, int& C) { const int st = b / 1024, sb = b % 1024, swz = sb ^ (((sb >> 9) & 1) << 5); R = (st >> 1) * 16 + swz / 64; C = (st & 1) * 32 + (swz % 64) / 2; }
__host__ __device__ __forceinline__ int perm32(int rho) { const int n = rho >> 4, i = rho & 15; return 8 * (i >> 2) + 4 * n + (i & 3); }

struct Unit { int pm, pn; };
struct Gemm { const bf16_t* A; const bf16_t* Bt; int M, N, K, lda, ldb;
    long pstepA = -1, pstepB = -1, qstepB = 0; };

struct StaticOrder {
    int nM, nN, nwg, G, c;
    __device__ __forceinline__ void init(int M, int N, int G_, int c_) { nM = M / BM; nN = N / BM; nwg = nM * nN; G = G_; c = c_; }
    __device__ __forceinline__ bool next(int i, Unit& u) const {
        const long L = (long)i * G + c; if (L >= nwg) return false;
        int wgid = (int)L; { const int q = nwg / NXCD, r = nwg % NXCD, xcd = wgid % NXCD, off = wgid / NXCD; wgid = (xcd < r ? xcd * (q + 1) : r * (q + 1) + (xcd - r) * q) + off; }
        const int nig = WGM * nN, gid = wgid / nig, fm = gid * WGM, gsz = (nM - fm) < WGM ? (nM - fm) : WGM;
        u.pm = fm + ((wgid % nig) % gsz); u.pn = (wgid % nig) / gsz; return true;
    }
};

struct LoraOrder {
    int G, c;
    __device__ __forceinline__ void init(int G_, int c_) { G = G_; c = c_; }
    __device__ __forceinline__ bool next(int i, Unit& u) const {
        const int L = i * G + c; if (L >= 5 * 132) return false;
        const int grp = L / 132, r = L - grp * 132;
        u.pm = grp * (MROWS / 256) + (r % (MROWS / 256)); u.pn = grp * 4 + r / (MROWS / 256); return true;
    }
};

template <class Epi, class Sched, int MIDK = 0, bool ALIGN_EPI = true>
__device__ __forceinline__ void gemm_phase(LAS unsigned char* lds, const Gemm g, const Sched& S, const Epi& E, const int tid) {
    const int wid = __builtin_amdgcn_readfirstlane(tid >> 6), lane = tid & 63, wr = wid >> 2, wc = wid & 3, fr = lane & 15, fq = lane >> 4;
    int nt = g.K / BK; asm volatile("" : "+s"(nt));
    unsigned voffA[2], voffB[2];
#pragma unroll
    for (int i = 0; i < 2; ++i) { int R, C; stage_rc(tid * 16 + i * 8192, R, C); const int Rb = Epi::PERM ? ((R & ~31) + perm32(R & 31)) : R;
        voffA[i] = (unsigned)(R * g.lda + C) * 2u; voffB[i] = (unsigned)(Rb * g.ldb + C) * 2u; }
    const size_t kstep = (size_t)(BK * 2);
    const size_t hstepA = (size_t)HALF * g.lda * 2, hstepB = (size_t)HALF * g.ldb * 2;
    const size_t tstepA = g.pstepA < 0 ? 2 * hstepA : (size_t)g.pstepA, tstepB = g.pstepB < 0 ? 2 * hstepB : (size_t)g.pstepB, qB = (size_t)g.qstepB;
    const unsigned ldsw = (unsigned)wid * 1024u;
    const int aoff = lds_byte(wr * 64 + fr, fq * 8), boff = lds_byte(wc * 32 + fr, fq * 8);
#define PG8_SA(b, h) (((b) * 2 + (h)) * HTB)
#define PG8_SB(b, h) ((4 + (b) * 2 + (h)) * HTB)
#define PG8_STAGE(bufoff, gbase, voff) do { _Pragma("unroll") for (int _i = 0; _i < 2; ++_i) \
        __builtin_amdgcn_global_load_lds((const unsigned*)((const char*)(gbase) + (voff)[_i]), (LAS unsigned*)(lds + (bufoff) + ldsw + _i * 8192), 16, 0, 0); } while (0)
#define PG8_LDA(dst, b, h) do { _Pragma("unroll") for (int m = 0; m < 4; ++m) _Pragma("unroll") for (int k = 0; k < 2; ++k) dst[m][k] = *(const LAS bf16x8*)(lds + PG8_SA(b, h) + aoff + m * 2048 + k * 1024); } while (0)
#define PG8_LDB(dst, b, h) do { _Pragma("unroll") for (int n = 0; n < 2; ++n) _Pragma("unroll") for (int k = 0; k < 2; ++k) dst[n][k] = *(const LAS bf16x8*)(lds + PG8_SB(b, h) + boff + n * 2048 + k * 1024); } while (0)
#define PG8_MMA(ai, bj, At, Bt) do { __builtin_amdgcn_s_setprio(1); _Pragma("unroll") for (int m = 0; m < 4; ++m) _Pragma("unroll") for (int n = 0; n < 2; ++n) _Pragma("unroll") for (int k = 0; k < 2; ++k) \
        acc[ai][bj][m][n] = __builtin_amdgcn_mfma_f32_16x16x32_bf16(Bt[n][k], At[m][k], acc[ai][bj][m][n], 0, 0, 0); __builtin_amdgcn_s_setprio(0); } while (0)
#define PG8_WAIT_V(n) asm volatile("s_waitcnt vmcnt(" #n ")" ::: "memory")
#define PG8_WAIT_L(n) asm volatile("s_waitcnt lgkmcnt(" #n ")" ::: "memory")
#define PG8_BAR __builtin_amdgcn_s_barrier()
#define PG8_SCHED __builtin_amdgcn_sched_barrier(0)
    Unit cur, nxt; int ui = 0;
    if (!S.next(0, cur)) return;
    f32x4 acc[2][2][4][2];
#pragma unroll
    for (int a = 0; a < 2; ++a)
#pragma unroll
        for (int b = 0; b < 2; ++b)
#pragma unroll
            for (int m = 0; m < 4; ++m)
#pragma unroll
                for (int n = 0; n < 2; ++n) acc[a][b][m][n] = zero4v();
    bf16x8 At[4][2], B0[2][2], B1[2][2];
    const char* cA = (const char*)g.A + (size_t)cur.pm * tstepA; const char* cB = (const char*)g.Bt + (size_t)cur.pn * tstepB + (size_t)cur.pm * qB;
    PG8_STAGE(PG8_SB(0, 0), cB, voffB); PG8_STAGE(PG8_SB(0, 1), cB + hstepB, voffB); PG8_STAGE(PG8_SA(0, 0), cA, voffA); PG8_STAGE(PG8_SA(0, 1), cA + hstepA, voffA);
    if (wr == 1) PG8_BAR;
    PG8_WAIT_V(2); PG8_BAR;
    PG8_STAGE(PG8_SB(1, 0), cB + kstep, voffB); PG8_STAGE(PG8_SA(1, 0), cA + kstep, voffA); PG8_STAGE(PG8_SB(1, 1), cB + hstepB + kstep, voffB);
    PG8_WAIT_V(6); PG8_BAR;
    for (;;) {
        const bool has_next = S.next(ui + 1, nxt);
        const char* nA = has_next ? (const char*)g.A + (size_t)nxt.pm * tstepA : cA; const char* nB = has_next ? (const char*)g.Bt + (size_t)nxt.pn * tstepB + (size_t)nxt.pm * qB : cB;
        for (int t = 0; t < nt; t += 2) {
            const bool last = (t == nt - 2);
            const char* a1 = cA + (size_t)(t + 1) * kstep;
            const char* a2 = last ? nA : cA + (size_t)(t + 2) * kstep; const char* b2 = last ? nB : cB + (size_t)(t + 2) * kstep;
            const char* a3 = a2 + kstep; const char* b3 = b2 + kstep;
            PG8_LDB(B0, 0, 0); PG8_LDB(B1, 0, 1); PG8_SCHED; PG8_LDA(At, 0, 0); PG8_STAGE(PG8_SA(1, 1), a1 + hstepA, voffA);
            PG8_WAIT_V(8); PG8_WAIT_L(0); PG8_BAR; PG8_MMA(0, 0, At, B0); PG8_MMA(0, 1, At, B1); PG8_BAR; PG8_SCHED;
            PG8_LDA(At, 0, 1); PG8_STAGE(PG8_SB(0, 0), b2, voffB); PG8_STAGE(PG8_SB(0, 1), b2 + hstepB, voffB); PG8_STAGE(PG8_SA(0, 0), a2, voffA);
            PG8_WAIT_V(8); PG8_WAIT_L(0); PG8_BAR; PG8_MMA(1, 0, At, B0); PG8_MMA(1, 1, At, B1); PG8_BAR; PG8_SCHED;
            PG8_LDB(B0, 1, 0); PG8_LDB(B1, 1, 1); PG8_SCHED; PG8_LDA(At, 1, 0); PG8_STAGE(PG8_SA(0, 1), a2 + hstepA, voffA);
            PG8_WAIT_V(8); PG8_WAIT_L(0); PG8_BAR; PG8_MMA(0, 0, At, B0); PG8_MMA(0, 1, At, B1); PG8_BAR; PG8_SCHED;
            PG8_LDA(At, 1, 1); PG8_STAGE(PG8_SB(1, 0), b3, voffB); PG8_STAGE(PG8_SB(1, 1), b3 + hstepB, voffB); PG8_STAGE(PG8_SA(1, 0), a3, voffA);
            PG8_WAIT_V(8); PG8_WAIT_L(0); PG8_BAR; PG8_MMA(1, 0, At, B0); PG8_MMA(1, 1, At, B1); PG8_BAR; PG8_SCHED;
            if constexpr (MIDK > 0) { if (((t + 2) % MIDK) == 0 && t + 2 < nt) { int ln_; asm volatile("v_mbcnt_lo_u32_b32 %0, -1, 0\n\tv_mbcnt_hi_u32_b32 %0, -1, %0" : "=v"(ln_)); E.mid(acc, cur, (t + 2) / MIDK - 1, wr, wc, ln_ & 15, ln_ >> 4); } }
        }
        if constexpr (ALIGN_EPI) { if (wr == 0) PG8_BAR; }
        { int ln_; asm volatile("v_mbcnt_lo_u32_b32 %0, -1, 0\n\tv_mbcnt_hi_u32_b32 %0, -1, %0" : "=v"(ln_)); E(acc, cur, wr, wc, ln_ & 15, ln_ >> 4); }
        if (!has_next) break;
#pragma unroll
        for (int a = 0; a < 2; ++a)
#pragma unroll
            for (int b = 0; b < 2; ++b)
#pragma unroll
                for (int m = 0; m < 4; ++m)
#pragma unroll
                    for (int n = 0; n < 2; ++n) acc[a][b][m][n] = zero4v();
        cur = nxt; cA = nA; cB = nB; ++ui;
        if constexpr (ALIGN_EPI) { if (wr == 1) PG8_BAR; }
    }
    PG8_WAIT_V(0);
    if constexpr (!ALIGN_EPI) { if (wr == 0) PG8_BAR; }
    PG8_BAR;
#undef PG8_SA
#undef PG8_SB
#undef PG8_STAGE
#undef PG8_LDA
#undef PG8_LDB
#undef PG8_MMA
#undef PG8_WAIT_V
#undef PG8_WAIT_L
#undef PG8_BAR
#undef PG8_SCHED
}

template <int ACT  > struct EpiBf16 {
    static constexpr bool PERM = true;
    bf16_t* O; int ldc;
    __device__ __forceinline__ void operator()(const f32x4 (&acc)[2][2][4][2], const Unit& u, int wr, int wc, int fr, int fq) const {
        const int row0 = u.pm * BM + wr * 64 + fr, col0 = u.pn * BM + wc * 32 + 8 * fq;
#pragma unroll
        for (int ai = 0; ai < 2; ++ai)
#pragma unroll
            for (int m = 0; m < 4; ++m) { bf16_t* rowp = O + (size_t)(row0 + ai * HALF + m * 16) * ldc + col0;
#pragma unroll
                for (int bj = 0; bj < 2; ++bj) { f32x4 v0 = acc[ai][bj][m][0], v1 = acc[ai][bj][m][1];
                    if (ACT == 1) {
#pragma unroll
                        for (int j = 0; j < 4; ++j) { const float a = fmaxf(v0[j], 0.f), b = fmaxf(v1[j], 0.f); v0[j] = a * a; v1[j] = b * b; } }
                    u32x4 w; w.x = cvt_pk_bf16(v0[0], v0[1]); w.y = cvt_pk_bf16(v0[2], v0[3]); w.z = cvt_pk_bf16(v1[0], v1[1]); w.w = cvt_pk_bf16(v1[2], v1[3]);
                    *(u32x4*)(rowp + bj * HALF) = w; } }
    }
};

struct EpiKV {
    static constexpr bool PERM = true;
    bf16_t* KC; bf16_t* VC;
    __device__ __forceinline__ void operator()(const f32x4 (&acc)[2][2][4][2], const Unit& u, int wr, int wc, int fr, int fq) const {
        const int row0 = u.pm * BM + wr * 64 + fr, c0 = wc * 32 + 8 * fq;
#pragma unroll
        for (int ai = 0; ai < 2; ++ai)
#pragma unroll
            for (int m = 0; m < 4; ++m) { const size_t row = (size_t)(row0 + ai * HALF + m * 16);
#pragma unroll
                for (int bj = 0; bj < 2; ++bj) { const f32x4 v0 = acc[ai][bj][m][0], v1 = acc[ai][bj][m][1];
                    u32x4 w; w.x = cvt_pk_bf16(v0[0], v0[1]); w.y = cvt_pk_bf16(v0[2], v0[3]); w.z = cvt_pk_bf16(v1[0], v1[1]); w.w = cvt_pk_bf16(v1[2], v1[3]);
                    bf16_t* dst = (bj == 0) ? KC + row * 1536 + u.pn * 192 + c0 : VC + row * 1024 + u.pn * 128 + c0;
                    *(u32x4*)dst = w; } }
    }
};

struct EpiLora {
    static constexpr bool PERM = false;
    float* Z; const float* bias;
    __device__ __forceinline__ void operator()(const f32x4 (&acc)[2][2][4][2], const Unit& u, int wr, int wc, int fr, int fq) const {
        const int grp = u.pn >> 2;
        const int row0 = (u.pm - grp * (MROWS / 256)) * BM + wr * 64 + fr, col0 = (u.pn & 3) * BM + wc * 32 + 4 * fq;
        float* base = Z + (size_t)grp * MROWS * AW; const float* bp = bias + grp * AW + col0;
        f32x4 bv[2][2];
#pragma unroll
        for (int bj = 0; bj < 2; ++bj)
#pragma unroll
            for (int n = 0; n < 2; ++n) bv[bj][n] = *(const f32x4*)(bp + bj * HALF + n * 16);
#pragma unroll
        for (int ai = 0; ai < 2; ++ai)
#pragma unroll
            for (int m = 0; m < 4; ++m) { float* rowp = base + (size_t)(row0 + ai * HALF + m * 16) * AW + col0;
#pragma unroll
                for (int bj = 0; bj < 2; ++bj)
#pragma unroll
                    for (int n = 0; n < 2; ++n) *(f32x4*)(rowp + bj * HALF + n * 16) = acc[ai][bj][m][n] + bv[bj][n]; }
    }
};

struct EpiMerge {
    static constexpr bool PERM = true;
    bf16_t* Mb; const bf16_t* Ug;
    __device__ __forceinline__ void mid(f32x4 (&acc)[2][2][4][2], const Unit& u, int seg, int wr, int wc, int fr, int fq) const {
        const int row0 = u.pm * BM + wr * 64 + fr, col0 = u.pn * BM + wc * 32 + 8 * fq;
#pragma unroll
        for (int ai = 0; ai < 2; ++ai) {
            u32x4 ga[4][2], gb[4][2];
#pragma unroll
            for (int m = 0; m < 4; ++m) { const bf16_t* gp = Ug + (size_t)(row0 + ai * HALF + m * 16) * IN_COLS + seg * 2048 + col0;
#pragma unroll
                for (int bj = 0; bj < 2; ++bj) { ga[m][bj] = *(const u32x4*)(gp + bj * HALF); gb[m][bj] = *(const u32x4*)(gp + 2048 + bj * HALF); } }
            asm volatile("" ::: "memory");
#pragma unroll
            for (int m = 0; m < 4; ++m)
#pragma unroll
                for (int bj = 0; bj < 2; ++bj) {
                    float a[8], b[8]; unpack8(ga[m][bj], a); unpack8(gb[m][bj], b);
#pragma unroll
                    for (int e = 0; e < 8; ++e) { const float ea = __expf(-fminf(fmaxf(a[e], -30.f), 30.f)), eb = __expf(-fminf(fmaxf(b[e], -30.f), 30.f));
                        const float ratio = (1.0f + eb) * __builtin_amdgcn_rcpf(1.0f + ea);
                        acc[ai][bj][m][e >> 2][e & 3] *= ratio; }
                }
        }
    }
    __device__ __forceinline__ void operator()(const f32x4 (&acc)[2][2][4][2], const Unit& u, int wr, int wc, int fr, int fq) const {
        const int row0 = u.pm * BM + wr * 64 + fr, col0 = u.pn * BM + wc * 32 + 8 * fq;
#pragma unroll
        for (int ai = 0; ai < 2; ++ai) {
            u32x4 gq_[4][2];
#pragma unroll
            for (int m = 0; m < 4; ++m)
#pragma unroll
                for (int bj = 0; bj < 2; ++bj) gq_[m][bj] = *(const u32x4*)(Ug + (size_t)(row0 + ai * HALF + m * 16) * IN_COLS + 4096 + col0 + bj * HALF);
            asm volatile("" ::: "memory");
#pragma unroll
            for (int m = 0; m < 4; ++m) { const size_t row = (size_t)(row0 + ai * HALF + m * 16);
#pragma unroll
                for (int bj = 0; bj < 2; ++bj) { const int col = col0 + bj * HALF;
                    float gq[8]; unpack8(gq_[m][bj], gq);
                    f32x4 v0 = acc[ai][bj][m][0], v1 = acc[ai][bj][m][1];
#pragma unroll
                    for (int e = 0; e < 4; ++e) { v0[e] *= sigmoidf_(gq[e]); v1[e] *= sigmoidf_(gq[4 + e]); }
                    u32x4 w; w.x = cvt_pk_bf16(v0[0], v0[1]); w.y = cvt_pk_bf16(v0[2], v0[3]); w.z = cvt_pk_bf16(v1[0], v1[1]); w.w = cvt_pk_bf16(v1[2], v1[3]);
                    *(u32x4*)(Mb + row * D + col) = w; } }
        }
    }
};

struct EpiResid {
    static constexpr bool PERM = false;
    float* X; const float* gl; const float* gc;
    __device__ __forceinline__ void operator()(const f32x4 (&acc)[2][2][4][2], const Unit& u, int wr, int wc, int fr, int fq) const {
        const int row0 = u.pm * BM + wr * 64 + fr, col0 = u.pn * BM + wc * 32 + 4 * fq;
        const float* gate = (u.pm * BM < SEQ) ? gl : gc;
        f32x4 gv[2][2];
#pragma unroll
        for (int bj = 0; bj < 2; ++bj)
#pragma unroll
            for (int n = 0; n < 2; ++n) gv[bj][n] = *(const f32x4*)(gate + col0 + bj * HALF + n * 16);
#pragma unroll
        for (int ai = 0; ai < 2; ++ai) {
            f32x4 xv[4][2][2];
#pragma unroll
            for (int m = 0; m < 4; ++m)
#pragma unroll
                for (int bj = 0; bj < 2; ++bj)
#pragma unroll
                    for (int n = 0; n < 2; ++n) xv[m][bj][n] = *(const f32x4*)(X + (size_t)(row0 + ai * HALF + m * 16) * D + col0 + bj * HALF + n * 16);
            asm volatile("" ::: "memory");
#pragma unroll
            for (int m = 0; m < 4; ++m)
#pragma unroll
                for (int bj = 0; bj < 2; ++bj)
#pragma unroll
                    for (int n = 0; n < 2; ++n) *(f32x4*)(X + (size_t)(row0 + ai * HALF + m * 16) * D + col0 + bj * HALF + n * 16) = xv[m][bj][n] + acc[ai][bj][m][n] * gv[bj][n];
            asm volatile("" ::: "memory");
        }
    }
};

template <int GATE> struct EpiPartial {
    static constexpr bool PERM = false;
    float* P; const float* gate; const bf16_t* Ugc;
    __device__ __forceinline__ void operator()(const f32x4 (&acc)[2][2][4][2], const Unit& u, int wr, int wc, int fr, int fq) const {
        const int row0 = wr * 64 + fr, col0 = u.pn * BM + wc * 32 + 4 * fq;
        float* base = P + (size_t)u.pm * CTXL * D;
#pragma unroll
        for (int ai = 0; ai < 2; ++ai)
#pragma unroll
            for (int m = 0; m < 4; ++m) { const int row = row0 + ai * HALF + m * 16;
#pragma unroll
                for (int bj = 0; bj < 2; ++bj)
#pragma unroll
                    for (int n = 0; n < 2; ++n) { const int col = col0 + bj * HALF + n * 16;
                        f32x4 gv;
                        if (GATE == 0) gv = *(const f32x4*)(gate + col);
                        else { const u32x2 gw = *(const u32x2*)(Ugc + (size_t)row * IN_COLS + u.pm * 2048 + col);
                            gv[0] = sigmoidf_(bflo(gw.x)); gv[1] = sigmoidf_(bfhi(gw.x)); gv[2] = sigmoidf_(bflo(gw.y)); gv[3] = sigmoidf_(bfhi(gw.y)); }
                        *(f32x4*)(base + (size_t)row * D + col) = acc[ai][bj][m][n] * gv; } }
    }
};
}

struct Args { const float* in[30]; float* out; unsigned char* ws; int ph_lo, ph_hi, flags, pad_; };
enum { I_X = 0, I_C, I_CTX, I_CCTX, I_ADAW, I_ADAB, I_NMIXG, I_NMLPG, I_WIN, I_CONV, I_W0, I_WUP, I_A0, I_AUP, I_GUP, I_KK, I_KA, I_RK, I_LNG, I_LNB,
       I_QNG, I_WUQ, I_KVNG, I_WUKV, I_RPB, I_WBR, I_WOUT, I_W1, I_W2, I_FNG };

struct Frame {
    LAS unsigned char* lds; int tid, lane, wave, bid, nb;
    const float* const* in; unsigned char* ws; float* out;
};

struct TJob { const float* src; bf16_t* dst; int K, Kpad, N, ldd; };

__device__ __forceinline__ TJob make_job(const Frame& F, int l, int j) {
    TJob t; unsigned char* ws = F.ws;
    switch (j) {
    case 0: t.src = F.in[I_WIN] + (size_t)l * D * IN_COLS; t.dst = (bf16_t*)(ws + WS_WIN) + (size_t)l * IN_COLS * D; t.K = D; t.Kpad = D; t.N = IN_COLS; t.ldd = D; break;
    case 1: t.src = F.in[I_W1] + (size_t)l * D * DFF; t.dst = (bf16_t*)(ws + WS_W1) + (size_t)l * DFF * D; t.K = D; t.Kpad = D; t.N = DFF; t.ldd = D; break;
    case 2: t.src = F.in[I_W2] + (size_t)l * DFF * D; t.dst = (bf16_t*)(ws + WS_W2) + (size_t)l * D * DFF; t.K = DFF; t.Kpad = DFF; t.N = D; t.ldd = DFF; break;
    case 3: case 4: case 5: t.src = F.in[I_WBR] + ((size_t)l * 3 + (j - 3)) * 1024 * D; t.dst = (bf16_t*)(ws + WS_WB) + (size_t)l * D * 3072 + (j - 3) * 1024; t.K = 1024; t.Kpad = 1024; t.N = D; t.ldd = 3072; break;
    case 6: t.src = F.in[I_WOUT] + (size_t)l * D * D; t.dst = (bf16_t*)(ws + WS_WO) + (size_t)l * D * D; t.K = D; t.Kpad = D; t.N = D; t.ldd = D; break;
    case 7: t.src = F.in[I_WUQ] + (size_t)l * QLORA * 1536; t.dst = (bf16_t*)(ws + WS_WUQ) + (size_t)l * 1536 * 512; t.K = QLORA; t.Kpad = 512; t.N = 1536; t.ldd = 512; break;
    case 8: t.src = F.in[I_WUKV] + (size_t)l * KVLORA * 2048; t.dst = (bf16_t*)(ws + WS_WUKV) + (size_t)l * 2048 * 256; t.K = KVLORA; t.Kpad = 256; t.N = 2048; t.ldd = 256; break;
    case 9: case 10: t.src = F.in[I_WUP] + ((size_t)l * 2 + (j - 9)) * 96 * AW; t.dst = (bf16_t*)(ws + WS_WLORA) + ((size_t)l * 5 + (j - 9)) * 1024 * 256; t.K = 96; t.Kpad = 256; t.N = AW; t.ldd = 256; break;
    case 11: case 12: t.src = F.in[I_AUP] + ((size_t)l * 2 + (j - 11)) * 96 * AW; t.dst = (bf16_t*)(ws + WS_WLORA) + ((size_t)l * 5 + 2 + (j - 11)) * 1024 * 256; t.K = 96; t.Kpad = 256; t.N = AW; t.ldd = 256; break;
    default: t.src = F.in[I_GUP] + (size_t)l * 256 * AW; t.dst = (bf16_t*)(ws + WS_WLORA) + ((size_t)l * 5 + 4) * 1024 * 256; t.K = 256; t.Kpad = 256; t.N = AW; t.ldd = 256; break;
    }
    return t;
}

__device__ __forceinline__ void transpose_job(const Frame& F, const TJob& J, int rot) {
    LAS float* tile = (LAS float*)F.lds;
    const int ntk = J.Kpad / 128, ntn = J.N / 64, ntiles = ntk * ntn;
    const int kr = F.tid >> 4, c4 = (F.tid & 15) * 4;
    const int sn = F.tid >> 3, k16 = (F.tid & 7) * 16;
    int start = F.bid - rot; if (start < 0) start += F.nb;
    f32x4 nx[4];
#define TJ_LOAD(ti_) do { const int tk_ = (ti_) / ntn, tn_ = (ti_) % ntn; \
        _Pragma("unroll") for (int it = 0; it < 4; ++it) { const int k = tk_ * 128 + kr + 32 * it; nx[it] = zero4v(); \
            if (k < J.K) nx[it] = *(const f32x4*)(J.src + (size_t)k * J.N + tn_ * 64 + c4); } } while (0)
    if (start < ntiles) TJ_LOAD(start);
    for (int ti = start; ti < ntiles; ti += F.nb) {
        const int tk = ti / ntn, tn = ti % ntn;
        f32x4 v[4];
#pragma unroll
        for (int it = 0; it < 4; ++it) v[it] = nx[it];
        if (ti + F.nb < ntiles) TJ_LOAD(ti + F.nb);
#pragma unroll
        for (int it = 0; it < 4; ++it) { LAS float* tp = tile + (kr + 32 * it) * 65 + c4; tp[0] = v[it][0]; tp[1] = v[it][1]; tp[2] = v[it][2]; tp[3] = v[it][3]; }
        lds_barrier();
        float e[16];
#pragma unroll
        for (int j = 0; j < 16; ++j) e[j] = tile[(k16 + j) * 65 + sn];
        u32x4 w0, w1; w0.x = cvt_pk_bf16(e[0], e[1]); w0.y = cvt_pk_bf16(e[2], e[3]); w0.z = cvt_pk_bf16(e[4], e[5]); w0.w = cvt_pk_bf16(e[6], e[7]);
        w1.x = cvt_pk_bf16(e[8], e[9]); w1.y = cvt_pk_bf16(e[10], e[11]); w1.z = cvt_pk_bf16(e[12], e[13]); w1.w = cvt_pk_bf16(e[14], e[15]);
        bf16_t* dp = J.dst + (size_t)(tn * 64 + sn) * J.ldd + tk * 128 + k16;
        *(u32x4*)dp = w0; *(u32x4*)(dp + 8) = w1;
        lds_barrier();
    }
#undef TJ_LOAD
}

__device__ __forceinline__ void p0_prologue(const Frame& F) {
    unsigned char* ws = F.ws;
    int rot = 0;
    for (int l = 0; l < DEPTH; ++l)
        for (int j = 0; j < 14; ++j) { const TJob J = make_job(F, l, j); transpose_job(F, J, rot); rot = (rot + ((J.Kpad / 128) * (J.N / 64)) % F.nb) % F.nb; }
    {
        LAS float* sv = (LAS float*)F.lds;
        LAS float* red = (LAS float*)(F.lds + 16384);
        for (int i = F.tid; i < 2 * D; i += NTHREADS) { const float x = (i < D) ? F.in[I_C][i] : F.in[I_CCTX][i - D]; sv[i] = x * sigmoidf_(x); }
        __syncthreads();
        const int cg = F.tid & 15, ks = F.tid >> 4;
        for (int u = F.bid; u < DEPTH * 192; u += F.nb) {
            const int l = u / 192, cb = (u % 192) * 64;
            const float* wp = F.in[I_ADAW] + (size_t)l * D * (6 * D) + cb + cg * 4;
            f32x4 a0 = zero4v(), a1 = a0;
#pragma unroll 4
            for (int k = ks; k < D; k += 32) { const f32x4 w = *(const f32x4*)(wp + (size_t)k * (6 * D)); a0 += w * sv[k]; a1 += w * sv[D + k]; }
            LAS float* rp = red + (ks * 16 + cg) * 8;
#pragma unroll
            for (int j = 0; j < 4; ++j) { rp[j] = a0[j]; rp[4 + j] = a1[j]; }
            __syncthreads();
            if (F.tid < 128) {
                const int g2 = F.tid >> 3, e = F.tid & 7; float s = 0.f;
#pragma unroll 8
                for (int q = 0; q < 32; ++q) s += red[(q * 16 + g2) * 8 + e];
                const int col = cb + g2 * 4 + (e & 3), sidx = e >> 2;
                ((float*)(ws + WS_MOD))[((size_t)l * 2 + sidx) * (6 * D) + col] = s + F.in[I_ADAB][(size_t)l * (6 * D) + col];
            }
            __syncthreads();
        }
    }
    {
        float* rt = (float*)(ws + WS_ROPE);
        for (int i = F.bid * NTHREADS + F.tid; i < SEQ * 32; i += F.nb * NTHREADS) {
            const int t = i >> 5, j = i & 31;
            const float inv = powf(10000.0f, -(float)(j & 15) / 16.0f);
            const float pos = (j < 16) ? (float)(t / GRIDW) : (float)(t % GRIDW);
            const float ang = pos * inv;
            rt[2 * i] = cosf(ang); rt[2 * i + 1] = sinf(ang);
        }
    }
    {
        float* lb = (float*)(ws + WS_LBIAS);
        for (int i = F.bid * NTHREADS + F.tid; i < DEPTH * 5 * AW; i += F.nb * NTHREADS) { const int l = i / (5 * AW), r = i % (5 * AW), grp = r / AW, c = r % AW;
            lb[i] = grp < 2 ? F.in[I_W0][((size_t)l * 2 + grp) * AW + c] : (grp < 4 ? F.in[I_A0][((size_t)l * 2 + grp - 2) * AW + c] : 0.f); }
        f32x4* X = (f32x4*)(ws + WS_X);
        const f32x4* x = (const f32x4*)F.in[I_X]; const f32x4* cx = (const f32x4*)F.in[I_CTX];
        const size_t n1 = (size_t)SEQ * D / 4, n2 = (size_t)CTXL * D / 4;
        for (size_t i = (size_t)F.bid * NTHREADS + F.tid; i < n1 + n2; i += (size_t)F.nb * NTHREADS) X[i] = (i < n1) ? x[i] : cx[i - n1];
        u32x4* z = (u32x4*)(ws + WS_LA); const size_t nz = (WS_KPE - WS_LA) / 16;
        for (size_t i = (size_t)F.bid * NTHREADS + F.tid; i < nz; i += (size_t)F.nb * NTHREADS) z[i] = __builtin_bit_cast(u32x4, zero4v());
    }
}

__device__ __forceinline__ void norm_phase(const Frame& F, int l, int which, const float* parts, int nparts) {
    float* X = (float*)(F.ws + WS_X); bf16_t* H = (bf16_t*)(F.ws + WS_H);
    const float* g = F.in[which ? I_NMLPG : I_NMIXG] + (size_t)l * D;
    const float* mod = (const float*)(F.ws + WS_MOD) + (size_t)l * 2 * 6 * D;
    f32x4 ga[8], sh[8];
#pragma unroll
    for (int i = 0; i < 8; ++i) { const int c = i * 256 + F.lane * 4; const float* m = mod + which * 3 * D;
        ga[i] = *(const f32x4*)(g + c) * (*(const f32x4*)(m + D + c) + 1.0f); sh[i] = *(const f32x4*)(m + c); }
    bool ctxp = false;
    const int row0 = F.bid * 8 + F.wave, rstep = F.nb * 8;
    f32x4 nx[8];
    if (row0 < MROWS) {
#pragma unroll
        for (int i = 0; i < 8; ++i) nx[i] = *(const f32x4*)(X + (size_t)row0 * D + i * 256 + F.lane * 4);
    }
    for (int row = row0; row < MROWS; row += rstep) {
        float* xr = X + (size_t)row * D;
        f32x4 v[8]; float ss = 0.f;
#pragma unroll
        for (int i = 0; i < 8; ++i) v[i] = nx[i];
        if (row + rstep < MROWS) {
#pragma unroll
            for (int i = 0; i < 8; ++i) nx[i] = *(const f32x4*)(xr + (size_t)rstep * D + i * 256 + F.lane * 4);
        }
        if (row >= SEQ) {
            if (!ctxp) { ctxp = true; const float* m = mod + 6 * D + which * 3 * D;
#pragma unroll
                for (int i = 0; i < 8; ++i) { const int c = i * 256 + F.lane * 4; ga[i] = *(const f32x4*)(g + c) * (*(const f32x4*)(m + D + c) + 1.0f); sh[i] = *(const f32x4*)(m + c); } }
            if (nparts > 0) {
                const float* pp = parts + (size_t)(row - SEQ) * D + F.lane * 4;
                for (int s = 0; s < nparts; ++s) {
#pragma unroll
                    for (int i = 0; i < 8; ++i) v[i] += *(const f32x4*)(pp + (size_t)s * CTXL * D + i * 256);
                }
#pragma unroll
                for (int i = 0; i < 8; ++i) *(f32x4*)(xr + i * 256 + F.lane * 4) = v[i];
            }
        }
#pragma unroll
        for (int i = 0; i < 8; ++i) ss += v[i][0] * v[i][0] + v[i][1] * v[i][1] + v[i][2] * v[i][2] + v[i][3] * v[i][3];
        ss = wave_sum(ss, F.lane);
        const float rstd = rsqrtf(ss * (1.0f / D) + RMS_EPS);
#pragma unroll
        for (int i = 0; i < 8; ++i) {
            const f32x4 h = (v[i] * rstd) * ga[i] + sh[i];
            u32x2 w; w.x = cvt_pk_bf16(h[0], h[1]); w.y = cvt_pk_bf16(h[2], h[3]);
            *(u32x2*)(H + (size_t)row * D + i * 256 + F.lane * 4) = w;
        }
    }
}

__device__ __forceinline__ void final_norm_phase(const Frame& F) {
    const float* X = (const float*)(F.ws + WS_X); const float* g = F.in[I_FNG];
    for (int row = F.bid * 8 + F.wave; row < SEQ; row += F.nb * 8) {
        const float* xr = X + (size_t)row * D;
        f32x4 v[8]; float ss = 0.f;
#pragma unroll
        for (int i = 0; i < 8; ++i) { v[i] = *(const f32x4*)(xr + i * 256 + F.lane * 4); ss += v[i][0] * v[i][0] + v[i][1] * v[i][1] + v[i][2] * v[i][2] + v[i][3] * v[i][3]; }
        ss = wave_sum(ss, F.lane);
        const float rstd = rsqrtf(ss * (1.0f / D) + RMS_EPS);
#pragma unroll
        for (int i = 0; i < 8; ++i) { const int c = i * 256 + F.lane * 4; *(f32x4*)(F.out + (size_t)row * D + c) = (v[i] * rstd) * *(const f32x4*)(g + c); }
    }
}

__device__ __forceinline__ void prep1_phase(const Frame& F, int l) {
    unsigned char* ws = F.ws;
    const bf16_t* U = (const bf16_t*)(ws + WS_U);
    float* Rf = (float*)(ws + WS_RF); float* Kf = (float*)(ws + WS_KF); float* Vf = (float*)(ws + WS_VF);
    bf16_t* LA = (bf16_t*)(ws + WS_LA); bf16_t* QL = (bf16_t*)(ws + WS_QL); bf16_t* KVL = (bf16_t*)(ws + WS_KVL); bf16_t* KC = (bf16_t*)(ws + WS_KC);
    const float* conv = F.in[I_CONV] + (size_t)l * 3 * RWKV_COLS;
    const float* qg = F.in[I_QNG] + (size_t)l * QLORA; const float* kvg = F.in[I_KVNG] + (size_t)l * KVLORA;
    const float* rope = (const float*)(ws + WS_ROPE);
    const u32x4 zero4 = __builtin_bit_cast(u32x4, zero4v());
    LAS float* cw = (LAS float*)F.lds;
    __syncthreads();
    for (int i = F.tid; i < 3 * RWKV_COLS / 4; i += NTHREADS) *(LAS f32x4*)(cw + 4 * i) = *(const f32x4*)(conv + 4 * i);
    __syncthreads();
    for (int row = F.bid * 8 + F.wave; row < MROWS; row += F.nb * 8) {
        const bool lat = row < SEQ; const int rr = lat ? row : row - SEQ, slen = lat ? SEQ : CTXL;
        const bool hp = rr > 0, hn = rr < slen - 1;
        const bf16_t* uc = U + (size_t)row * IN_COLS;
        u32x4 wc_[8], wp_[8], wn_[8];
#pragma unroll
        for (int it = 0; it < 8; ++it) {
            const int gi = it * 64 + F.lane, col = (gi < RWKV_COLS / 8 ? gi : 0) * 8;
            wc_[it] = *(const u32x4*)(uc + col);
            wp_[it] = hp ? *(const u32x4*)(uc - IN_COLS + col) : zero4;
            wn_[it] = hn ? *(const u32x4*)(uc + IN_COLS + col) : zero4;
        }
        asm volatile("" ::: "memory");
#pragma unroll
        for (int it = 0; it < 8; ++it) {
            const int gi = it * 64 + F.lane;
            if (gi < RWKV_COLS / 8) {
                const int col = gi * 8;
                float c[8], p[8], n[8], o[8]; unpack8(wc_[it], c); unpack8(wp_[it], p); unpack8(wn_[it], n);
                const f32x4 k0a = *(const LAS f32x4*)(cw + col), k0b = *(const LAS f32x4*)(cw + col + 4);
                const f32x4 k1a = *(const LAS f32x4*)(cw + RWKV_COLS + col), k1b = *(const LAS f32x4*)(cw + RWKV_COLS + col + 4);
                const f32x4 k2a = *(const LAS f32x4*)(cw + 2 * RWKV_COLS + col), k2b = *(const LAS f32x4*)(cw + 2 * RWKV_COLS + col + 4);
#pragma unroll
                for (int j = 0; j < 4; ++j) { o[j] = k0a[j] * p[j] + k1a[j] * c[j] + k2a[j] * n[j]; o[4 + j] = k0b[j] * p[4 + j] + k1b[j] * c[4 + j] + k2b[j] * n[4 + j]; }
                if (it < 6) {
                    float* dst = (it < 2 ? Rf : (it < 4 ? Kf : Vf)) + (size_t)row * AW + (it & 1) * 512 + F.lane * 8;
                    *(f32x4*)dst = (f32x4){o[0], o[1], o[2], o[3]}; *(f32x4*)(dst + 4) = (f32x4){o[4], o[5], o[6], o[7]};
                } else if (col < 3264) {
                    const int d = (col - 3072) >= 96 ? 1 : 0, cc = (col - 3072) - 96 * d;
#pragma unroll
                    for (int j = 0; j < 8; ++j) o[j] = tanhf(o[j]);
                    *(u32x4*)(LA + ((size_t)d * MROWS + row) * 256 + cc) = pack8(o);
                } else if (col < 3456) {
                    const int d = (col - 3264) >= 96 ? 1 : 0, cc = (col - 3264) - 96 * d;
                    *(u32x4*)(LA + ((size_t)(2 + d) * MROWS + row) * 256 + cc) = pack8(o);
                } else {
#pragma unroll
                    for (int j = 0; j < 8; ++j) o[j] = sigmoidf_(o[j]);
                    *(u32x4*)(LA + ((size_t)4 * MROWS + row) * 256 + (col - 3456)) = pack8(o);
                }
            }
        }
        {
            float x[8]; float ss = 0.f;
            if (F.lane < 56) { unpack8(*(const u32x4*)(uc + MLA_OFF + F.lane * 8), x);
#pragma unroll
                for (int j = 0; j < 8; ++j) ss += x[j] * x[j]; }
            ss = wave_sum(ss, F.lane);
            const float rstd = rsqrtf(ss * (1.0f / QLORA) + RMS_EPS);
            if (F.lane < 56) {
#pragma unroll
                for (int j = 0; j < 8; ++j) x[j] = x[j] * rstd * qg[F.lane * 8 + j];
                *(u32x4*)(QL + (size_t)row * 512 + F.lane * 8) = pack8(x);
            }
            float y[8]; float s2 = 0.f;
            if (F.lane < 16) { unpack8(*(const u32x4*)(uc + MLA_OFF + QLORA + F.lane * 8), y);
#pragma unroll
                for (int j = 0; j < 8; ++j) s2 += y[j] * y[j]; }
            s2 = wave_sum(s2, F.lane);
            const float rstd2 = rsqrtf(s2 * (1.0f / KVLORA) + RMS_EPS);
            if (F.lane < 16) {
#pragma unroll
                for (int j = 0; j < 8; ++j) y[j] = y[j] * rstd2 * kvg[F.lane * 8 + j];
                *(u32x4*)(KVL + (size_t)row * 256 + F.lane * 8) = pack8(y);
            }
        }
        {
            const float xv = bf2f(uc[MLA_OFF + QLORA + KVLORA + F.lane]);
            const float pv = shx(xv, 16, F.lane);
            float o = xv;
            if (lat) {
                const int ai = (F.lane < 32 ? 0 : 16) + (F.lane & 15);
                const float cs = rope[((size_t)row * 32 + ai) * 2], sn = rope[((size_t)row * 32 + ai) * 2 + 1];
                o = ((F.lane & 16) == 0) ? (xv * cs - pv * sn) : (pv * sn + xv * cs);
            }
            const bf16_t ob = f2bf(o);
#pragma unroll
            for (int hh = 0; hh < 8; ++hh) KC[(size_t)row * 1536 + hh * 192 + 128 + F.lane] = ob;
        }
    }
}

constexpr int SC_TC = 32;
constexpr int SC_STEP_FLOATS = 6 * 64;
constexpr int SC_BUF_BYTES = SC_TC * SC_STEP_FLOATS * 4;
constexpr int SC_CS_OFF = 2 * SC_BUF_BYTES;
constexpr int SC_Y_OFF = SC_CS_OFF + 2 * SC_TC * 2 * 4;

__device__ __forceinline__ float dpp_allsum16(float x) {
    x += __int_as_float(__builtin_amdgcn_update_dpp(0, __float_as_int(x), 0xB1, 0xF, 0xF, true));
    x += __int_as_float(__builtin_amdgcn_update_dpp(0, __float_as_int(x), 0x4E, 0xF, 0xF, true));
    x += __int_as_float(__builtin_amdgcn_update_dpp(0, __float_as_int(x), 0x141, 0xF, 0xF, true));
    x += __int_as_float(__builtin_amdgcn_update_dpp(0, __float_as_int(x), 0x140, 0xF, 0xF, true));
    return x;
}

__device__ __forceinline__ int scan_row(int dir, int s) {
    if (dir == 0) return s < CTXL ? SEQ + s : s - CTXL;
    return s < CTXL ? SEQ + (CTXL - 1) - s : (SEQ - 1) - (s - CTXL);
}

__device__ __forceinline__ void readout_phase(const Frame& F, int l) {
    unsigned char* ws = F.ws;
    const float* Rf = (const float*)(ws + WS_RF); const float* Kf = (const float*)(ws + WS_KF); const float* Vf = (const float*)(ws + WS_VF);
    const float* A0 = (const float*)(ws + WS_AD); const float* A1 = A0 + (size_t)MROWS * AW;
    const float* Y0 = (const float*)(ws + WS_Y); const float* Y1 = Y0 + (size_t)MROWS * AW;
    const float* G = (const float*)(ws + WS_G);
    bf16_t* YC = (bf16_t*)(ws + WS_YCAT);
    const float* lng = F.in[I_LNG] + (size_t)l * AW; const float* lnb = F.in[I_LNB] + (size_t)l * AW;
    const float* ka = F.in[I_KA] + (size_t)l * AW; const float* rk = F.in[I_RK] + (size_t)l * AW;
    for (int it = F.bid * 8 + F.wave; it < MROWS * 16; it += F.nb * 8) {
        const int row = it >> 4, head = it & 15, c = head * 64 + F.lane;
        const size_t o = (size_t)row * AW + c;
        const float y = Y0[o] + Y1[o];
        const float mu = wave_sum(y, F.lane) * (1.0f / 64.0f);
        const float dv = y - mu;
        const float var = wave_sum(dv * dv, F.lane) * (1.0f / 64.0f);
        const float yn = dv * rsqrtf(var + GN_EPS) * lng[c] + lnb[c];
        const float k = Kf[o], kac = ka[c];
        const float kmean = 0.5f * (k * (1.0f + (sigmoidf_(A0[o]) - 1.0f) * kac) + k * (1.0f + (sigmoidf_(A1[o]) - 1.0f) * kac));
        const float bsum = wave_sum(Rf[o] * kmean * rk[c], F.lane);
        const float outv = (yn + bsum * Vf[o]) * G[o];
        YC[(size_t)row * 3072 + c] = f2bf(outv);
    }
}

constexpr float NEG_BIG = -1.0e30f;
__device__ __forceinline__ float fexp2(float x) { return __builtin_amdgcn_exp2f(x); }
__device__ __forceinline__ bf16x8 tr_pair(const LAS unsigned char* p0, const LAS unsigned char* p1) {
    const bf16x4 a = __builtin_amdgcn_ds_read_tr16_b64_v4i16((LAS bf16x4*)p0), b = __builtin_amdgcn_ds_read_tr16_b64_v4i16((LAS bf16x4*)p1);
    return (bf16x8){a[0], a[1], a[2], a[3], b[0], b[1], b[2], b[3]};
}
template <int NKS> __device__ __forceinline__ void sm_update(f32x4 (&s)[NKS], float& m, float& l, float& alpha, int lane, float sc) {
    float mx = fmaxf(fmaxf(s[0][0], s[0][1]), fmaxf(s[0][2], s[0][3]));
#pragma unroll
    for (int k = 1; k < NKS; ++k) mx = fmaxf(fmaxf(mx, s[k][0]), fmaxf(fmaxf(s[k][1], s[k][2]), s[k][3]));
    mx = rows_max(mx);
    const float mn = fmaxf(m, mx * sc); alpha = fexp2(m - mn); m = mn;
    float sum = 0.f;
#pragma unroll
    for (int k = 0; k < NKS; ++k) {
#pragma unroll
        for (int j = 0; j < 4; ++j) { const float p = fexp2(__builtin_fmaf(s[k][j], sc, -mn)); s[k][j] = p; sum += p; } }
    l = l * alpha + sum;
}
__device__ __forceinline__ bf16x8 pack_p(const f32x4 a, const f32x4 b) {
    u32x4 w; w.x = cvt_pk_bf16(a[0], a[1]); w.y = cvt_pk_bf16(a[2], a[3]); w.z = cvt_pk_bf16(b[0], b[1]); w.w = cvt_pk_bf16(b[2], b[3]);
    return __builtin_bit_cast(bf16x8, w);
}

constexpr int MA_KSTR = 416, MA_VSTR = 288, MA_KBUF = 64 * MA_KSTR, MA_VBUF = 64 * MA_VSTR;
constexpr int MA_K_OFF = 0, MA_V_OFF = 3 * MA_KBUF;
static_assert(MA_V_OFF + 3 * MA_VBUF <= LDS_BAR_OFF - 64, "MLA LDS map");

__device__ __forceinline__ void mla_unit(const Frame& F, int h, int q0, int key0, int ntiles) {
    unsigned char* ws = F.ws;
    const bf16_t* Q = (const bf16_t*)(ws + WS_Q); const bf16_t* KC = (const bf16_t*)(ws + WS_KC); const bf16_t* VC = (const bf16_t*)(ws + WS_VC);
    const float* rope = (const float*)(ws + WS_ROPE);
    bf16_t* YC = (bf16_t*)(ws + WS_YCAT);
    const int qi = F.lane & 15, g = F.lane >> 4;
    constexpr float SC = 0.07216878364870322f * LOG2E;
    bf16x8 Qf[2][6];
#pragma unroll
    for (int qs = 0; qs < 2; ++qs) {
        const int qr = q0 + F.wave * 32 + qs * 16 + qi;
        const bf16_t* qp = Q + (size_t)qr * 1536 + h * QHD;
#pragma unroll
        for (int kk = 0; kk < 4; ++kk) Qf[qs][kk] = *(const bf16x8*)(qp + 32 * kk + 8 * g);
#pragma unroll
        for (int kk = 4; kk < 6; ++kk) {
            const int d0 = 32 * kk + 8 * g;
            const u32x4 own = *(const u32x4*)(qp + d0);
            if (qr < SEQ) {
                const u32x4 par = *(const u32x4*)(qp + d0 + ((g < 2) ? 16 : -16));
                float xo[8], xp[8], o[8]; unpack8(own, xo); unpack8(par, xp);
                const float* rp = rope + ((size_t)qr * 32 + (kk - 4) * 16 + 8 * (g & 1)) * 2;
#pragma unroll
                for (int j = 0; j < 8; ++j) { const float cs = rp[2 * j], sn = rp[2 * j + 1]; o[j] = (g < 2) ? (xo[j] * cs - xp[j] * sn) : (xp[j] * sn + xo[j] * cs); }
                Qf[qs][kk] = __builtin_bit_cast(bf16x8, pack8(o));
            } else Qf[qs][kk] = __builtin_bit_cast(bf16x8, own);
        }
    }
    f32x4 O[2][8];
#pragma unroll
    for (int qs = 0; qs < 2; ++qs)
#pragma unroll
        for (int dt = 0; dt < 8; ++dt) O[qs][dt] = zero4v();
    float m[2] = {NEG_BIG, NEG_BIG}, l[2] = {0.f, 0.f};
    unsigned ko[4], vo[3];
#pragma unroll
    for (int i = 0; i < 4; ++i) { const int sl = ((i < 3) ? (F.wave + 8 * i) : (24 + (F.wave & 1))) * 64 + F.lane, key = sl / 26, part = sl - key * 26;
        ko[i] = (unsigned)((key0 + key) * 1536 + h * 192 + ((part < 24) ? part : 0) * 8) * 2u; }
#pragma unroll
    for (int i = 0; i < 3; ++i) { const int sl = ((i < 2) ? (F.wave + 8 * i) : (16 + (F.wave & 1))) * 64 + F.lane, key = sl / 18, part = sl - key * 18;
        vo[i] = (unsigned)((key0 + key) * 1024 + h * 128 + ((part < 16) ? part : 0) * 8) * 2u; }
    const __amdgpu_buffer_rsrc_t rK = __builtin_amdgcn_make_buffer_rsrc((void*)KC, 0, 0x7ffffff0, 0x00020000), rV = __builtin_amdgcn_make_buffer_rsrc((void*)VC, 0, 0x7ffffff0, 0x00020000);
#define MLA_DMA(t_, slot_) do { const int ks_ = (t_) * (64 * 1536 * 2), vs_ = (t_) * (64 * 1024 * 2);        \
        LAS unsigned char* kb_ = F.lds + MA_K_OFF + (slot_) * MA_KBUF; LAS unsigned char* vb_ = F.lds + MA_V_OFF + (slot_) * MA_VBUF; \
        _Pragma("unroll") for (int i = 0; i < 3; ++i) __builtin_amdgcn_raw_ptr_buffer_load_lds(rK, (LAS void*)(kb_ + (F.wave + 8 * i) * 1024), 16, ko[i], ks_, 0, 0); \
        if (F.wave >= 6) __builtin_amdgcn_raw_ptr_buffer_load_lds(rK, (LAS void*)(kb_ + (24 + (F.wave & 1)) * 1024), 16, ko[3], ks_, 0, 0); \
        _Pragma("unroll") for (int i = 0; i < 2; ++i) __builtin_amdgcn_raw_ptr_buffer_load_lds(rV, (LAS void*)(vb_ + (F.wave + 8 * i) * 1024), 16, vo[i], vs_, 0, 0); \
        if (F.wave == 4 || F.wave == 5) __builtin_amdgcn_raw_ptr_buffer_load_lds(rV, (LAS void*)(vb_ + (16 + (F.wave & 1)) * 1024), 16, vo[2], vs_, 0, 0); } while (0)
    __syncthreads();
    MLA_DMA(0, 0); MLA_DMA(1, 1);
    asm volatile("s_waitcnt vmcnt(0)" ::: "memory");
    lds_barrier();
    const int krd = qi * MA_KSTR + 16 * g;
    const int vrd = (4 * g + (qi >> 2)) * MA_VSTR + (qi & 3) * 8;
    f32x4 s[2][4];
#define MLA_H1(slot_) do { const LAS unsigned char* kb = F.lds + MA_K_OFF + (slot_) * MA_KBUF; \
        _Pragma("unroll") for (int ks = 0; ks < 4; ++ks) { s[0][ks] = zero4v(); s[1][ks] = zero4v(); \
            _Pragma("unroll") for (int kk = 0; kk < 6; ++kk) { const bf16x8 kf = *(const LAS bf16x8*)(kb + krd + ks * 16 * MA_KSTR + kk * 64); \
                s[0][ks] = __builtin_amdgcn_mfma_f32_16x16x32_bf16(kf, Qf[0][kk], s[0][ks], 0, 0, 0); \
                s[1][ks] = __builtin_amdgcn_mfma_f32_16x16x32_bf16(kf, Qf[1][kk], s[1][ks], 0, 0, 0); } } } while (0)
#define MLA_H2(slot_) do { const LAS unsigned char* vb = F.lds + MA_V_OFF + (slot_) * MA_VBUF; \
        bf16x8 P[2][2]; \
        _Pragma("unroll") for (int qs = 0; qs < 2; ++qs) { \
            float alpha; sm_update<4>(s[qs], m[qs], l[qs], alpha, F.lane, SC); \
            if (__builtin_amdgcn_ballot_w64(alpha != 1.0f) != 0ull) {        \
                _Pragma("unroll") for (int dt = 0; dt < 8; ++dt) O[qs][dt] = O[qs][dt] * alpha; } \
            P[qs][0] = pack_p(s[qs][0], s[qs][1]); P[qs][1] = pack_p(s[qs][2], s[qs][3]); } \
        _Pragma("unroll") for (int kst = 0; kst < 2; ++kst) { \
            _Pragma("unroll") for (int dt = 0; dt < 8; ++dt) { const LAS unsigned char* vp = vb + vrd + kst * 32 * MA_VSTR + dt * 32; \
                const bf16x8 vf = tr_pair(vp, vp + 16 * MA_VSTR); \
                O[0][dt] = __builtin_amdgcn_mfma_f32_16x16x32_bf16(vf, P[0][kst], O[0][dt], 0, 0, 0); \
                O[1][dt] = __builtin_amdgcn_mfma_f32_16x16x32_bf16(vf, P[1][kst], O[1][dt], 0, 0, 0); } } } while (0)
    int sc = 0, sn2 = 2;
    for (int t = 0; t < ntiles; ++t) {
        if (t + 2 < ntiles) MLA_DMA(t + 2, sn2);
        MLA_H1(sc);
        MLA_H2(sc);
        if (t + 2 < ntiles) { if (F.wave < 4) asm volatile("s_waitcnt vmcnt(5)" ::: "memory"); else asm volatile("s_waitcnt vmcnt(6)" ::: "memory"); }
        else asm volatile("s_waitcnt vmcnt(0)" ::: "memory");
        lds_barrier();
        sc = (sc == 2) ? 0 : sc + 1; sn2 = (sn2 == 2) ? 0 : sn2 + 1;
    }
#undef MLA_H1
#undef MLA_H2
#undef MLA_DMA
#pragma unroll
    for (int qs = 0; qs < 2; ++qs) {
        const float lt = rows_sum(l[qs]);
        const float inv = 1.0f / lt;
        const int qr = q0 + F.wave * 32 + qs * 16 + qi;
        bf16_t* op = YC + (size_t)qr * 3072 + 1024 + h * VDIM + 4 * g;
#pragma unroll
        for (int dt = 0; dt < 8; ++dt) { const f32x4 o = O[qs][dt] * inv; u32x2 w; w.x = cvt_pk_bf16(o[0], o[1]); w.y = cvt_pk_bf16(o[2], o[3]); *(u32x2*)(op + dt * 16) = w; }
    }
}

constexpr int NA_KSTR = 288, NA_VSTR = 288, NA_KBUF = 64 * NA_KSTR, NA_VBUF = 64 * NA_VSTR;
constexpr int NA_K_OFF = 0, NA_V_OFF = 3 * NA_KBUF, NA_RPB_OFF = NA_V_OFF + 3 * NA_VBUF;
static_assert(NA_RPB_OFF + 4096 <= LDS_BAR_OFF - 64, "NA LDS map");

__device__ __forceinline__ void na_unit(const Frame& F, int l, int gi, int hp) {
    unsigned char* ws = F.ws;
    const bf16_t* U = (const bf16_t*)(ws + WS_U);
    bf16_t* YC = (bf16_t*)(ws + WS_YCAT);
    const int qi = F.lane & 15, g = F.lane >> 4, g4 = F.wave & 3, hh = F.wave >> 2, h = hp * 2 + hh;
    const bool lat = gi < 128;
    const int r0 = lat ? min(max(gi - 4, 0), 120) : 0;
    const int np = lat ? 12 : 4;
    const int qr = (lat ? gi * 64 : SEQ + (gi - 128) * 64) + 16 * g4 + qi;
    constexpr float SC = 0.125f * LOG2E;
    bf16x8 Qf[2];
#pragma unroll
    for (int kk = 0; kk < 2; ++kk) Qf[kk] = *(const bf16x8*)(U + (size_t)qr * IN_COLS + NA_OFF + h * 64 + 32 * kk + 8 * g);
    f32x4 O[4];
#pragma unroll
    for (int dt = 0; dt < 4; ++dt) O[dt] = zero4v();
    float m = NEG_BIG, lsum = 0.f;
    unsigned ko[3], vo[3];
#pragma unroll
    for (int i = 0; i < 3; ++i) { const int sl = ((i < 2) ? (F.wave + 8 * i) : (16 + (F.wave & 1))) * 64 + F.lane, key = sl / 18, part = sl - key * 18;
        const unsigned e = (unsigned)(key * IN_COLS + NA_OFF + hp * 128 + ((part < 16) ? part : 0) * 8);
        ko[i] = (e + 1024u) * 2u; vo[i] = (e + 2048u) * 2u; }
    const __amdgpu_buffer_rsrc_t rU = __builtin_amdgcn_make_buffer_rsrc((void*)U, 0, 0x7ffffff0, 0x00020000);
#define NA_PIECE_ROW(p) ((lat && (p) < 8) ? (r0 + (p)) * 64 : SEQ + ((p) - (lat ? 8 : 0)) * 64)
#define NA_DMA(p_, slot_) do { const int so_ = NA_PIECE_ROW(p_) * (IN_COLS * 2); \
        LAS unsigned char* kb_ = F.lds + NA_K_OFF + (slot_) * NA_KBUF; LAS unsigned char* vb_ = F.lds + NA_V_OFF + (slot_) * NA_VBUF; \
        _Pragma("unroll") for (int i = 0; i < 2; ++i) { __builtin_amdgcn_raw_ptr_buffer_load_lds(rU, (LAS void*)(kb_ + (F.wave + 8 * i) * 1024), 16, ko[i], so_, 0, 0); \
            __builtin_amdgcn_raw_ptr_buffer_load_lds(rU, (LAS void*)(vb_ + (F.wave + 8 * i) * 1024), 16, vo[i], so_, 0, 0); } \
        if (F.wave < 2) { __builtin_amdgcn_raw_ptr_buffer_load_lds(rU, (LAS void*)(kb_ + (16 + F.wave) * 1024), 16, ko[2], so_, 0, 0); \
            __builtin_amdgcn_raw_ptr_buffer_load_lds(rU, (LAS void*)(vb_ + (16 + F.wave) * 1024), 16, vo[2], so_, 0, 0); } } while (0)
    __syncthreads();
    if (lat) { LAS float* rp = (LAS float*)(F.lds + NA_RPB_OFF); const float* src = F.in[I_RPB] + ((size_t)l * 16 + hp * 2) * 465;
        for (int i = F.tid; i < 930; i += NTHREADS) rp[i] = src[i] * LOG2E; }
    NA_DMA(0, 0); NA_DMA(1, 1);
    asm volatile("s_waitcnt vmcnt(0)" ::: "memory");
    lds_barrier();
    const int c0 = (g4 == 0) ? 0 : (g4 == 1 ? 8 : (g4 == 2 ? 24 : 32));
    const int qc = 16 * g4 + qi, cs_ = min(max(qc - 8, 0), 48);
    const int krd = qi * NA_KSTR + hh * 128 + 16 * g;
    const int vrd = (4 * g + (qi >> 2)) * NA_VSTR + hh * 128 + (qi & 3) * 8;
    const LAS float* rpb = (const LAS float*)(F.lds + NA_RPB_OFF) + hh * 465;
    int sc = 0, sn2 = 2;
    for (int p = 0; p < np; ++p) {
        if (p + 2 < np) NA_DMA(p + 2, sn2);
        const LAS unsigned char* kb = F.lds + NA_K_OFF + sc * NA_KBUF;
        const LAS unsigned char* vb = F.lds + NA_V_OFF + sc * NA_VBUF;
        const bool win = lat && p < 8;
        const int ntl = win ? 1 : 2;
        for (int tl = 0; tl < ntl; ++tl) {
            const int kbase = win ? c0 : tl * 32;
            f32x4 s[2];
#pragma unroll
            for (int ks = 0; ks < 2; ++ks) {
                s[ks] = zero4v();
#pragma unroll
                for (int kk = 0; kk < 2; ++kk) {
                    const bf16x8 kf = *(const LAS bf16x8*)(kb + krd + (kbase + ks * 16) * NA_KSTR + kk * 64);
                    s[ks] = __builtin_amdgcn_mfma_f32_16x16x32_bf16(kf, Qf[kk], s[ks], 0, 0, 0);
                }
            }
            if (win) {
                const int dr = (r0 + p) - gi + 7;
#pragma unroll
                for (int ks = 0; ks < 2; ++ks)
#pragma unroll
                    for (int j = 0; j < 4; ++j) {
                        const int cc = c0 + 16 * ks + 4 * g + j, rel = cc - cs_;
                        const bool valid = (rel >= 0) && (rel < 16);
                        const int bi = min(max(cc - qc + 15, 0), 30);
                        const float bias = rpb[dr * 31 + bi];
                        s[ks][j] = valid ? (s[ks][j] * SC + bias) : NEG_BIG;
                    }
            } else {
#pragma unroll
                for (int ks = 0; ks < 2; ++ks) s[ks] = s[ks] * SC;
            }
            float alpha; sm_update<2>(s, m, lsum, alpha, F.lane, 1.0f);
#pragma unroll
            for (int dt = 0; dt < 4; ++dt) O[dt] = O[dt] * alpha;
            const bf16x8 P = pack_p(s[0], s[1]);
#pragma unroll
            for (int dt = 0; dt < 4; ++dt) {
                const LAS unsigned char* vp = vb + vrd + kbase * NA_VSTR + dt * 32;
                const bf16x8 vf = tr_pair(vp, vp + 16 * NA_VSTR);
                O[dt] = __builtin_amdgcn_mfma_f32_16x16x32_bf16(vf, P, O[dt], 0, 0, 0);
            }
        }
        if (p + 2 < np) { if (F.wave < 2) asm volatile("s_waitcnt vmcnt(6)" ::: "memory"); else asm volatile("s_waitcnt vmcnt(4)" ::: "memory"); }
        else asm volatile("s_waitcnt vmcnt(0)" ::: "memory");
        lds_barrier();
        sc = (sc == 2) ? 0 : sc + 1; sn2 = (sn2 == 2) ? 0 : sn2 + 1;
    }
#undef NA_DMA
#undef NA_PIECE_ROW
    const float lt = rows_sum(lsum);
    const float inv = 1.0f / lt;
    bf16_t* op = YC + (size_t)qr * 3072 + 2048 + h * 64 + 4 * g;
#pragma unroll
    for (int dt = 0; dt < 4; ++dt) { const f32x4 o = O[dt] * inv; u32x2 w; w.x = cvt_pk_bf16(o[0], o[1]); w.y = cvt_pk_bf16(o[2], o[3]); *(u32x2*)(op + dt * 16) = w; }
}

__device__ __forceinline__ void attn_phase(const Frame& F, int l, int flags) {
    if (!(flags & 2)) {
        for (int u = F.bid; u < 256; u += F.nb) mla_unit(F, u & 7, (u >> 3) * 256, 0, MROWS / 64);
        for (int v = F.nb - 1 - F.bid; v < 8; v += F.nb) mla_unit(F, v, SEQ, SEQ, CTXL / 64);
    }
    if (!(flags & 4)) {
        unsigned* q = (unsigned*)(F.ws + WS_CTL) + 8192 + l * 64;
        volatile LAS unsigned* slot = (volatile LAS unsigned*)(F.lds + LDS_BAR_OFF - 64);
        for (;;) {
            __syncthreads();
            if (F.tid == 0) *slot = __hip_atomic_fetch_add(q, 1u, __ATOMIC_RELAXED, __HIP_MEMORY_SCOPE_AGENT);
            __syncthreads();
            const int u = (int)*slot;
            if (u >= 1056) break;
            na_unit(F, l, u >> 3, u & 7);
        }
    }
}

constexpr int CH_NCH = MROWS / 64;
constexpr int CH_NTASK = 32 * CH_NCH;
constexpr int CS = 144;
constexpr int CF = 68;
constexpr int CIMG = 64 * CS;
constexpr int O_KT = 0, O_RT = CIMG, O_BH = 2 * CIMG, O_KH = 3 * CIMG, O_V = 4 * CIMG, O_BB = 5 * CIMG  , O_KB = 6 * CIMG  ,
              O_AAK = 7 * CIMG  , O_ARB = 8 * CIMG, O_ARK = 9 * CIMG, O_T = 10 * CIMG, O_AF = 11 * CIMG, O_TF = O_AF + 64 * CF * 4, O_TOT = O_TF + 64 * CF * 4,
              O_GL = O_TOT + 8 * 64 * 4, O_CHEND = O_GL + 256;
static_assert(O_CHEND <= LDS_BAR_OFF, "chunk LDS map");

__device__ __forceinline__ bf16x8 ch_rowread(const LAS unsigned char* img, int tile, int ks, int qi, int g) {
    return *(const LAS bf16x8*)(img + (16 * tile + qi) * CS + (32 * ks + 8 * g) * 2);
}
__device__ __forceinline__ bf16x8 ch_trread(const LAS unsigned char* img, int tile, int ks, int qi, int g) {
    const LAS unsigned char* p = img + (32 * ks + 8 * g + (qi >> 2)) * CS + (16 * tile + 4 * (qi & 3)) * 2;
    return tr_pair(p, p + 4 * CS);
}
__device__ __forceinline__ void ch_store_bf16(LAS unsigned char* img, int tr, int tc, int qi, int g, const f32x4 v) {
#pragma unroll
    for (int jj = 0; jj < 4; ++jj) *(LAS bf16_t*)(img + (16 * tr + 4 * g + jj) * CS + (16 * tc + qi) * 2) = f2bf(v[jj]);
}
#define MFMA_BF(a, b, c) __builtin_amdgcn_mfma_f32_16x16x32_bf16(a, b, c, 0, 0, 0)
#define MFMA_F32(a, b, c) __builtin_amdgcn_mfma_f32_16x16x4f32(a, b, c, 0, 0, 0)

__device__ __forceinline__ void rwkvA_phase(const Frame& F, int l) {
    unsigned char* ws = F.ws;
    const float* Rf = (const float*)(ws + WS_RF); const float* Kf = (const float*)(ws + WS_KF); const float* Vf = (const float*)(ws + WS_VF);
    float* MN = (float*)(ws + WS_MN); bf16_t* RY = (bf16_t*)(ws + WS_RY);
    const int qi = F.lane & 15, g = F.lane >> 4, tr = F.wave >> 1, tcb = (F.wave & 1) * 2;
    LAS unsigned char* L = F.lds;
    LAS float* Af = (LAS float*)(L + O_AF); LAS float* Tf = (LAS float*)(L + O_TF); LAS float* tot = (LAS float*)(L + O_TOT); LAS float* gL = (LAS float*)(L + O_GL);
    float pk_[8], pv_[8], pr_[8], pza_[8], pzw_[8];
#define RA_LOAD(task_) do { const int hd_ = (task_) / CH_NCH, c_ = (task_) - hd_ * CH_NCH, dir_ = hd_ & 1; \
        const size_t o0_ = (size_t)scan_row(dir_, c_ * 64 + F.wave * 8) * AW + (hd_ >> 1) * 64 + F.lane; const int ds_ = dir_ ? -AW : AW;        \
        const float* kp_ = Kf + o0_; const float* vp_ = Vf + o0_; const float* rp_ = Rf + o0_; \
        const float* zw_ = (const float*)(ws + WS_WD) + (size_t)dir_ * MROWS * AW + o0_; const float* za_ = (const float*)(ws + WS_AD) + (size_t)dir_ * MROWS * AW + o0_; \
        _Pragma("unroll") for (int e = 0; e < 8; ++e) { pk_[e] = kp_[e * ds_]; pv_[e] = vp_[e * ds_]; pr_[e] = rp_[e * ds_]; pza_[e] = za_[e * ds_]; pzw_[e] = zw_[e * ds_]; } } while (0)
    if (F.bid < CH_NTASK) RA_LOAD(F.bid);
    for (int task = F.bid; task < CH_NTASK; task += F.nb) {
        const f32x4 z4 = zero4v();
        const int hd = task / CH_NCH, c = task - hd * CH_NCH, head = hd >> 1, dir = hd & 1;
        const int ch = head * 64 + F.lane;
        const float kkc = F.in[I_KK][(size_t)l * AW + ch], kac = F.in[I_KA][(size_t)l * AW + ch];
        {
            float kk_[8], b_[8], kd_[8], r_[8], lw_[8], cl_[8];
            float run = 0.f;
#pragma unroll
            for (int e = 0; e < 8; ++e) {
                const int i = F.wave * 8 + e;
                const float k = pk_[e], a = sigmoidf_(pza_[e]);
                lw_[e] = -0.6065306597126334f * sigmoidf_(pzw_[e]);
                r_[e] = pr_[e];
                const float kkr = k * kkc;
                const float nrm = sqrtf(wave_sum(kkr * kkr, F.lane));
                kk_[e] = kkr * __builtin_amdgcn_rcpf(fmaxf(nrm, 1e-12f));
                b_[e] = kk_[e] * a;
                kd_[e] = k * (1.0f + (a - 1.0f) * kac);
                run += lw_[e]; cl_[e] = run;
                *(LAS bf16_t*)(L + O_V + i * CS + F.lane * 2) = f2bf(pv_[e]);
            }
            if (task + F.nb < CH_NTASK) RA_LOAD(task + F.nb);
            tot[F.wave * 64 + F.lane] = run;
            lds_barrier();
            float off = 0.f, all = 0.f;
#pragma unroll
            for (int w = 0; w < 8; ++w) { const float t = tot[w * 64 + F.lane]; all += t; off += (w < F.wave) ? t : 0.f; }
            if (F.wave == 0) gL[F.lane] = __expf(all);
#pragma unroll
            for (int e = 0; e < 8; ++e) {
                const int i = F.wave * 8 + e;
                const float cum = off + cl_[e], cumm = cum - lw_[e];
                const float ec = __expf(cum), em = __expf(cumm), ei = __expf(-cum), eh = __expf(all - cum);
                const int o = i * CS + F.lane * 2;
                *(LAS bf16_t*)(L + O_KT + o) = f2bf(kk_[e] * em);
                *(LAS bf16_t*)(L + O_RT + o) = f2bf(r_[e] * ec);
                *(LAS bf16_t*)(L + O_BB + o) = f2bf(b_[e] * ei);
                *(LAS bf16_t*)(L + O_KB + o) = f2bf(kd_[e] * ei);
                *(LAS bf16_t*)(L + O_BH + o) = f2bf(b_[e] * eh);
                *(LAS bf16_t*)(L + O_KH + o) = f2bf(kd_[e] * eh);
            }
        }
        lds_barrier();
        {
            f32x4 ab[2] = {z4, z4}, ak[2] = {z4, z4}, rb[2] = {z4, z4}, rk[2] = {z4, z4};
#pragma unroll
            for (int ks = 0; ks < 2; ++ks) {
                const bf16x8 aK = ch_rowread(L + O_KT, tr, ks, qi, g), aR = ch_rowread(L + O_RT, tr, ks, qi, g);
#pragma unroll
                for (int t = 0; t < 2; ++t) {
                    const bf16x8 bB = ch_rowread(L + O_BB, tcb + t, ks, qi, g), bK = ch_rowread(L + O_KB, tcb + t, ks, qi, g);
                    ab[t] = MFMA_BF(aK, bB, ab[t]); ak[t] = MFMA_BF(aK, bK, ak[t]); rb[t] = MFMA_BF(aR, bB, rb[t]); rk[t] = MFMA_BF(aR, bK, rk[t]);
                }
            }
#pragma unroll
            for (int t = 0; t < 2; ++t) {
                const int col = 16 * (tcb + t) + qi;
#pragma unroll
                for (int jj = 0; jj < 4; ++jj) {
                    const int row = 16 * tr + 4 * g + jj;
                    const bool lo = col < row, le = col <= row;
                    Af[row * CF + col] = lo ? ab[t][jj] : 0.f;
                    ak[t][jj] = lo ? ak[t][jj] : 0.f; rb[t][jj] = le ? rb[t][jj] : 0.f; rk[t][jj] = le ? rk[t][jj] : 0.f;
                }
                ch_store_bf16(L + O_AAK, tr, tcb + t, qi, g, ak[t]); ch_store_bf16(L + O_ARB, tr, tcb + t, qi, g, rb[t]); ch_store_bf16(L + O_ARK, tr, tcb + t, qi, g, rk[t]);
            }
        }
        lds_barrier();
        if (F.wave == 0) {
            float t[16];
#pragma unroll
            for (int i = 0; i < 16; ++i) {
                float acc = (i == qi) ? 1.f : 0.f;
                f32x4 ar[4];
#pragma unroll
                for (int q = 0; q < (i + 3) / 4; ++q) ar[q] = *(const LAS f32x4*)(Af + (16 * g + i) * CF + 16 * g + 4 * q);
#pragma unroll
                for (int j = 0; j < i; ++j) acc -= ar[j >> 2][j & 3] * t[j];
                t[i] = acc;
            }
#pragma unroll
            for (int i = 0; i < 16; ++i) Tf[(16 * g + i) * CF + 16 * g + qi] = t[i];
        }
        lds_barrier();
#pragma unroll 1
        for (int d = 1; d < 4; ++d) {
            if (F.wave < 4 - d) {
                const int bp = F.wave, b = bp + d;
                f32x4 X = z4;
                for (int bb = bp; bb < b; ++bb) {
#pragma unroll
                    for (int s = 0; s < 4; ++s) X = MFMA_F32(Af[(16 * b + qi) * CF + 16 * bb + 4 * s + g], Tf[(16 * bb + 4 * s + g) * CF + 16 * bp + qi], X);
                }
                f32x4 R = z4;
#pragma unroll
                for (int s = 0; s < 4; ++s) R = MFMA_F32(Tf[(16 * b + qi) * CF + 16 * b + 4 * g + s], X[s], R);
#pragma unroll
                for (int jj = 0; jj < 4; ++jj) Tf[(16 * b + 4 * g + jj) * CF + 16 * bp + qi] = -R[jj];
            }
            lds_barrier();
        }
        for (int idx = F.tid; idx < 4096; idx += NTHREADS) { const int row = idx >> 6, col = idx & 63;
            *(LAS bf16_t*)(L + O_T + row * CS + col * 2) = f2bf(((col >> 4) > (row >> 4)) ? 0.f : Tf[row * CF + col]); }
        lds_barrier();
        {
            f32x4 av[2] = {z4, z4}, p[2] = {z4, z4};
#pragma unroll
            for (int ks = 0; ks < 2; ++ks) {
                const bf16x8 aA = ch_rowread(L + O_AAK, tr, ks, qi, g), aT = ch_rowread(L + O_T, tr, ks, qi, g);
#pragma unroll
                for (int t = 0; t < 2; ++t) { av[t] = MFMA_BF(aA, ch_trread(L + O_V, tcb + t, ks, qi, g), av[t]); p[t] = MFMA_BF(aT, ch_trread(L + O_KT, tcb + t, ks, qi, g), p[t]); }
            }
#pragma unroll
            for (int t = 0; t < 2; ++t) { ch_store_bf16(L + O_BB, tr, tcb + t, qi, g, av[t]); ch_store_bf16(L + O_KB, tr, tcb + t, qi, g, p[t]); }
        }
        lds_barrier();
        {
            f32x4 q[2] = {z4, z4};
#pragma unroll
            for (int ks = 0; ks < 2; ++ks) {
                const bf16x8 aT = ch_rowread(L + O_T, tr, ks, qi, g);
#pragma unroll
                for (int t = 0; t < 2; ++t) q[t] = MFMA_BF(aT, ch_trread(L + O_BB, tcb + t, ks, qi, g), q[t]);
            }
#pragma unroll
            for (int t = 0; t < 2; ++t) ch_store_bf16(L + O_AAK, tr, tcb + t, qi, g, q[t]);
        }
        lds_barrier();
        {
            f32x4 m[2] = {z4, z4}, n1[2] = {z4, z4}, n2[2] = {z4, z4}, ry[2] = {z4, z4}, y1[2] = {z4, z4}, y2[2] = {z4, z4};
#pragma unroll
            for (int ks = 0; ks < 2; ++ks) {
                const bf16x8 aPt = ch_trread(L + O_KB, tr, ks, qi, g), aVt = ch_trread(L + O_V, tr, ks, qi, g), aQt = ch_trread(L + O_AAK, tr, ks, qi, g);
                const bf16x8 aRb = ch_rowread(L + O_ARB, tr, ks, qi, g), aRk = ch_rowread(L + O_ARK, tr, ks, qi, g);
#pragma unroll
                for (int t = 0; t < 2; ++t) {
                    const bf16x8 bBh = ch_trread(L + O_BH, tcb + t, ks, qi, g), bKh = ch_trread(L + O_KH, tcb + t, ks, qi, g);
                    const bf16x8 bP = ch_trread(L + O_KB, tcb + t, ks, qi, g), bV = ch_trread(L + O_V, tcb + t, ks, qi, g), bQ = ch_trread(L + O_AAK, tcb + t, ks, qi, g);
                    m[t] = MFMA_BF(aPt, bBh, m[t]); n1[t] = MFMA_BF(aVt, bKh, n1[t]); n2[t] = MFMA_BF(aQt, bBh, n2[t]);
                    ry[t] = MFMA_BF(aRb, bP, ry[t]); y1[t] = MFMA_BF(aRk, bV, y1[t]); y2[t] = MFMA_BF(aRb, bQ, y2[t]);
                }
            }
            const int lo = (16 * tr + 4 * g) * 64 + 16 * tcb + qi;
            float* Np = MN + (size_t)task * 2 * 4096 + 4096 + lo;
            bf16_t* MTh = (bf16_t*)(MN + (size_t)task * 2 * 4096); bf16_t* MTl = MTh + 4096;
            bf16_t* Rp = RY + (size_t)task * 4096 + lo;
            const LAS bf16_t* Rt = (const LAS bf16_t*)(L + O_RT + (16 * tr + 4 * g) * CS + (16 * tcb + qi) * 2);
            const int dstep = (dir == 0) ? AW : -AW;
            float* Yp = (float*)(ws + WS_Y) + (size_t)dir * MROWS * AW + (size_t)scan_row(dir, c * 64 + 16 * tr + 4 * g) * AW + head * 64 + 16 * tcb + qi;
#pragma unroll
            for (int t = 0; t < 2; ++t) {
#pragma unroll
                for (int jj = 0; jj < 4; ++jj) {
                    const bool dg = (16 * tr + 4 * g + jj) == (16 * (tcb + t) + qi);
                    m[t][jj] = (dg ? gL[16 * (tcb + t) + qi] : 0.f) - m[t][jj];
                    Np[jj * 64 + t * 16] = n1[t][jj] - n2[t][jj];
                    Rp[jj * 64 + t * 16] = f2bf(bf2f(Rt[jj * (CS / 2) + t * 16]) - ry[t][jj]);
                    Yp[jj * dstep + t * 16] = y1[t][jj] - y2[t][jj];
                }
                float hi_[4];
#pragma unroll
                for (int jj = 0; jj < 4; ++jj) hi_[jj] = bf2f(f2bf(m[t][jj]));
                u32x2 wh, wl; wh.x = cvt_pk_bf16(hi_[0], hi_[1]); wh.y = cvt_pk_bf16(hi_[2], hi_[3]);
                wl.x = cvt_pk_bf16(m[t][0] - hi_[0], m[t][1] - hi_[1]); wl.y = cvt_pk_bf16(m[t][2] - hi_[2], m[t][3] - hi_[3]);
                const int mo_ = (16 * (tcb + t) + qi) * 64 + 32 * (tr >> 1) + 8 * g + 4 * (tr & 1);
                *(u32x2*)(MTh + mo_) = wh; *(u32x2*)(MTl + mo_) = wl;
            }
        }
        lds_barrier();
    }
}

#undef RA_LOAD
constexpr int RB_BLOCKS = 32;
constexpr int RB_SLOT = 32768;
__device__ __forceinline__ void rwkvB_phase(const Frame& F) {
    if (F.bid >= RB_BLOCKS) return;
    unsigned char* ws = F.ws;
    bf16_t* SC = (bf16_t*)(ws + WS_SC);
    const int qi = F.lane & 15, g = F.lane >> 4, hd = F.bid, vt = F.wave & 3;
    const bool loader = F.wave >= 4;
    const __amdgpu_buffer_rsrc_t rM = __builtin_amdgcn_make_buffer_rsrc((void*)(ws + WS_MN), 0, 0x7ffffff0, 0x00020000);
    const unsigned lo_ = (unsigned)(F.lane * 16);
#define RB_DMA(c_) do { const int so_ = (hd * CH_NCH + (c_)) * RB_SLOT; LAS unsigned char* sb_ = F.lds + ((c_) & 3) * RB_SLOT; \
        _Pragma("unroll") for (int i = 0; i < 8; ++i) __builtin_amdgcn_raw_ptr_buffer_load_lds(rM, (LAS void*)(sb_ + (vt + 4 * i) * 1024), 16, lo_ + (unsigned)((vt + 4 * i) * 1024), so_, 0, 0); } while (0)
    __syncthreads();
    if (loader) { RB_DMA(0); RB_DMA(1); RB_DMA(2); asm volatile("s_waitcnt vmcnt(16)" ::: "memory"); }
    lds_barrier();
    f32x4 T[4];
#pragma unroll
    for (int kt = 0; kt < 4; ++kt) T[kt] = zero4v();
    for (int c = 0; c < CH_NCH; ++c) {
        if (loader) {
            if (c + 3 < CH_NCH) { RB_DMA(c + 3); asm volatile("s_waitcnt vmcnt(16)" ::: "memory"); }
            else asm volatile("s_waitcnt vmcnt(0)" ::: "memory");
        } else {
            const LAS unsigned char* sb = F.lds + (c & 3) * RB_SLOT;
            bf16_t* Sg = SC + (size_t)(hd * CH_NCH + c) * 4096 + (16 * vt + qi) * 64 + 4 * g;
            bf16x8 bh[2], bl[2];
#pragma unroll
            for (int ks = 0; ks < 2; ++ks) {
                u32x4 wh, wl;
#pragma unroll
                for (int h = 0; h < 2; ++h) {
                    const f32x4 x = T[2 * ks + h];
                    float xh[4];
#pragma unroll
                    for (int j = 0; j < 4; ++j) xh[j] = bf2f(f2bf(x[j]));
                    const unsigned h0 = cvt_pk_bf16(xh[0], xh[1]), h1 = cvt_pk_bf16(xh[2], xh[3]);
                    const unsigned l0 = cvt_pk_bf16(x[0] - xh[0], x[1] - xh[1]), l1 = cvt_pk_bf16(x[2] - xh[2], x[3] - xh[3]);
                    if (h == 0) { wh.x = h0; wh.y = h1; wl.x = l0; wl.y = l1; } else { wh.z = h0; wh.w = h1; wl.z = l0; wl.w = l1; }
                    u32x2 sv; sv.x = h0; sv.y = h1; *(u32x2*)(Sg + 16 * (2 * ks + h)) = sv;
                }
                bh[ks] = __builtin_bit_cast(bf16x8, wh); bl[ks] = __builtin_bit_cast(bf16x8, wl);
            }
#pragma unroll
            for (int kt = 0; kt < 4; ++kt) {
                f32x4 acc = *(const LAS f32x4*)(sb + 16384 + ((16 * vt + qi) * 64 + 16 * kt + 4 * g) * 4);
#pragma unroll
                for (int ks = 0; ks < 2; ++ks) {
                    const bf16x8 ah = *(const LAS bf16x8*)(sb + ((16 * kt + qi) * 64 + 32 * ks + 8 * g) * 2);
                    const bf16x8 al = *(const LAS bf16x8*)(sb + 8192 + ((16 * kt + qi) * 64 + 32 * ks + 8 * g) * 2);
                    acc = MFMA_BF(ah, bh[ks], acc); acc = MFMA_BF(ah, bl[ks], acc); acc = MFMA_BF(al, bh[ks], acc);
                }
                T[kt] = acc;
            }
        }
        lds_barrier();
    }
#undef RB_DMA
}

__device__ __forceinline__ void rwkvC_readout_phase(const Frame& F, int l) {
    unsigned char* ws = F.ws;
    const bf16_t* RY = (const bf16_t*)(ws + WS_RY); const bf16_t* SC = (const bf16_t*)(ws + WS_SC);
    const float* Rf = (const float*)(ws + WS_RF); const float* Kf = (const float*)(ws + WS_KF); const float* Vf = (const float*)(ws + WS_VF);
    const float* Z0 = (const float*)(ws + WS_AD); const float* Z1 = Z0 + (size_t)MROWS * AW;
    const float* Y0 = (const float*)(ws + WS_Y); const float* Y1 = Y0 + (size_t)MROWS * AW;
    const float* G = (const float*)(ws + WS_G);
    bf16_t* YC = (bf16_t*)(ws + WS_YCAT);
    const int qi = F.lane & 15, g = F.lane >> 4;
    for (int qtask = F.bid * 8 + F.wave; qtask < CH_NCH * 16 * 4; qtask += F.nb * 8) {
        const int task = qtask >> 2, tr = qtask & 3;
        const int rb = task >> 4, head = task & 15, R0 = rb * 64;
        const int cf = (R0 >= SEQ) ? (R0 - SEQ) / 64 : (R0 + CTXL) / 64, cb = (MROWS - 64 - R0) / 64;
        const int tf = (head * 2) * CH_NCH + cf, tb = (head * 2 + 1) * CH_NCH + cb;
        f32x4 y[1][4];
        {
            bf16x8 bS[4][2];
#pragma unroll
            for (int tc = 0; tc < 4; ++tc)
#pragma unroll
                for (int ks = 0; ks < 2; ++ks) bS[tc][ks] = *(const bf16x8*)(SC + (size_t)tf * 4096 + (16 * tc + qi) * 64 + 32 * ks + 8 * g);
            {
                const bf16_t* ap = RY + (size_t)tf * 4096 + (16 * tr + qi) * 64 + 8 * g;
                const bf16x8 a0 = *(const bf16x8*)ap, a1 = *(const bf16x8*)(ap + 32);
#pragma unroll
                for (int tc = 0; tc < 4; ++tc) { f32x4 acc = zero4v(); acc = MFMA_BF(a0, bS[tc][0], acc); y[0][tc] = MFMA_BF(a1, bS[tc][1], acc); }
            }
#pragma unroll
            for (int tc = 0; tc < 4; ++tc)
#pragma unroll
                for (int ks = 0; ks < 2; ++ks) bS[tc][ks] = *(const bf16x8*)(SC + (size_t)tb * 4096 + (16 * tc + qi) * 64 + 32 * ks + 8 * g);
            {
                const bf16_t* ap = RY + (size_t)tb * 4096 + (63 - (16 * tr + qi)) * 64 + 8 * g;
                const bf16x8 a0 = *(const bf16x8*)ap, a1 = *(const bf16x8*)(ap + 32);
#pragma unroll
                for (int tc = 0; tc < 4; ++tc) { f32x4 acc = y[0][tc]; acc = MFMA_BF(a0, bS[tc][0], acc); y[0][tc] = MFMA_BF(a1, bS[tc][1], acc); }
            }
        }
        const float* lng = F.in[I_LNG] + (size_t)l * AW + head * 64; const float* lnb = F.in[I_LNB] + (size_t)l * AW + head * 64;
        const float* ka = F.in[I_KA] + (size_t)l * AW + head * 64; const float* rk = F.in[I_RK] + (size_t)l * AW + head * 64;
        float lg[4], lb[4], kav[4], rkv[4];
#pragma unroll
        for (int tc = 0; tc < 4; ++tc) { lg[tc] = lng[16 * tc + qi]; lb[tc] = lnb[16 * tc + qi]; kav[tc] = ka[16 * tc + qi]; rkv[tc] = rk[16 * tc + qi]; }
        {
            float a_y0[4][4], a_y1[4][4], a_k[4][4], a_z0[4][4], a_z1[4][4], a_r[4][4], a_v[4][4], a_g[4][4];
#pragma unroll
            for (int jj = 0; jj < 4; ++jj) {
                const size_t o = (size_t)(R0 + 16 * tr + 4 * g + jj) * AW + head * 64 + qi;
#pragma unroll
                for (int tc = 0; tc < 4; ++tc) { a_y0[jj][tc] = Y0[o + 16 * tc]; a_y1[jj][tc] = Y1[o + 16 * tc]; a_k[jj][tc] = Kf[o + 16 * tc]; a_z0[jj][tc] = Z0[o + 16 * tc];
                    a_z1[jj][tc] = Z1[o + 16 * tc]; a_r[jj][tc] = Rf[o + 16 * tc]; a_v[jj][tc] = Vf[o + 16 * tc]; a_g[jj][tc] = G[o + 16 * tc]; }
            }
            asm volatile("" ::: "memory");
#pragma unroll
            for (int jj = 0; jj < 4; ++jj) {
                const int row = R0 + 16 * tr + 4 * g + jj;
                float yv[4], s1 = 0.f, bs = 0.f;
#pragma unroll
                for (int tc = 0; tc < 4; ++tc) {
                    yv[tc] = y[0][tc][jj] + a_y0[jj][tc] + a_y1[jj][tc]; s1 += yv[tc];
                    const float kmean = a_k[jj][tc] * (1.0f + (0.5f * (sigmoidf_(a_z0[jj][tc]) + sigmoidf_(a_z1[jj][tc])) - 1.0f) * kav[tc]);
                    bs += a_r[jj][tc] * kmean * rkv[tc];
                }
                s1 = dpp_allsum16(s1); bs = dpp_allsum16(bs);
                const float mu = s1 * (1.0f / 64.0f);
                float s2 = 0.f;
#pragma unroll
                for (int tc = 0; tc < 4; ++tc) { yv[tc] -= mu; s2 += yv[tc] * yv[tc]; }
                s2 = dpp_allsum16(s2);
                const float rstd = rsqrtf(s2 * (1.0f / 64.0f) + GN_EPS);
#pragma unroll
                for (int tc = 0; tc < 4; ++tc) {
                    const float outv = (yv[tc] * rstd * lg[tc] + lb[tc] + bs * a_v[jj][tc]) * a_g[jj][tc];
                    YC[(size_t)row * 3072 + head * 64 + 16 * tc + qi] = f2bf(outv);
                }
            }
        }
    }
}


#ifndef PROBE_PHASE
#define PROBE_PHASE -1
#endif
#define REP(k) for (int rep_ = 0; rep_ < ((PROBE_PHASE == (k)) ? 2 : 1); ++rep_)
constexpr int NPH = 12;
constexpr int PH_TOTAL = 2 + DEPTH * NPH;

__global__ void __launch_bounds__(NTHREADS, 2) fwd_kernel(Args args) {
    extern __shared__ __attribute__((aligned(16))) unsigned char lds_raw[];
    Frame F;
    F.lds = (LAS unsigned char*)lds_raw;
    F.tid = threadIdx.x; F.lane = F.tid & 63; F.wave = __builtin_amdgcn_readfirstlane(F.tid >> 6);
    F.bid = blockIdx.x; F.nb = gridDim.x;
    F.in = args.in; F.ws = args.ws; F.out = args.out;
    unsigned char* ws = args.ws;
    const int lo = args.ph_lo, hi = args.ph_hi;
    const bool multi = (hi - lo) > 1;
    volatile LAS unsigned* bst = (volatile LAS unsigned*)(F.lds + LDS_BAR_OFF);
    if (F.tid < 4) bst[F.tid] = 0u;
    __syncthreads();
    XcdBarrier bar; bar.bar = (unsigned*)(ws + WS_CTL); bar.x = 0; bar.st = bst;
    if (multi) bar = xcd_barrier_post((unsigned*)(ws + WS_CTL), bst);
#define IN(k) (lo <= (k) && (k) < hi)
#define FRESH() do { asm volatile("v_mbcnt_lo_u32_b32 %0, -1, 0\n\tv_mbcnt_hi_u32_b32 %0, -1, %0" : "=v"(F.lane)); asm volatile("" : "+s"(F.wave), "+s"(F.bid), "+s"(F.nb)); \
    F.tid = F.wave * 64 + F.lane; asm volatile("" : "+s"(F.ws), "+s"(F.out)); ws = F.ws; } while (0)
#define SEAM(k) do { if (IN(k) && IN((k) + 1)) { asm volatile("" : "+s"(bar.x)); xcd_barrier(bar); } } while (0)

    if (IN(0)) { FRESH(); p0_prologue(F); }
    SEAM(0);

    for (int l = 0; l < DEPTH; ++l) {
        const int pb = 1 + l * NPH;
        if (IN(pb + 0)) REP(0) { FRESH(); norm_phase(F, l, 0, (const float*)(ws + WS_P2), l > 0 ? 32 : 0); }
        SEAM(pb + 0);
        if (IN(pb + 1)) REP(1) { FRESH();
            pg8::Gemm g{(const bf16_t*)(ws + WS_H), (const bf16_t*)(ws + WS_WIN) + (size_t)l * IN_COLS * D, MROWS, IN_COLS, D, D, D};
            pg8::StaticOrder S; S.init(MROWS, IN_COLS, F.nb, F.bid);
            pg8::EpiBf16<0> E{(bf16_t*)(ws + WS_U), IN_COLS};
            pg8::gemm_phase(F.lds, g, S, E, F.tid);
        }
        SEAM(pb + 1);
        if (IN(pb + 2)) REP(2) { FRESH(); prep1_phase(F, l); }
        SEAM(pb + 2);
        if (IN(pb + 3)) REP(3) { FRESH();
            {
                pg8::Gemm g{(const bf16_t*)(ws + WS_LA), (const bf16_t*)(ws + WS_WLORA) + (size_t)l * 5120 * 256, 5 * MROWS, 5120, 256, 256, 256};
                pg8::LoraOrder S; S.init(F.nb, F.bid);
                pg8::EpiLora E{(float*)(ws + WS_WD), (const float*)(ws + WS_LBIAS) + (size_t)l * 5 * AW};
                pg8::gemm_phase(F.lds, g, S, E, F.tid);
            }
            FRESH();
            {
                pg8::Gemm g{(const bf16_t*)(ws + WS_QL), (const bf16_t*)(ws + WS_WUQ) + (size_t)l * 1536 * 512, MROWS, 1536, 512, 512, 512};
                pg8::StaticOrder S; S.init(MROWS, 1536, F.nb, F.bid);
                pg8::EpiBf16<0> E{(bf16_t*)(ws + WS_Q), 1536};
                pg8::gemm_phase(F.lds, g, S, E, F.tid);
            }
            FRESH();
            {
                pg8::Gemm g{(const bf16_t*)(ws + WS_KVL), (const bf16_t*)(ws + WS_WUKV) + (size_t)l * 2048 * 256, MROWS, 2048, 256, 256, 256};
                pg8::StaticOrder S; S.init(MROWS, 2048, F.nb, F.bid);
                pg8::EpiKV E{(bf16_t*)(ws + WS_KC), (bf16_t*)(ws + WS_VC)};
                pg8::gemm_phase(F.lds, g, S, E, F.tid);
            }
        }
        SEAM(pb + 3);
        if (IN(pb + 4)) REP(4) { FRESH(); rwkvA_phase(F, l); }
        SEAM(pb + 4);
        if (IN(pb + 5)) REP(5) { FRESH(); if (!(args.flags & 1)) rwkvB_phase(F); FRESH(); attn_phase(F, l, args.flags); }
        SEAM(pb + 5);
        if (IN(pb + 6)) REP(6) { FRESH(); rwkvC_readout_phase(F, l); }
        SEAM(pb + 6);
        if (IN(pb + 7)) REP(7) { FRESH();
            { pg8::Gemm g{(const bf16_t*)(ws + WS_YCAT), (const bf16_t*)(ws + WS_WB) + (size_t)l * D * 3072, SEQ, D, 3072, 3072, 3072};
              pg8::StaticOrder S; S.init(SEQ, D, F.nb, F.bid);
              pg8::EpiMerge E{(bf16_t*)(ws + WS_MRGB), (const bf16_t*)(ws + WS_U) + GATE_OFF};
              pg8::gemm_phase<pg8::EpiMerge, pg8::StaticOrder, 16>(F.lds, g, S, E, F.tid); }
            FRESH();
            if (l < DEPTH - 1)
            { pg8::Gemm g{(const bf16_t*)(ws + WS_YCAT) + (size_t)SEQ * 3072, (const bf16_t*)(ws + WS_WB) + (size_t)l * D * 3072, 3 * 256, D, 1024, 3072, 3072, 2048, -1, 2048};
              pg8::StaticOrder S; S.init(3 * 256, D, F.nb, F.nb - 1 - F.bid);
              pg8::EpiPartial<1> E{(float*)(ws + WS_PM), nullptr, (const bf16_t*)(ws + WS_U) + (size_t)SEQ * IN_COLS + GATE_OFF};
              pg8::gemm_phase(F.lds, g, S, E, F.tid); }
        }
        SEAM(pb + 7);
        if (IN(pb + 8)) REP(8) { FRESH();
            const float* mod = (const float*)(ws + WS_MOD) + (size_t)l * 2 * 6 * D;
            { pg8::Gemm g{(const bf16_t*)(ws + WS_MRGB), (const bf16_t*)(ws + WS_WO) + (size_t)l * D * D, SEQ, D, D, D, D};
              pg8::StaticOrder S; S.init(SEQ, D, F.nb, F.bid);
              pg8::EpiResid E{(float*)(ws + ((args.flags & 8) ? WS_Y : WS_X)), mod + 2 * D, mod + 6 * D + 2 * D};
              pg8::gemm_phase(F.lds, g, S, E, F.tid); }
            FRESH();
            {
                const int cu = F.nb - 1 - F.bid;
                if (cu < 64 && l < DEPTH - 1) {
                    pg8::StaticOrder S; S.init(8 * 256, D, F.nb, cu);
                    pg8::Unit u0; S.next(0, u0);
                    bf16_t* scr = (bf16_t*)(ws + WS_CSCR) + (size_t)cu * 65536;
                    const float* src = (const float*)(ws + WS_PM) + u0.pm * 256;
                    for (int i = F.tid; i < 256 * 64; i += NTHREADS) { const int r = i >> 6, c4 = (i & 63) * 4; f32x4 v = *(const f32x4*)(src + (size_t)r * D + c4);
#pragma unroll
                        for (int s = 1; s < 3; ++s) v += *(const f32x4*)(src + (size_t)s * CTXL * D + (size_t)r * D + c4);
                        u32x2 w; w.x = cvt_pk_bf16(v[0], v[1]); w.y = cvt_pk_bf16(v[2], v[3]); *(u32x2*)(scr + r * 256 + c4) = w; }
                    __builtin_amdgcn_fence(__ATOMIC_RELEASE, "agent"); asm volatile("s_waitcnt vmcnt(0)" ::: "memory"); __syncthreads();
                    __builtin_amdgcn_fence(__ATOMIC_ACQUIRE, "agent"); asm volatile("s_waitcnt vmcnt(0)" ::: "memory");
                    pg8::Gemm g{scr, (const bf16_t*)(ws + WS_WO) + (size_t)l * D * D, 8 * 256, D, 256, 256, D, 0, -1, 512};
                    pg8::EpiPartial<0> E{(float*)(ws + WS_PO), mod + 6 * D + 2 * D, nullptr};
                    pg8::gemm_phase(F.lds, g, S, E, F.tid);
                }
            }
        }
        SEAM(pb + 8);
        if (IN(pb + 9)) REP(9) { FRESH(); norm_phase(F, l, 1, (const float*)(ws + WS_PO), l < DEPTH - 1 ? 8 : 0); }
        SEAM(pb + 9);
        if (IN(pb + 10)) REP(10) { FRESH();
            const int mrows = (l < DEPTH - 1) ? MROWS : SEQ;
            pg8::Gemm g{(const bf16_t*)(ws + WS_H), (const bf16_t*)(ws + WS_W1) + (size_t)l * DFF * D, mrows, DFF, D, D, D};
            pg8::StaticOrder S; S.init(mrows, DFF, F.nb, F.bid);
            pg8::EpiBf16<1> E{(bf16_t*)(ws + WS_U), DFF};
            pg8::gemm_phase(F.lds, g, S, E, F.tid);
        }
        SEAM(pb + 10);
        if (IN(pb + 11)) REP(11) { FRESH();
            const float* mod = (const float*)(ws + WS_MOD) + (size_t)l * 2 * 6 * D;
            { pg8::Gemm g{(const bf16_t*)(ws + WS_U), (const bf16_t*)(ws + WS_W2) + (size_t)l * D * DFF, SEQ, D, DFF, DFF, DFF};
              pg8::StaticOrder S; S.init(SEQ, D, F.nb, F.bid);
              pg8::EpiResid E{(float*)(ws + ((args.flags & 8) ? WS_Y : WS_X)), mod + 5 * D, mod + 6 * D + 5 * D};
              pg8::gemm_phase(F.lds, g, S, E, F.tid); }
            FRESH();
            if (l < DEPTH - 1)
            { pg8::Gemm g{(const bf16_t*)(ws + WS_U) + (size_t)SEQ * DFF, (const bf16_t*)(ws + WS_W2) + (size_t)l * D * DFF, 32 * 256, D, 256, DFF, DFF, 512, -1, 512};
              pg8::StaticOrder S; S.init(32 * 256, D, F.nb, F.nb - 1 - F.bid);
              pg8::EpiPartial<0> E{(float*)(ws + WS_P2), mod + 6 * D + 5 * D, nullptr};
              pg8::gemm_phase(F.lds, g, S, E, F.tid); }
        }
        SEAM(pb + 11);
    }
    if (IN(PH_TOTAL - 1)) { FRESH(); final_norm_phase(F); }
#undef IN
#undef SEAM
}

#ifndef HOST_PROBE_FLAGS
#define HOST_PROBE_FLAGS 0
#endif
#ifndef HOST_PROBE_PHASE
#define HOST_PROBE_PHASE -1
#endif
#ifndef N_LAUNCH_MODE
#define N_LAUNCH_MODE 1
#endif
extern "C" void kernel_launch(void* const* d_in, const int* in_sizes, int n_in, void* d_out, int out_size, void* d_ws, size_t ws_size, hipStream_t stream) {
    static int grid = 0;
    if (grid == 0) {
        if (n_in != 30 || out_size != SEQ * D || ws_size < WS_END) { fprintf(stderr, "kernel_launch: unexpected shapes (n_in %d out %d ws %zu need %zu)\n", n_in, out_size, ws_size, (size_t)WS_END); grid = -1; return; }
        int dev = 0, cus = 0, per_cu = 0;
        if (hipGetDevice(&dev) != hipSuccess || hipDeviceGetAttribute(&cus, hipDeviceAttributeMultiprocessorCount, dev) != hipSuccess) { grid = -1; return; }
        if (hipFuncSetAttribute((const void*)fwd_kernel, hipFuncAttributeMaxDynamicSharedMemorySize, LDS_BYTES) != hipSuccess) { fprintf(stderr, "kernel_launch: hipFuncSetAttribute failed\n"); grid = -1; return; }
        if (hipOccupancyMaxActiveBlocksPerMultiprocessor(&per_cu, (const void*)fwd_kernel, NTHREADS, LDS_BYTES) != hipSuccess || per_cu < 1) { fprintf(stderr, "kernel_launch: occupancy query says %d\n", per_cu); (void)hipGetLastError(); grid = -1; return; }
        grid = cus;
    }
    if (grid < 0) return;
    (void)hipMemsetAsync((char*)d_ws + WS_CTL, 0, CTL_BYTES, stream);
    Args a{};
    for (int i = 0; i < 30; ++i) a.in[i] = (const float*)d_in[i];
    a.out = (float*)d_out; a.ws = (unsigned char*)d_ws;
#if N_LAUNCH_MODE == 1
    a.ph_lo = 0; a.ph_hi = PH_TOTAL;
    hipLaunchKernelGGL(fwd_kernel, dim3(grid), dim3(NTHREADS), LDS_BYTES, stream, a);
#else
    for (int p = 0; p < PH_TOTAL; ++p) { a.ph_lo = p; a.ph_hi = p + 1;
        const int reps = ((p >= 1 && p < PH_TOTAL - 1 && ((p - 1) % NPH) == HOST_PROBE_PHASE) || (p == 0 && HOST_PROBE_PHASE == 100)) ? 2 : 1;
        for (int r = 0; r < reps; ++r) { a.flags = (r == 1) ? HOST_PROBE_FLAGS : 0; hipLaunchKernelGGL(fwd_kernel, dim3(grid), dim3(NTHREADS), LDS_BYTES, stream, a); } }
#endif
}
```

```cpp
#include <hip/hip_runtime.h>
#include <cstdio>
#include <cstdint>

#define LAS __attribute__((address_space(3)))
typedef unsigned short bf16_t;
typedef short bf16x8 __attribute__((ext_vector_type(8)));
typedef short bf16x4 __attribute__((ext_vector_type(4)));
typedef float f32x4 __attribute__((ext_vector_type(4)));
typedef float f32x2 __attribute__((ext_vector_type(2)));
typedef unsigned u32x4 __attribute__((ext_vector_type(4)));
typedef unsigned u32x2 __attribute__((ext_vector_type(2)));

constexpr int D = 2048, SEQ = 8192, CTXL = 256, MROWS = SEQ + CTXL, DEPTH = 4, GRIDW = 64;
constexpr int IN_COLS = 13568, RWKV_COLS = 3712, MLA_OFF = 3712, NA_OFF = 4352, GATE_OFF = 7424, DFF = 8192;
constexpr int AW = 1024;
constexpr int QLORA = 448, KVLORA = 128, QKROPE = 64, QKNOPE = 128, VDIM = 128, BHEADS = 8, QHD = 192;
constexpr float RMS_EPS = 1e-6f, GN_EPS = 64e-5f;
constexpr float LOG2E = 1.4426950408889634f;

constexpr size_t al256(size_t x) { return (x + 255) & ~(size_t)255; }
constexpr size_t WS_CTL = 0;
constexpr size_t CTL_BYTES = 65536;
constexpr size_t WS_MOD = WS_CTL + CTL_BYTES;
constexpr size_t WS_LBIAS = al256(WS_MOD + (size_t)DEPTH * 2 * 6 * D * 4);
constexpr size_t WS_ROPE = al256(WS_LBIAS + (size_t)DEPTH * 5 * AW * 4);
constexpr size_t WS_X = al256(WS_ROPE + (size_t)SEQ * 32 * 2 * 4);
constexpr size_t WS_H = al256(WS_X + (size_t)MROWS * D * 4);
constexpr size_t WS_U = al256(WS_H + (size_t)MROWS * D * 2);
constexpr size_t WS_WIN = al256(WS_U + (size_t)MROWS * IN_COLS * 2);
constexpr size_t WS_W1 = al256(WS_WIN + (size_t)DEPTH * IN_COLS * D * 2);
constexpr size_t WS_W2 = al256(WS_W1 + (size_t)DEPTH * DFF * D * 2);
constexpr size_t WS_WB = al256(WS_W2 + (size_t)DEPTH * DFF * D * 2);
constexpr size_t WS_WO = al256(WS_WB + (size_t)DEPTH * D * 3072 * 2);
constexpr size_t WS_WUQ = al256(WS_WO + (size_t)DEPTH * D * D * 2);
constexpr size_t WS_WUKV = al256(WS_WUQ + (size_t)DEPTH * 1536 * 512 * 2);
constexpr size_t WS_WLORA = al256(WS_WUKV + (size_t)DEPTH * 2048 * 256 * 2);
constexpr size_t WS_RF = al256(WS_WLORA + (size_t)DEPTH * 5120 * 256 * 2);
constexpr size_t WS_KF = al256(WS_RF + (size_t)MROWS * AW * 4);
constexpr size_t WS_VF = al256(WS_KF + (size_t)MROWS * AW * 4);
constexpr size_t WS_WD = al256(WS_VF + (size_t)MROWS * AW * 4);
constexpr size_t WS_AD = al256(WS_WD + (size_t)2 * MROWS * AW * 4);
constexpr size_t WS_G = al256(WS_AD + (size_t)2 * MROWS * AW * 4);
constexpr size_t WS_Y = al256(WS_G + (size_t)MROWS * AW * 4);
constexpr size_t WS_LA = al256(WS_Y + (size_t)2 * MROWS * AW * 4);
constexpr size_t WS_QL = al256(WS_LA + (size_t)MROWS * 1280 * 2);
constexpr size_t WS_KVL = al256(WS_QL + (size_t)MROWS * 512 * 2);
constexpr size_t WS_KPE = al256(WS_KVL + (size_t)MROWS * 256 * 2);
constexpr size_t WS_Q = WS_KPE;
constexpr size_t WS_KC = al256(WS_Q + (size_t)MROWS * 1536 * 2);
constexpr size_t WS_VC = al256(WS_KC + (size_t)MROWS * 1536 * 2);
constexpr size_t WS_YCAT = al256(WS_VC + (size_t)MROWS * 1024 * 2);
constexpr size_t WS_MRG = WS_RF;
constexpr size_t WS_MRGB = al256(WS_YCAT + (size_t)MROWS * 3072 * 2);
constexpr size_t WS_MN = al256(WS_MRGB + (size_t)MROWS * D * 2);
constexpr size_t WS_RY = al256(WS_MN + (size_t)4224 * 2 * 4096 * 4);
constexpr size_t WS_SC = al256(WS_RY + (size_t)4224 * 4096 * 2);
constexpr size_t WS_CSCR = al256(WS_SC + (size_t)4224 * 4096 * 2);
constexpr size_t WS_PM = WS_MN;
constexpr size_t WS_PO = WS_PM + (size_t)12 * CTXL * D * 4;
constexpr size_t WS_P2 = WS_PO + (size_t)8 * CTXL * D * 4;
static_assert(WS_P2 + (size_t)32 * CTXL * D * 4 <= WS_RY, "partial slabs must fit the MN buffer");
constexpr size_t WS_END = al256(WS_CSCR + (size_t)64 * 65536 * 2);
static_assert(WS_KF == WS_RF + (size_t)MROWS * AW * 4, "MRG alias needs r|k contiguous");

constexpr int LDS_BYTES = 147456;
constexpr int LDS_BAR_OFF = LDS_BYTES - 16;
constexpr int NTHREADS = 512;

typedef __bf16 bf16x2n __attribute__((ext_vector_type(2)));
__device__ __forceinline__ unsigned cvt_pk_bf16(float lo, float hi) { return __builtin_bit_cast(unsigned, __builtin_convertvector((f32x2){lo, hi}, bf16x2n)); }
__device__ __forceinline__ bf16_t f2bf(float f) { return __builtin_bit_cast(bf16_t, (__bf16)f); }
__device__ __forceinline__ float bf2f(bf16_t h) { return __uint_as_float(((unsigned)h) << 16); }
__device__ __forceinline__ float bflo(unsigned w) { return __uint_as_float(w << 16); }
__device__ __forceinline__ float bfhi(unsigned w) { return __uint_as_float(w & 0xFFFF0000u); }
__device__ __forceinline__ float sigmoidf_(float x) { return __builtin_amdgcn_rcpf(1.0f + __expf(-x)); }
__device__ __forceinline__ void unpack8(const u32x4 w, float (&f)[8]) { f[0] = bflo(w.x); f[1] = bfhi(w.x); f[2] = bflo(w.y); f[3] = bfhi(w.y); f[4] = bflo(w.z); f[5] = bfhi(w.z); f[6] = bflo(w.w); f[7] = bfhi(w.w); }
__device__ __forceinline__ u32x4 pack8(const float (&f)[8]) { u32x4 w; w.x = cvt_pk_bf16(f[0], f[1]); w.y = cvt_pk_bf16(f[2], f[3]); w.z = cvt_pk_bf16(f[4], f[5]); w.w = cvt_pk_bf16(f[6], f[7]); return w; }

__device__ __forceinline__ void lds_barrier() { asm volatile("s_waitcnt lgkmcnt(0)\n\ts_barrier" ::: "memory"); }
__device__ __forceinline__ f32x4 zero4v() { f32x4 z = (f32x4){0.f, 0.f, 0.f, 0.f}; asm volatile("" : "+v"(z)); return z; }
__device__ __forceinline__ float shx(float v, int m, int lane) { return __int_as_float(__builtin_amdgcn_ds_bpermute((lane ^ m) << 2, __float_as_int(v))); }
__device__ __forceinline__ float rows_max(float x) {
    const auto r = __builtin_amdgcn_permlane16_swap(__float_as_uint(x), __float_as_uint(x), false, false); x = fmaxf(__uint_as_float(r[0]), __uint_as_float(r[1]));
    const auto q = __builtin_amdgcn_permlane32_swap(__float_as_uint(x), __float_as_uint(x), false, false); return fmaxf(__uint_as_float(q[0]), __uint_as_float(q[1]));
}
__device__ __forceinline__ float rows_sum(float x) {
    const auto r = __builtin_amdgcn_permlane16_swap(__float_as_uint(x), __float_as_uint(x), false, false); x = __uint_as_float(r[0]) + __uint_as_float(r[1]);
    const auto q = __builtin_amdgcn_permlane32_swap(__float_as_uint(x), __float_as_uint(x), false, false); return __uint_as_float(q[0]) + __uint_as_float(q[1]);
}
__device__ __forceinline__ float wave_sum(float x, int  ) {
    x += __int_as_float(__builtin_amdgcn_update_dpp(0, __float_as_int(x), 0xB1, 0xF, 0xF, true));
    x += __int_as_float(__builtin_amdgcn_update_dpp(0, __float_as_int(x), 0x4E, 0xF, 0xF, true));
    x += __int_as_float(__builtin_amdgcn_update_dpp(0, __float_as_int(x), 0x141, 0xF, 0xF, true));
    x += __int_as_float(__builtin_amdgcn_update_dpp(0, __float_as_int(x), 0x140, 0xF, 0xF, true));
    const int xi = __float_as_int(x);
    return (__int_as_float(__builtin_amdgcn_readlane(xi, 0)) + __int_as_float(__builtin_amdgcn_readlane(xi, 16))) +
           (__int_as_float(__builtin_amdgcn_readlane(xi, 32)) + __int_as_float(__builtin_amdgcn_readlane(xi, 48)));
}

#define XB_TMO      128
#define XB_XCNT(j)  (256  + 64 * (j))
#define XB_XSUB(j)  (1280 + 64 * (j))
#define XB_XGEN(j)  (2304 + 64 * (j))
#define XB_TOP      3328
#define XB_TOPGEN   3392
#define XCD_BAR_WORDS 3456
#define XB_SPIN_CAP (1u << 22)

__device__ __forceinline__ unsigned xb_ld(unsigned* p)              { return __hip_atomic_load(p, __ATOMIC_RELAXED, __HIP_MEMORY_SCOPE_AGENT); }
__device__ __forceinline__ unsigned xb_add(unsigned* p, unsigned v) { return __hip_atomic_fetch_add(p, v, __ATOMIC_RELAXED, __HIP_MEMORY_SCOPE_AGENT); }
__device__ __forceinline__ unsigned xb_xcc_id() { return (unsigned)__builtin_amdgcn_s_getreg((3 << 11) | 20) & 0xFu; }
#define XB_SPIN(cond, bar) do { unsigned _sp = 0; while (cond) { __builtin_amdgcn_s_sleep(1); \
    if ((++_sp & 255u) == 0u) { if (xb_ld(&(bar)[XB_TMO])) break; if (_sp > XB_SPIN_CAP) { atomicAdd(&(bar)[XB_TMO], 1u); break; } } } } while (0)

struct XcdBarrier { unsigned* bar; unsigned x; volatile LAS unsigned* st; };

__device__ __forceinline__ XcdBarrier xcd_barrier_post(unsigned* bar, volatile LAS unsigned* st) {
    XcdBarrier b; b.bar = bar; b.x = xb_xcc_id(); b.st = st;
    if (threadIdx.x == 0) (void)xb_add(&bar[XB_XCNT(b.x)], 1u);
    return b;
}
__device__ __forceinline__ void xcd_barrier_complete(unsigned* bar, unsigned x, unsigned& nloc, unsigned& nx) {
    const unsigned G = gridDim.x * gridDim.y * gridDim.z;
    unsigned sum, cnt, mine, sp = 0u;
    for (;;) {
        sum = 0u; cnt = 0u; mine = 0u;
#pragma unroll
        for (unsigned j = 0; j < 16; ++j) { const unsigned c = xb_ld(&bar[XB_XCNT(j)]); sum += c; cnt += (c > 0u) ? 1u : 0u; mine = (j == x) ? c : mine; }
        if (sum == G) break;
        __builtin_amdgcn_s_sleep(1);
        if ((++sp & 255u) == 0u) { if (xb_ld(&bar[XB_TMO])) break; if (sp > XB_SPIN_CAP) { atomicAdd(&bar[XB_TMO], 1u); break; } }
    }
    nloc = mine > 0u ? mine : 1u; nx = cnt > 0u ? cnt : 1u;
}
__device__ __forceinline__ void xcd_barrier(const XcdBarrier& b) {
    asm volatile("s_waitcnt vmcnt(0)" ::: "memory");
    __syncthreads();
    if (threadIdx.x == 0) {
        unsigned* bar = b.bar;
        __builtin_amdgcn_s_waitcnt(0);
        unsigned nloc = b.st[0], nx = b.st[1];
        if (nloc == 0u) { xcd_barrier_complete(bar, b.x, nloc, nx); b.st[0] = nloc; b.st[1] = nx; }
        const unsigned old = xb_add(&bar[XB_XSUB(b.x)], 1u);
        const unsigned gen = old / nloc;
        if (old + 1u == (gen + 1u) * nloc) {
            __builtin_amdgcn_fence(__ATOMIC_RELEASE, "agent");
            asm volatile("s_waitcnt vmcnt(0)" ::: "memory");
            const unsigned og = xb_add(&bar[XB_TOP], 1u);
            const unsigned tg = og / nx;
            if (og + 1u == (tg + 1u) * nx) xb_add(&bar[XB_TOPGEN], 1u);
            else XB_SPIN(xb_ld(&bar[XB_TOPGEN]) == tg, bar);
            __builtin_amdgcn_fence(__ATOMIC_ACQUIRE, "agent");
            xb_add(&bar[XB_XGEN(b.x)], 1u);
            asm volatile("s_waitcnt vmcnt(0)" ::: "memory");
        } else {
            XB_SPIN(xb_ld(&bar[XB_XGEN(b.x)]) == gen, bar);
            __builtin_amdgcn_fence(__ATOMIC_ACQUIRE, "agent");
            asm volatile("s_waitcnt vmcnt(0)" ::: "memory");
        }
    }
    __syncthreads();
}

namespace pg8 {
constexpr int BM = 256, BK = 64, HALF = 128, HTB = HALF * BK * 2, STAGE_BYTES = 8 * HTB, NXCD = 8, WGM = 4;
__host__ __device__ __forceinline__ int lds_byte(int r, int c) { const int st = (r >> 4) * 2 + (c >> 5), rr = r & 15, cc = c & 31, ob = rr * 64 + cc * 2; return st * 1024 + (ob ^ (((ob >> 9) & 1) << 5)); }
__host__ __device__ __forceinline__ void stage_rc(int b, int& R, int& C) { const int st = b / 1024, sb = b % 1024, swz = sb ^ (((sb >> 9) & 1) << 5); R = (st >> 1) * 16 + swz / 64; C = (st & 1) * 32 + (swz % 64) / 2; }
__host__ __device__ __forceinline__ int perm32(int rho) { const int n = rho >> 4, i = rho & 15; return 8 * (i >> 2) + 4 * n + (i & 3); }

struct Unit { int pm, pn; };
struct Gemm { const bf16_t* A; const bf16_t* Bt; int M, N, K, lda, ldb;
    long pstepA = -1, pstepB = -1, qstepB = 0; };

struct StaticOrder {
    int nM, nN, nwg, G, c;
    __device__ __forceinline__ void init(int M, int N, int G_, int c_) { nM = M / BM; nN = N / BM; nwg = nM * nN; G = G_; c = c_; }
    __device__ __forceinline__ bool next(int i, Unit& u) const {
        const long L = (long)i * G + c; if (L >= nwg) return false;
        int wgid = (int)L; { const int q = nwg / NXCD, r = nwg % NXCD, xcd = wgid % NXCD, off = wgid / NXCD; wgid = (xcd < r ? xcd * (q + 1) : r * (q + 1) + (xcd - r) * q) + off; }
        const int nig = WGM * nN, gid = wgid / nig, fm = gid * WGM, gsz = (nM - fm) < WGM ? (nM - fm) : WGM;
        u.pm = fm + ((wgid % nig) % gsz); u.pn = (wgid % nig) / gsz; return true;
    }
};

struct LoraOrder {
    int G, c;
    __device__ __forceinline__ void init(int G_, int c_) { G = G_; c = c_; }
    __device__ __forceinline__ bool next(int i, Unit& u) const {
        const int L = i * G + c; if (L >= 5 * 132) return false;
        const int grp = L / 132, r = L - grp * 132;
        u.pm = grp * (MROWS / 256) + (r % (MROWS / 256)); u.pn = grp * 4 + r / (MROWS / 256); return true;
    }
};

template <class Epi, class Sched, int MIDK = 0, bool ALIGN_EPI = true>
__device__ __forceinline__ void gemm_phase(LAS unsigned char* lds, const Gemm g, const Sched& S, const Epi& E, const int tid) {
    const int wid = __builtin_amdgcn_readfirstlane(tid >> 6), lane = tid & 63, wr = wid >> 2, wc = wid & 3, fr = lane & 15, fq = lane >> 4;
    int nt = g.K / BK; asm volatile("" : "+s"(nt));
    unsigned voffA[2], voffB[2];
#pragma unroll
    for (int i = 0; i < 2; ++i) { int R, C; stage_rc(tid * 16 + i * 8192, R, C); const int Rb = Epi::PERM ? ((R & ~31) + perm32(R & 31)) : R;
        voffA[i] = (unsigned)(R * g.lda + C) * 2u; voffB[i] = (unsigned)(Rb * g.ldb + C) * 2u; }
    const size_t kstep = (size_t)(BK * 2);
    const size_t hstepA = (size_t)HALF * g.lda * 2, hstepB = (size_t)HALF * g.ldb * 2;
    const size_t tstepA = g.pstepA < 0 ? 2 * hstepA : (size_t)g.pstepA, tstepB = g.pstepB < 0 ? 2 * hstepB : (size_t)g.pstepB, qB = (size_t)g.qstepB;
    const unsigned ldsw = (unsigned)wid * 1024u;
    const int aoff = lds_byte(wr * 64 + fr, fq * 8), boff = lds_byte(wc * 32 + fr, fq * 8);
#define PG8_SA(b, h) (((b) * 2 + (h)) * HTB)
#define PG8_SB(b, h) ((4 + (b) * 2 + (h)) * HTB)
#define PG8_STAGE(bufoff, gbase, voff) do { _Pragma("unroll") for (int _i = 0; _i < 2; ++_i) \
        __builtin_amdgcn_global_load_lds((const unsigned*)((const char*)(gbase) + (voff)[_i]), (LAS unsigned*)(lds + (bufoff) + ldsw + _i * 8192), 16, 0, 0); } while (0)
#define PG8_LDA(dst, b, h) do { _Pragma("unroll") for (int m = 0; m < 4; ++m) _Pragma("unroll") for (int k = 0; k < 2; ++k) dst[m][k] = *(const LAS bf16x8*)(lds + PG8_SA(b, h) + aoff + m * 2048 + k * 1024); } while (0)
#define PG8_LDB(dst, b, h) do { _Pragma("unroll") for (int n = 0; n < 2; ++n) _Pragma("unroll") for (int k = 0; k < 2; ++k) dst[n][k] = *(const LAS bf16x8*)(lds + PG8_SB(b, h) + boff + n * 2048 + k * 1024); } while (0)
#define PG8_MMA(ai, bj, At, Bt) do { __builtin_amdgcn_s_setprio(1); _Pragma("unroll") for (int m = 0; m < 4; ++m) _Pragma("unroll") for (int n = 0; n < 2; ++n) _Pragma("unroll") for (int k = 0; k < 2; ++k) \
        acc[ai][bj][m][n] = __builtin_amdgcn_mfma_f32_16x16x32_bf16(Bt[n][k], At[m][k], acc[ai][bj][m][n], 0, 0, 0); __builtin_amdgcn_s_setprio(0); } while (0)
#define PG8_WAIT_V(n) asm volatile("s_waitcnt vmcnt(" #n ")" ::: "memory")
#define PG8_WAIT_L(n) asm volatile("s_waitcnt lgkmcnt(" #n ")" ::: "memory")
#define PG8_BAR __builtin_amdgcn_s_barrier()
#define PG8_SCHED __builtin_amdgcn_sched_barrier(0)
    Unit cur, nxt; int ui = 0;
    if (!S.next(0, cur)) return;
    f32x4 acc[2][2][4][2];
#pragma unroll
    for (int a = 0; a < 2; ++a)
#pragma unroll
        for (int b = 0; b < 2; ++b)
#pragma unroll
            for (int m = 0; m < 4; ++m)
#pragma unroll
                for (int n = 0; n < 2; ++n) acc[a][b][m][n] = zero4v();
    bf16x8 At[4][2], B0[2][2], B1[2][2];
    const char* cA = (const char*)g.A + (size_t)cur.pm * tstepA; const char* cB = (const char*)g.Bt + (size_t)cur.pn * tstepB + (size_t)cur.pm * qB;
    PG8_STAGE(PG8_SB(0, 0), cB, voffB); PG8_STAGE(PG8_SB(0, 1), cB + hstepB, voffB); PG8_STAGE(PG8_SA(0, 0), cA, voffA); PG8_STAGE(PG8_SA(0, 1), cA + hstepA, voffA);
    if (wr == 1) PG8_BAR;
    PG8_WAIT_V(2); PG8_BAR;
    PG8_STAGE(PG8_SB(1, 0), cB + kstep, voffB); PG8_STAGE(PG8_SA(1, 0), cA + kstep, voffA); PG8_STAGE(PG8_SB(1, 1), cB + hstepB + kstep, voffB);
    PG8_WAIT_V(6); PG8_BAR;
    for (;;) {
        const bool has_next = S.next(ui + 1, nxt);
        const char* nA = has_next ? (const char*)g.A + (size_t)nxt.pm * tstepA : cA; const char* nB = has_next ? (const char*)g.Bt + (size_t)nxt.pn * tstepB + (size_t)nxt.pm * qB : cB;
        for (int t = 0; t < nt; t += 2) {
            const bool last = (t == nt - 2);
            const char* a1 = cA + (size_t)(t + 1) * kstep;
            const char* a2 = last ? nA : cA + (size_t)(t + 2) * kstep; const char* b2 = last ? nB : cB + (size_t)(t + 2) * kstep;
            const char* a3 = a2 + kstep; const char* b3 = b2 + kstep;
            PG8_LDB(B0, 0, 0); PG8_LDB(B1, 0, 1); PG8_SCHED; PG8_LDA(At, 0, 0); PG8_STAGE(PG8_SA(1, 1), a1 + hstepA, voffA);
            PG8_WAIT_V(8); PG8_WAIT_L(0); PG8_BAR; PG8_MMA(0, 0, At, B0); PG8_MMA(0, 1, At, B1); PG8_BAR; PG8_SCHED;
            PG8_LDA(At, 0, 1); PG8_STAGE(PG8_SB(0, 0), b2, voffB); PG8_STAGE(PG8_SB(0, 1), b2 + hstepB, voffB); PG8_STAGE(PG8_SA(0, 0), a2, voffA);
            PG8_WAIT_V(8); PG8_WAIT_L(0); PG8_BAR; PG8_MMA(1, 0, At, B0); PG8_MMA(1, 1, At, B1); PG8_BAR; PG8_SCHED;
            PG8_LDB(B0, 1, 0); PG8_LDB(B1, 1, 1); PG8_SCHED; PG8_LDA(At, 1, 0); PG8_STAGE(PG8_SA(0, 1), a2 + hstepA, voffA);
            PG8_WAIT_V(8); PG8_WAIT_L(0); PG8_BAR; PG8_MMA(0, 0, At, B0); PG8_MMA(0, 1, At, B1); PG8_BAR; PG8_SCHED;
            PG8_LDA(At, 1, 1); PG8_STAGE(PG8_SB(1, 0), b3, voffB); PG8_STAGE(PG8_SB(1, 1), b3 + hstepB, voffB); PG8_STAGE(PG8_SA(1, 0), a3, voffA);
            PG8_WAIT_V(8); PG8_WAIT_L(0); PG8_BAR; PG8_MMA(1, 0, At, B0); PG8_MMA(1, 1, At, B1); PG8_BAR; PG8_SCHED;
            if constexpr (MIDK > 0) { if (((t + 2) % MIDK) == 0 && t + 2 < nt) { int ln_; asm volatile("v_mbcnt_lo_u32_b32 %0, -1, 0\n\tv_mbcnt_hi_u32_b32 %0, -1, %0" : "=v"(ln_)); E.mid(acc, cur, (t + 2) / MIDK - 1, wr, wc, ln_ & 15, ln_ >> 4); } }
        }
        if constexpr (ALIGN_EPI) { if (wr == 0) PG8_BAR; }
        { int ln_; asm volatile("v_mbcnt_lo_u32_b32 %0, -1, 0\n\tv_mbcnt_hi_u32_b32 %0, -1, %0" : "=v"(ln_)); E(acc, cur, wr, wc, ln_ & 15, ln_ >> 4); }
        if (!has_next) break;
#pragma unroll
        for (int a = 0; a < 2; ++a)
#pragma unroll
            for (int b = 0; b < 2; ++b)
#pragma unroll
                for (int m = 0; m < 4; ++m)
#pragma unroll
                    for (int n = 0; n < 2; ++n) acc[a][b][m][n] = zero4v();
        cur = nxt; cA = nA; cB = nB; ++ui;
        if constexpr (ALIGN_EPI) { if (wr == 1) PG8_BAR; }
    }
    PG8_WAIT_V(0);
    if constexpr (!ALIGN_EPI) { if (wr == 0) PG8_BAR; }
    PG8_BAR;
#undef PG8_SA
#undef PG8_SB
#undef PG8_STAGE
#undef PG8_LDA
#undef PG8_LDB
#undef PG8_MMA
#undef PG8_WAIT_V
#undef PG8_WAIT_L
#undef PG8_BAR
#undef PG8_SCHED
}

template <int ACT  > struct EpiBf16 {
    static constexpr bool PERM = true;
    bf16_t* O; int ldc;
    __device__ __forceinline__ void operator()(const f32x4 (&acc)[2][2][4][2], const Unit& u, int wr, int wc, int fr, int fq) const {
        const int row0 = u.pm * BM + wr * 64 + fr, col0 = u.pn * BM + wc * 32 + 8 * fq;
#pragma unroll
        for (int ai = 0; ai < 2; ++ai)
#pragma unroll
            for (int m = 0; m < 4; ++m) { bf16_t* rowp = O + (size_t)(row0 + ai * HALF + m * 16) * ldc + col0;
#pragma unroll
                for (int bj = 0; bj < 2; ++bj) { f32x4 v0 = acc[ai][bj][m][0], v1 = acc[ai][bj][m][1];
                    if (ACT == 1) {
#pragma unroll
                        for (int j = 0; j < 4; ++j) { const float a = fmaxf(v0[j], 0.f), b = fmaxf(v1[j], 0.f); v0[j] = a * a; v1[j] = b * b; } }
                    u32x4 w; w.x = cvt_pk_bf16(v0[0], v0[1]); w.y = cvt_pk_bf16(v0[2], v0[3]); w.z = cvt_pk_bf16(v1[0], v1[1]); w.w = cvt_pk_bf16(v1[2], v1[3]);
                    *(u32x4*)(rowp + bj * HALF) = w; } }
    }
};

struct EpiKV {
    static constexpr bool PERM = true;
    bf16_t* KC; bf16_t* VC;
    __device__ __forceinline__ void operator()(const f32x4 (&acc)[2][2][4][2], const Unit& u, int wr, int wc, int fr, int fq) const {
        const int row0 = u.pm * BM + wr * 64 + fr, c0 = wc * 32 + 8 * fq;
#pragma unroll
        for (int ai = 0; ai < 2; ++ai)
#pragma unroll
            for (int m = 0; m < 4; ++m) { const size_t row = (size_t)(row0 + ai * HALF + m * 16);
#pragma unroll
                for (int bj = 0; bj < 2; ++bj) { const f32x4 v0 = acc[ai][bj][m][0], v1 = acc[ai][bj][m][1];
                    u32x4 w; w.x = cvt_pk_bf16(v0[0], v0[1]); w.y = cvt_pk_bf16(v0[2], v0[3]); w.z = cvt_pk_bf16(v1[0], v1[1]); w.w = cvt_pk_bf16(v1[2], v1[3]);
                    bf16_t* dst = (bj == 0) ? KC + row * 1536 + u.pn * 192 + c0 : VC + row * 1024 + u.pn * 128 + c0;
                    *(u32x4*)dst = w; } }
    }
};

struct EpiLora {
    static constexpr bool PERM = false;
    float* Z; const float* bias;
    __device__ __forceinline__ void operator()(const f32x4 (&acc)[2][2][4][2], const Unit& u, int wr, int wc, int fr, int fq) const {
        const int grp = u.pn >> 2;
        const int row0 = (u.pm - grp * (MROWS / 256)) * BM + wr * 64 + fr, col0 = (u.pn & 3) * BM + wc * 32 + 4 * fq;
        float* base = Z + (size_t)grp * MROWS * AW; const float* bp = bias + grp * AW + col0;
        f32x4 bv[2][2];
#pragma unroll
        for (int bj = 0; bj < 2; ++bj)
#pragma unroll
            for (int n = 0; n < 2; ++n) bv[bj][n] = *(const f32x4*)(bp + bj * HALF + n * 16);
#pragma unroll
        for (int ai = 0; ai < 2; ++ai)
#pragma unroll
            for (int m = 0; m < 4; ++m) { float* rowp = base + (size_t)(row0 + ai * HALF + m * 16) * AW + col0;
#pragma unroll
                for (int bj = 0; bj < 2; ++bj)
#pragma unroll
                    for (int n = 0; n < 2; ++n) *(f32x4*)(rowp + bj * HALF + n * 16) = acc[ai][bj][m][n] + bv[bj][n]; }
    }
};

struct EpiMerge {
    static constexpr bool PERM = true;
    bf16_t* Mb; const bf16_t* Ug;
    __device__ __forceinline__ void mid(f32x4 (&acc)[2][2][4][2], const Unit& u, int seg, int wr, int wc, int fr, int fq) const {
        const int row0 = u.pm * BM + wr * 64 + fr, col0 = u.pn * BM + wc * 32 + 8 * fq;
#pragma unroll
        for (int ai = 0; ai < 2; ++ai) {
            u32x4 ga[4][2], gb[4][2];
#pragma unroll
            for (int m = 0; m < 4; ++m) { const bf16_t* gp = Ug + (size_t)(row0 + ai * HALF + m * 16) * IN_COLS + seg * 2048 + col0;
#pragma unroll
                for (int bj = 0; bj < 2; ++bj) { ga[m][bj] = *(const u32x4*)(gp + bj * HALF); gb[m][bj] = *(const u32x4*)(gp + 2048 + bj * HALF); } }
            asm volatile("" ::: "memory");
#pragma unroll
            for (int m = 0; m < 4; ++m)
#pragma unroll
                for (int bj = 0; bj < 2; ++bj) {
                    float a[8], b[8]; unpack8(ga[m][bj], a); unpack8(gb[m][bj], b);
#pragma unroll
                    for (int e = 0; e < 8; ++e) { const float ea = __expf(-fminf(fmaxf(a[e], -30.f), 30.f)), eb = __expf(-fminf(fmaxf(b[e], -30.f), 30.f));
                        const float ratio = (1.0f + eb) * __builtin_amdgcn_rcpf(1.0f + ea);
                        acc[ai][bj][m][e >> 2][e & 3] *= ratio; }
                }
        }
    }
    __device__ __forceinline__ void operator()(const f32x4 (&acc)[2][2][4][2], const Unit& u, int wr, int wc, int fr, int fq) const {
        const int row0 = u.pm * BM + wr * 64 + fr, col0 = u.pn * BM + wc * 32 + 8 * fq;
#pragma unroll
        for (int ai = 0; ai < 2; ++ai) {
            u32x4 gq_[4][2];
#pragma unroll
            for (int m = 0; m < 4; ++m)
#pragma unroll
                for (int bj = 0; bj < 2; ++bj) gq_[m][bj] = *(const u32x4*)(Ug + (size_t)(row0 + ai * HALF + m * 16) * IN_COLS + 4096 + col0 + bj * HALF);
            asm volatile("" ::: "memory");
#pragma unroll
            for (int m = 0; m < 4; ++m) { const size_t row = (size_t)(row0 + ai * HALF + m * 16);
#pragma unroll
                for (int bj = 0; bj < 2; ++bj) { const int col = col0 + bj * HALF;
                    float gq[8]; unpack8(gq_[m][bj], gq);
                    f32x4 v0 = acc[ai][bj][m][0], v1 = acc[ai][bj][m][1];
#pragma unroll
                    for (int e = 0; e < 4; ++e) { v0[e] *= sigmoidf_(gq[e]); v1[e] *= sigmoidf_(gq[4 + e]); }
                    u32x4 w; w.x = cvt_pk_bf16(v0[0], v0[1]); w.y = cvt_pk_bf16(v0[2], v0[3]); w.z = cvt_pk_bf16(v1[0], v1[1]); w.w = cvt_pk_bf16(v1[2], v1[3]);
                    *(u32x4*)(Mb + row * D + col) = w; } }
        }
    }
};

struct EpiResid {
    static constexpr bool PERM = false;
    float* X; const float* gl; const float* gc;
    __device__ __forceinline__ void operator()(const f32x4 (&acc)[2][2][4][2], const Unit& u, int wr, int wc, int fr, int fq) const {
        const int row0 = u.pm * BM + wr * 64 + fr, col0 = u.pn * BM + wc * 32 + 4 * fq;
        const float* gate = (u.pm * BM < SEQ) ? gl : gc;
        f32x4 gv[2][2];
#pragma unroll
        for (int bj = 0; bj < 2; ++bj)
#pragma unroll
            for (int n = 0; n < 2; ++n) gv[bj][n] = *(const f32x4*)(gate + col0 + bj * HALF + n * 16);
#pragma unroll
        for (int ai = 0; ai < 2; ++ai) {
            f32x4 xv[4][2][2];
#pragma unroll
            for (int m = 0; m < 4; ++m)
#pragma unroll
                for (int bj = 0; bj < 2; ++bj)
#pragma unroll
                    for (int n = 0; n < 2; ++n) xv[m][bj][n] = *(const f32x4*)(X + (size_t)(row0 + ai * HALF + m * 16) * D + col0 + bj * HALF + n * 16);
            asm volatile("" ::: "memory");
#pragma unroll
            for (int m = 0; m < 4; ++m)
#pragma unroll
                for (int bj = 0; bj < 2; ++bj)
#pragma unroll
                    for (int n = 0; n < 2; ++n) *(f32x4*)(X + (size_t)(row0 + ai * HALF + m * 16) * D + col0 + bj * HALF + n * 16) = xv[m][bj][n] + acc[ai][bj][m][n] * gv[bj][n];
            asm volatile("" ::: "memory");
        }
    }
};

template <int GATE> struct EpiPartial {
    static constexpr bool PERM = false;
    float* P; const float* gate; const bf16_t* Ugc;
    __device__ __forceinline__ void operator()(const f32x4 (&acc)[2][2][4][2], const Unit& u, int wr, int wc, int fr, int fq) const {
        const int row0 = wr * 64 + fr, col0 = u.pn * BM + wc * 32 + 4 * fq;
        float* base = P + (size_t)u.pm * CTXL * D;
#pragma unroll
        for (int ai = 0; ai < 2; ++ai)
#pragma unroll
            for (int m = 0; m < 4; ++m) { const int row = row0 + ai * HALF + m * 16;
#pragma unroll
                for (int bj = 0; bj < 2; ++bj)
#pragma unroll
                    for (int n = 0; n < 2; ++n) { const int col = col0 + bj * HALF + n * 16;
                        f32x4 gv;
                        if (GATE == 0) gv = *(const f32x4*)(gate + col);
                        else { const u32x2 gw = *(const u32x2*)(Ugc + (size_t)row * IN_COLS + u.pm * 2048 + col);
                            gv[0] = sigmoidf_(bflo(gw.x)); gv[1] = sigmoidf_(bfhi(gw.x)); gv[2] = sigmoidf_(bflo(gw.y)); gv[3] = sigmoidf_(bfhi(gw.y)); }
                        *(f32x4*)(base + (size_t)row * D + col) = acc[ai][bj][m][n] * gv; } }
    }
};
}

struct Args { const float* in[30]; float* out; unsigned char* ws; int ph_lo, ph_hi, flags, pad_; };
enum { I_X = 0, I_C, I_CTX, I_CCTX, I_ADAW, I_ADAB, I_NMIXG, I_NMLPG, I_WIN, I_CONV, I_W0, I_WUP, I_A0, I_AUP, I_GUP, I_KK, I_KA, I_RK, I_LNG, I_LNB,
       I_QNG, I_WUQ, I_KVNG, I_WUKV, I_RPB, I_WBR, I_WOUT, I_W1, I_W2, I_FNG };

struct Frame {
    LAS unsigned char* lds; int tid, lane, wave, bid, nb;
    const float* const* in; unsigned char* ws; float* out;
};

struct TJob { const float* src; bf16_t* dst; int K, Kpad, N, ldd; };

__device__ __forceinline__ TJob make_job(const Frame& F, int l, int j) {
    TJob t; unsigned char* ws = F.ws;
    switch (j) {
    case 0: t.src = F.in[I_WIN] + (size_t)l * D * IN_COLS; t.dst = (bf16_t*)(ws + WS_WIN) + (size_t)l * IN_COLS * D; t.K = D; t.Kpad = D; t.N = IN_COLS; t.ldd = D; break;
    case 1: t.src = F.in[I_W1] + (size_t)l * D * DFF; t.dst = (bf16_t*)(ws + WS_W1) + (size_t)l * DFF * D; t.K = D; t.Kpad = D; t.N = DFF; t.ldd = D; break;
    case 2: t.src = F.in[I_W2] + (size_t)l * DFF * D; t.dst = (bf16_t*)(ws + WS_W2) + (size_t)l * D * DFF; t.K = DFF; t.Kpad = DFF; t.N = D; t.ldd = DFF; break;
    case 3: case 4: case 5: t.src = F.in[I_WBR] + ((size_t)l * 3 + (j - 3)) * 1024 * D; t.dst = (bf16_t*)(ws + WS_WB) + (size_t)l * D * 3072 + (j - 3) * 1024; t.K = 1024; t.Kpad = 1024; t.N = D; t.ldd = 3072; break;
    case 6: t.src = F.in[I_WOUT] + (size_t)l * D * D; t.dst = (bf16_t*)(ws + WS_WO) + (size_t)l * D * D; t.K = D; t.Kpad = D; t.N = D; t.ldd = D; break;
    case 7: t.src = F.in[I_WUQ] + (size_t)l * QLORA * 1536; t.dst = (bf16_t*)(ws + WS_WUQ) + (size_t)l * 1536 * 512; t.K = QLORA; t.Kpad = 512; t.N = 1536; t.ldd = 512; break;
    case 8: t.src = F.in[I_WUKV] + (size_t)l * KVLORA * 2048; t.dst = (bf16_t*)(ws + WS_WUKV) + (size_t)l * 2048 * 256; t.K = KVLORA; t.Kpad = 256; t.N = 2048; t.ldd = 256; break;
    case 9: case 10: t.src = F.in[I_WUP] + ((size_t)l * 2 + (j - 9)) * 96 * AW; t.dst = (bf16_t*)(ws + WS_WLORA) + ((size_t)l * 5 + (j - 9)) * 1024 * 256; t.K = 96; t.Kpad = 256; t.N = AW; t.ldd = 256; break;
    case 11: case 12: t.src = F.in[I_AUP] + ((size_t)l * 2 + (j - 11)) * 96 * AW; t.dst = (bf16_t*)(ws + WS_WLORA) + ((size_t)l * 5 + 2 + (j - 11)) * 1024 * 256; t.K = 96; t.Kpad = 256; t.N = AW; t.ldd = 256; break;
    default: t.src = F.in[I_GUP] + (size_t)l * 256 * AW; t.dst = (bf16_t*)(ws + WS_WLORA) + ((size_t)l * 5 + 4) * 1024 * 256; t.K = 256; t.Kpad = 256; t.N = AW; t.ldd = 256; break;
    }
    return t;
}

__device__ __forceinline__ void transpose_job(const Frame& F, const TJob& J, int rot) {
    LAS float* tile = (LAS float*)F.lds;
    const int ntk = J.Kpad / 128, ntn = J.N / 64, ntiles = ntk * ntn;
    const int kr = F.tid >> 4, c4 = (F.tid & 15) * 4;
    const int sn = F.tid >> 3, k16 = (F.tid & 7) * 16;
    int start = F.bid - rot; if (start < 0) start += F.nb;
    f32x4 nx[4];
#define TJ_LOAD(ti_) do { const int tk_ = (ti_) / ntn, tn_ = (ti_) % ntn; \
        _Pragma("unroll") for (int it = 0; it < 4; ++it) { const int k = tk_ * 128 + kr + 32 * it; nx[it] = zero4v(); \
            if (k < J.K) nx[it] = *(const f32x4*)(J.src + (size_t)k * J.N + tn_ * 64 + c4); } } while (0)
    if (start < ntiles) TJ_LOAD(start);
    for (int ti = start; ti < ntiles; ti += F.nb) {
        const int tk = ti / ntn, tn = ti % ntn;
        f32x4 v[4];
#pragma unroll
        for (int it = 0; it < 4; ++it) v[it] = nx[it];
        if (ti + F.nb < ntiles) TJ_LOAD(ti + F.nb);
#pragma unroll
        for (int it = 0; it < 4; ++it) { LAS float* tp = tile + (kr + 32 * it) * 65 + c4; tp[0] = v[it][0]; tp[1] = v[it][1]; tp[2] = v[it][2]; tp[3] = v[it][3]; }
        lds_barrier();
        float e[16];
#pragma unroll
        for (int j = 0; j < 16; ++j) e[j] = tile[(k16 + j) * 65 + sn];
        u32x4 w0, w1; w0.x = cvt_pk_bf16(e[0], e[1]); w0.y = cvt_pk_bf16(e[2], e[3]); w0.z = cvt_pk_bf16(e[4], e[5]); w0.w = cvt_pk_bf16(e[6], e[7]);
        w1.x = cvt_pk_bf16(e[8], e[9]); w1.y = cvt_pk_bf16(e[10], e[11]); w1.z = cvt_pk_bf16(e[12], e[13]); w1.w = cvt_pk_bf16(e[14], e[15]);
        bf16_t* dp = J.dst + (size_t)(tn * 64 + sn) * J.ldd + tk * 128 + k16;
        *(u32x4*)dp = w0; *(u32x4*)(dp + 8) = w1;
        lds_barrier();
    }
#undef TJ_LOAD
}

__device__ __forceinline__ void p0_prologue(const Frame& F) {
    unsigned char* ws = F.ws;
    int rot = 0;
    for (int l = 0; l < DEPTH; ++l)
        for (int j = 0; j < 14; ++j) { const TJob J = make_job(F, l, j); transpose_job(F, J, rot); rot = (rot + ((J.Kpad / 128) * (J.N / 64)) % F.nb) % F.nb; }
    {
        LAS float* sv = (LAS float*)F.lds;
        LAS float* red = (LAS float*)(F.lds + 16384);
        for (int i = F.tid; i < 2 * D; i += NTHREADS) { const float x = (i < D) ? F.in[I_C][i] : F.in[I_CCTX][i - D]; sv[i] = x * sigmoidf_(x); }
        __syncthreads();
        const int cg = F.tid & 15, ks = F.tid >> 4;
        for (int u = F.bid; u < DEPTH * 192; u += F.nb) {
            const int l = u / 192, cb = (u % 192) * 64;
            const float* wp = F.in[I_ADAW] + (size_t)l * D * (6 * D) + cb + cg * 4;
            f32x4 a0 = zero4v(), a1 = a0;
#pragma unroll 4
            for (int k = ks; k < D; k += 32) { const f32x4 w = *(const f32x4*)(wp + (size_t)k * (6 * D)); a0 += w * sv[k]; a1 += w * sv[D + k]; }
            LAS float* rp = red + (ks * 16 + cg) * 8;
#pragma unroll
            for (int j = 0; j < 4; ++j) { rp[j] = a0[j]; rp[4 + j] = a1[j]; }
            __syncthreads();
            if (F.tid < 128) {
                const int g2 = F.tid >> 3, e = F.tid & 7; float s = 0.f;
#pragma unroll 8
                for (int q = 0; q < 32; ++q) s += red[(q * 16 + g2) * 8 + e];
                const int col = cb + g2 * 4 + (e & 3), sidx = e >> 2;
                ((float*)(ws + WS_MOD))[((size_t)l * 2 + sidx) * (6 * D) + col] = s + F.in[I_ADAB][(size_t)l * (6 * D) + col];
            }
            __syncthreads();
        }
    }
    {
        float* rt = (float*)(ws + WS_ROPE);
        for (int i = F.bid * NTHREADS + F.tid; i < SEQ * 32; i += F.nb * NTHREADS) {
            const int t = i >> 5, j = i & 31;
            const float inv = powf(10000.0f, -(float)(j & 15) / 16.0f);
            const float pos = (j < 16) ? (float)(t / GRIDW) : (float)(t % GRIDW);
            const float ang = pos * inv;
            rt[2 * i] = cosf(ang); rt[2 * i + 1] = sinf(ang);
        }
    }
    {
        float* lb = (float*)(ws + WS_LBIAS);
        for (int i = F.bid * NTHREADS + F.tid; i < DEPTH * 5 * AW; i += F.nb * NTHREADS) { const int l = i / (5 * AW), r = i % (5 * AW), grp = r / AW, c = r % AW;
            lb[i] = grp < 2 ? F.in[I_W0][((size_t)l * 2 + grp) * AW + c] : (grp < 4 ? F.in[I_A0][((size_t)l * 2 + grp - 2) * AW + c] : 0.f); }
        f32x4* X = (f32x4*)(ws + WS_X);
        const f32x4* x = (const f32x4*)F.in[I_X]; const f32x4* cx = (const f32x4*)F.in[I_CTX];
        const size_t n1 = (size_t)SEQ * D / 4, n2 = (size_t)CTXL * D / 4;
        for (size_t i = (size_t)F.bid * NTHREADS + F.tid; i < n1 + n2; i += (size_t)F.nb * NTHREADS) X[i] = (i < n1) ? x[i] : cx[i - n1];
        u32x4* z = (u32x4*)(ws + WS_LA); const size_t nz = (WS_KPE - WS_LA) / 16;
        for (size_t i = (size_t)F.bid * NTHREADS + F.tid; i < nz; i += (size_t)F.nb * NTHREADS) z[i] = __builtin_bit_cast(u32x4, zero4v());
    }
}

__device__ __forceinline__ void norm_phase(const Frame& F, int l, int which, const float* parts, int nparts) {
    float* X = (float*)(F.ws + WS_X); bf16_t* H = (bf16_t*)(F.ws + WS_H);
    const float* g = F.in[which ? I_NMLPG : I_NMIXG] + (size_t)l * D;
    const float* mod = (const float*)(F.ws + WS_MOD) + (size_t)l * 2 * 6 * D;
    f32x4 ga[8], sh[8];
#pragma unroll
    for (int i = 0; i < 8; ++i) { const int c = i * 256 + F.lane * 4; const float* m = mod + which * 3 * D;
        ga[i] = *(const f32x4*)(g + c) * (*(const f32x4*)(m + D + c) + 1.0f); sh[i] = *(const f32x4*)(m + c); }
    bool ctxp = false;
    const int row0 = F.bid * 8 + F.wave, rstep = F.nb * 8;
    f32x4 nx[8];
    if (row0 < MROWS) {
#pragma unroll
        for (int i = 0; i < 8; ++i) nx[i] = *(const f32x4*)(X + (size_t)row0 * D + i * 256 + F.lane * 4);
    }
    for (int row = row0; row < MROWS; row += rstep) {
        float* xr = X + (size_t)row * D;
        f32x4 v[8]; float ss = 0.f;
#pragma unroll
        for (int i = 0; i < 8; ++i) v[i] = nx[i];
        if (row + rstep < MROWS) {
#pragma unroll
            for (int i = 0; i < 8; ++i) nx[i] = *(const f32x4*)(xr + (size_t)rstep * D + i * 256 + F.lane * 4);
        }
        if (row >= SEQ) {
            if (!ctxp) { ctxp = true; const float* m = mod + 6 * D + which * 3 * D;
#pragma unroll
                for (int i = 0; i < 8; ++i) { const int c = i * 256 + F.lane * 4; ga[i] = *(const f32x4*)(g + c) * (*(const f32x4*)(m + D + c) + 1.0f); sh[i] = *(const f32x4*)(m + c); } }
            if (nparts > 0) {
                const float* pp = parts + (size_t)(row - SEQ) * D + F.lane * 4;
                for (int s = 0; s < nparts; ++s) {
#pragma unroll
                    for (int i = 0; i < 8; ++i) v[i] += *(const f32x4*)(pp + (size_t)s * CTXL * D + i * 256);
                }
#pragma unroll
                for (int i = 0; i < 8; ++i) *(f32x4*)(xr + i * 256 + F.lane * 4) = v[i];
            }
        }
#pragma unroll
        for (int i = 0; i < 8; ++i) ss += v[i][0] * v[i][0] + v[i][1] * v[i][1] + v[i][2] * v[i][2] + v[i][3] * v[i][3];
        ss = wave_sum(ss, F.lane);
        const float rstd = rsqrtf(ss * (1.0f / D) + RMS_EPS);
#pragma unroll
        for (int i = 0; i < 8; ++i) {
            const f32x4 h = (v[i] * rstd) * ga[i] + sh[i];
            u32x2 w; w.x = cvt_pk_bf16(h[0], h[1]); w.y = cvt_pk_bf16(h[2], h[3]);
            *(u32x2*)(H + (size_t)row * D + i * 256 + F.lane * 4) = w;
        }
    }
}

__device__ __forceinline__ void final_norm_phase(const Frame& F) {
    const float* X = (const float*)(F.ws + WS_X); const float* g = F.in[I_FNG];
    for (int row = F.bid * 8 + F.wave; row < SEQ; row += F.nb * 8) {
        const float* xr = X + (size_t)row * D;
        f32x4 v[8]; float ss = 0.f;
#pragma unroll
        for (int i = 0; i < 8; ++i) { v[i] = *(const f32x4*)(xr + i * 256 + F.lane * 4); ss += v[i][0] * v[i][0] + v[i][1] * v[i][1] + v[i][2] * v[i][2] + v[i][3] * v[i][3]; }
        ss = wave_sum(ss, F.lane);
        const float rstd = rsqrtf(ss * (1.0f / D) + RMS_EPS);
#pragma unroll
        for (int i = 0; i < 8; ++i) { const int c = i * 256 + F.lane * 4; *(f32x4*)(F.out + (size_t)row * D + c) = (v[i] * rstd) * *(const f32x4*)(g + c); }
    }
}

__device__ __forceinline__ void prep1_phase(const Frame& F, int l) {
    unsigned char* ws = F.ws;
    const bf16_t* U = (const bf16_t*)(ws + WS_U);
    float* Rf = (float*)(ws + WS_RF); float* Kf = (float*)(ws + WS_KF); float* Vf = (float*)(ws + WS_VF);
    bf16_t* LA = (bf16_t*)(ws + WS_LA); bf16_t* QL = (bf16_t*)(ws + WS_QL); bf16_t* KVL = (bf16_t*)(ws + WS_KVL); bf16_t* KC = (bf16_t*)(ws + WS_KC);
    const float* conv = F.in[I_CONV] + (size_t)l * 3 * RWKV_COLS;
    const float* qg = F.in[I_QNG] + (size_t)l * QLORA; const float* kvg = F.in[I_KVNG] + (size_t)l * KVLORA;
    const float* rope = (const float*)(ws + WS_ROPE);
    const u32x4 zero4 = __builtin_bit_cast(u32x4, zero4v());
    LAS float* cw = (LAS float*)F.lds;
    __syncthreads();
    for (int i = F.tid; i < 3 * RWKV_COLS / 4; i += NTHREADS) *(LAS f32x4*)(cw + 4 * i) = *(const f32x4*)(conv + 4 * i);
    __syncthreads();
    for (int row = F.bid * 8 + F.wave; row < MROWS; row += F.nb * 8) {
        const bool lat = row < SEQ; const int rr = lat ? row : row - SEQ, slen = lat ? SEQ : CTXL;
        const bool hp = rr > 0, hn = rr < slen - 1;
        const bf16_t* uc = U + (size_t)row * IN_COLS;
        u32x4 wc_[8], wp_[8], wn_[8];
#pragma unroll
        for (int it = 0; it < 8; ++it) {
            const int gi = it * 64 + F.lane, col = (gi < RWKV_COLS / 8 ? gi : 0) * 8;
            wc_[it] = *(const u32x4*)(uc + col);
            wp_[it] = hp ? *(const u32x4*)(uc - IN_COLS + col) : zero4;
            wn_[it] = hn ? *(const u32x4*)(uc + IN_COLS + col) : zero4;
        }
        asm volatile("" ::: "memory");
#pragma unroll
        for (int it = 0; it < 8; ++it) {
            const int gi = it * 64 + F.lane;
            if (gi < RWKV_COLS / 8) {
                const int col = gi * 8;
                float c[8], p[8], n[8], o[8]; unpack8(wc_[it], c); unpack8(wp_[it], p); unpack8(wn_[it], n);
                const f32x4 k0a = *(const LAS f32x4*)(cw + col), k0b = *(const LAS f32x4*)(cw + col + 4);
                const f32x4 k1a = *(const LAS f32x4*)(cw + RWKV_COLS + col), k1b = *(const LAS f32x4*)(cw + RWKV_COLS + col + 4);
                const f32x4 k2a = *(const LAS f32x4*)(cw + 2 * RWKV_COLS + col), k2b = *(const LAS f32x4*)(cw + 2 * RWKV_COLS + col + 4);
#pragma unroll
                for (int j = 0; j < 4; ++j) { o[j] = k0a[j] * p[j] + k1a[j] * c[j] + k2a[j] * n[j]; o[4 + j] = k0b[j] * p[4 + j] + k1b[j] * c[4 + j] + k2b[j] * n[4 + j]; }
                if (it < 6) {
                    float* dst = (it < 2 ? Rf : (it < 4 ? Kf : Vf)) + (size_t)row * AW + (it & 1) * 512 + F.lane * 8;
                    *(f32x4*)dst = (f32x4){o[0], o[1], o[2], o[3]}; *(f32x4*)(dst + 4) = (f32x4){o[4], o[5], o[6], o[7]};
                } else if (col < 3264) {
                    const int d = (col - 3072) >= 96 ? 1 : 0, cc = (col - 3072) - 96 * d;
#pragma unroll
                    for (int j = 0; j < 8; ++j) o[j] = tanhf(o[j]);
                    *(u32x4*)(LA + ((size_t)d * MROWS + row) * 256 + cc) = pack8(o);
                } else if (col < 3456) {
                    const int d = (col - 3264) >= 96 ? 1 : 0, cc = (col - 3264) - 96 * d;
                    *(u32x4*)(LA + ((size_t)(2 + d) * MROWS + row) * 256 + cc) = pack8(o);
                } else {
#pragma unroll
                    for (int j = 0; j < 8; ++j) o[j] = sigmoidf_(o[j]);
                    *(u32x4*)(LA + ((size_t)4 * MROWS + row) * 256 + (col - 3456)) = pack8(o);
                }
            }
        }
        {
            float x[8]; float ss = 0.f;
            if (F.lane < 56) { unpack8(*(const u32x4*)(uc + MLA_OFF + F.lane * 8), x);
#pragma unroll
                for (int j = 0; j < 8; ++j) ss += x[j] * x[j]; }
            ss = wave_sum(ss, F.lane);
            const float rstd = rsqrtf(ss * (1.0f / QLORA) + RMS_EPS);
            if (F.lane < 56) {
#pragma unroll
                for (int j = 0; j < 8; ++j) x[j] = x[j] * rstd * qg[F.lane * 8 + j];
                *(u32x4*)(QL + (size_t)row * 512 + F.lane * 8) = pack8(x);
            }
            float y[8]; float s2 = 0.f;
            if (F.lane < 16) { unpack8(*(const u32x4*)(uc + MLA_OFF + QLORA + F.lane * 8), y);
#pragma unroll
                for (int j = 0; j < 8; ++j) s2 += y[j] * y[j]; }
            s2 = wave_sum(s2, F.lane);
            const float rstd2 = rsqrtf(s2 * (1.0f / KVLORA) + RMS_EPS);
            if (F.lane < 16) {
#pragma unroll
                for (int j = 0; j < 8; ++j) y[j] = y[j] * rstd2 * kvg[F.lane * 8 + j];
                *(u32x4*)(KVL + (size_t)row * 256 + F.lane * 8) = pack8(y);
            }
        }
        {
            const float xv = bf2f(uc[MLA_OFF + QLORA + KVLORA + F.lane]);
            const float pv = shx(xv, 16, F.lane);
            float o = xv;
            if (lat) {
                const int ai = (F.lane < 32 ? 0 : 16) + (F.lane & 15);
                const float cs = rope[((size_t)row * 32 + ai) * 2], sn = rope[((size_t)row * 32 + ai) * 2 + 1];
                o = ((F.lane & 16) == 0) ? (xv * cs - pv * sn) : (pv * sn + xv * cs);
            }
            const bf16_t ob = f2bf(o);
#pragma unroll
            for (int hh = 0; hh < 8; ++hh) KC[(size_t)row * 1536 + hh * 192 + 128 + F.lane] = ob;
        }
    }
}

constexpr int SC_TC = 32;
constexpr int SC_STEP_FLOATS = 6 * 64;
constexpr int SC_BUF_BYTES = SC_TC * SC_STEP_FLOATS * 4;
constexpr int SC_CS_OFF = 2 * SC_BUF_BYTES;
constexpr int SC_Y_OFF = SC_CS_OFF + 2 * SC_TC * 2 * 4;

__device__ __forceinline__ float dpp_allsum16(float x) {
    x += __int_as_float(__builtin_amdgcn_update_dpp(0, __float_as_int(x), 0xB1, 0xF, 0xF, true));
    x += __int_as_float(__builtin_amdgcn_update_dpp(0, __float_as_int(x), 0x4E, 0xF, 0xF, true));
    x += __int_as_float(__builtin_amdgcn_update_dpp(0, __float_as_int(x), 0x141, 0xF, 0xF, true));
    x += __int_as_float(__builtin_amdgcn_update_dpp(0, __float_as_int(x), 0x140, 0xF, 0xF, true));
    return x;
}

__device__ __forceinline__ int scan_row(int dir, int s) {
    if (dir == 0) return s < CTXL ? SEQ + s : s - CTXL;
    return s < CTXL ? SEQ + (CTXL - 1) - s : (SEQ - 1) - (s - CTXL);
}

__device__ __forceinline__ void readout_phase(const Frame& F, int l) {
    unsigned char* ws = F.ws;
    const float* Rf = (const float*)(ws + WS_RF); const float* Kf = (const float*)(ws + WS_KF); const float* Vf = (const float*)(ws + WS_VF);
    const float* A0 = (const float*)(ws + WS_AD); const float* A1 = A0 + (size_t)MROWS * AW;
    const float* Y0 = (const float*)(ws + WS_Y); const float* Y1 = Y0 + (size_t)MROWS * AW;
    const float* G = (const float*)(ws + WS_G);
    bf16_t* YC = (bf16_t*)(ws + WS_YCAT);
    const float* lng = F.in[I_LNG] + (size_t)l * AW; const float* lnb = F.in[I_LNB] + (size_t)l * AW;
    const float* ka = F.in[I_KA] + (size_t)l * AW; const float* rk = F.in[I_RK] + (size_t)l * AW;
    for (int it = F.bid * 8 + F.wave; it < MROWS * 16; it += F.nb * 8) {
        const int row = it >> 4, head = it & 15, c = head * 64 + F.lane;
        const size_t o = (size_t)row * AW + c;
        const float y = Y0[o] + Y1[o];
        const float mu = wave_sum(y, F.lane) * (1.0f / 64.0f);
        const float dv = y - mu;
        const float var = wave_sum(dv * dv, F.lane) * (1.0f / 64.0f);
        const float yn = dv * rsqrtf(var + GN_EPS) * lng[c] + lnb[c];
        const float k = Kf[o], kac = ka[c];
        const float kmean = 0.5f * (k * (1.0f + (sigmoidf_(A0[o]) - 1.0f) * kac) + k * (1.0f + (sigmoidf_(A1[o]) - 1.0f) * kac));
        const float bsum = wave_sum(Rf[o] * kmean * rk[c], F.lane);
        const float outv = (yn + bsum * Vf[o]) * G[o];
        YC[(size_t)row * 3072 + c] = f2bf(outv);
    }
}

constexpr float NEG_BIG = -1.0e30f;
__device__ __forceinline__ float fexp2(float x) { return __builtin_amdgcn_exp2f(x); }
__device__ __forceinline__ bf16x8 tr_pair(const LAS unsigned char* p0, const LAS unsigned char* p1) {
    const bf16x4 a = __builtin_amdgcn_ds_read_tr16_b64_v4i16((LAS bf16x4*)p0), b = __builtin_amdgcn_ds_read_tr16_b64_v4i16((LAS bf16x4*)p1);
    return (bf16x8){a[0], a[1], a[2], a[3], b[0], b[1], b[2], b[3]};
}
template <int NKS> __device__ __forceinline__ void sm_update(f32x4 (&s)[NKS], float& m, float& l, float& alpha, int lane, float sc) {
    float mx = fmaxf(fmaxf(s[0][0], s[0][1]), fmaxf(s[0][2], s[0][3]));
#pragma unroll
    for (int k = 1; k < NKS; ++k) mx = fmaxf(fmaxf(mx, s[k][0]), fmaxf(fmaxf(s[k][1], s[k][2]), s[k][3]));
    mx = rows_max(mx);
    const float mn = fmaxf(m, mx * sc); alpha = fexp2(m - mn); m = mn;
    float sum = 0.f;
#pragma unroll
    for (int k = 0; k < NKS; ++k) {
#pragma unroll
        for (int j = 0; j < 4; ++j) { const float p = fexp2(__builtin_fmaf(s[k][j], sc, -mn)); s[k][j] = p; sum += p; } }
    l = l * alpha + sum;
}
__device__ __forceinline__ bf16x8 pack_p(const f32x4 a, const f32x4 b) {
    u32x4 w; w.x = cvt_pk_bf16(a[0], a[1]); w.y = cvt_pk_bf16(a[2], a[3]); w.z = cvt_pk_bf16(b[0], b[1]); w.w = cvt_pk_bf16(b[2], b[3]);
    return __builtin_bit_cast(bf16x8, w);
}

typedef float f32x16 __attribute__((ext_vector_type(16)));
constexpr int MA_KSTR = 400, MA_VSTR = 288, MA_KBUF = 64 * MA_KSTR, MA_VBUF = 64 * MA_VSTR;
constexpr int MA_K_OFF = 0, MA_V_OFF = 3 * MA_KBUF;
static_assert(MA_V_OFF + 3 * MA_VBUF <= LDS_BAR_OFF - 64, "MLA LDS map");
#define MFMA32(a, b, c) __builtin_amdgcn_mfma_f32_32x32x16_bf16(a, b, c, 0, 0, 0)

__device__ __forceinline__ void mla_unit(const Frame& F, int h, int q0, int key0, int ntiles) {
    unsigned char* ws = F.ws;
    const bf16_t* Q = (const bf16_t*)(ws + WS_Q); const bf16_t* KC = (const bf16_t*)(ws + WS_KC); const bf16_t* VC = (const bf16_t*)(ws + WS_VC);
    const float* rope = (const float*)(ws + WS_ROPE);
    bf16_t* YC = (bf16_t*)(ws + WS_YCAT);
    const int ql = F.lane & 31, hh = F.lane >> 5, qr = q0 + F.wave * 32 + ql;
    constexpr float SC = 0.07216878364870322f * LOG2E;
    bf16x8 Qf[12];
    {
        const bf16_t* qp = Q + (size_t)qr * 1536 + h * QHD;
#pragma unroll
        for (int ks = 0; ks < 8; ++ks) Qf[ks] = *(const bf16x8*)(qp + 16 * ks + 8 * hh);
#pragma unroll
        for (int ks = 8; ks < 12; ++ks) {
            const int d0 = 16 * ks + 8 * hh;
            const u32x4 own = *(const u32x4*)(qp + d0);
            if (qr < SEQ) {
                const u32x4 par = *(const u32x4*)(qp + d0 + ((ks & 1) ? -16 : 16));
                float xo[8], xp[8], o[8]; unpack8(own, xo); unpack8(par, xp);
                const float* rp = rope + ((size_t)qr * 32 + ((ks - 8) >> 1) * 16 + 8 * hh) * 2;
#pragma unroll
                for (int j = 0; j < 8; ++j) { const float cs = rp[2 * j], sn = rp[2 * j + 1]; o[j] = (ks & 1) ? (xp[j] * sn + xo[j] * cs) : (xo[j] * cs - xp[j] * sn); }
                Qf[ks] = __builtin_bit_cast(bf16x8, pack8(o));
            } else Qf[ks] = __builtin_bit_cast(bf16x8, own);
        }
    }
    f32x16 O[4];
#pragma unroll
    for (int dt = 0; dt < 4; ++dt) { const f32x4 z = zero4v();
#pragma unroll
        for (int r = 0; r < 16; ++r) O[dt][r] = z[r & 3]; }
    float m = NEG_BIG, l = 0.f;
    unsigned ko[4], vo[3];
#pragma unroll
    for (int i = 0; i < 4; ++i) { const int sl = ((i < 3) ? (F.wave + 8 * i) : 24) * 64 + F.lane, key = sl / 25, part = sl - key * 25;
        ko[i] = (unsigned)((key0 + key) * 1536 + h * 192 + ((part < 24) ? part : 0) * 8) * 2u; }
#pragma unroll
    for (int i = 0; i < 3; ++i) { const int sl = ((i < 2) ? (F.wave + 8 * i) : (16 + (F.wave & 1))) * 64 + F.lane, key = sl / 18, part = sl - key * 18;
        vo[i] = (unsigned)((key0 + key) * 1024 + h * 128 + ((part < 16) ? part : 0) * 8) * 2u; }
    const __amdgpu_buffer_rsrc_t rK = __builtin_amdgcn_make_buffer_rsrc((void*)KC, 0, 0x7ffffff0, 0x00020000), rV = __builtin_amdgcn_make_buffer_rsrc((void*)VC, 0, 0x7ffffff0, 0x00020000);
#define MLA_DMA(t_, slot_) do { const int ks_ = (t_) * (64 * 1536 * 2), vs_ = (t_) * (64 * 1024 * 2); \
        LAS unsigned char* kb_ = F.lds + MA_K_OFF + (slot_) * MA_KBUF; LAS unsigned char* vb_ = F.lds + MA_V_OFF + (slot_) * MA_VBUF; \
        _Pragma("unroll") for (int i = 0; i < 3; ++i) __builtin_amdgcn_raw_ptr_buffer_load_lds(rK, (LAS void*)(kb_ + (F.wave + 8 * i) * 1024), 16, ko[i], ks_, 0, 0); \
        if (F.wave == 6) __builtin_amdgcn_raw_ptr_buffer_load_lds(rK, (LAS void*)(kb_ + 24 * 1024), 16, ko[3], ks_, 0, 0); \
        _Pragma("unroll") for (int i = 0; i < 2; ++i) __builtin_amdgcn_raw_ptr_buffer_load_lds(rV, (LAS void*)(vb_ + (F.wave + 8 * i) * 1024), 16, vo[i], vs_, 0, 0); \
        if (F.wave == 4 || F.wave == 5) __builtin_amdgcn_raw_ptr_buffer_load_lds(rV, (LAS void*)(vb_ + (16 + (F.wave & 1)) * 1024), 16, vo[2], vs_, 0, 0); } while (0)
    __syncthreads();
    MLA_DMA(0, 0); MLA_DMA(1, 1);
    asm volatile("s_waitcnt vmcnt(0)" ::: "memory");
    lds_barrier();
    const int krd = ql * MA_KSTR + 16 * hh;
    const int vrd = (4 * hh + ((F.lane & 15) >> 2)) * MA_VSTR + (((F.lane >> 4) & 1) * 16 + (F.lane & 3) * 4) * 2;
    int sc = 0, sn2 = 2;
    for (int t = 0; t < ntiles; ++t) {
        if (t + 2 < ntiles) MLA_DMA(t + 2, sn2);
        const LAS unsigned char* kb = F.lds + MA_K_OFF + sc * MA_KBUF;
        const LAS unsigned char* vb = F.lds + MA_V_OFF + sc * MA_VBUF;
        f32x16 s[2];
#pragma unroll
        for (int kt = 0; kt < 2; ++kt) {
            { const f32x4 z = zero4v();
#pragma unroll
              for (int r = 0; r < 16; ++r) s[kt][r] = z[r & 3]; }
#pragma unroll
            for (int ks = 0; ks < 12; ++ks) { const bf16x8 kf = *(const LAS bf16x8*)(kb + krd + kt * 32 * MA_KSTR + ks * 32); s[kt] = MFMA32(kf, Qf[ks], s[kt]); }
        }
        float mx = fmaxf(fmaxf(s[0][0], s[0][1]), s[0][2]);
#pragma unroll
        for (int kt = 0; kt < 2; ++kt)
#pragma unroll
            for (int r = 0; r < 16; ++r) mx = fmaxf(mx, s[kt][r]);
        { const auto q2 = __builtin_amdgcn_permlane32_swap(__float_as_uint(mx), __float_as_uint(mx), false, false); mx = fmaxf(__uint_as_float(q2[0]), __uint_as_float(q2[1])); }
        const float mn = fmaxf(m, mx * SC), alpha = fexp2(m - mn); m = mn;
        float sum = 0.f;
#pragma unroll
        for (int kt = 0; kt < 2; ++kt)
#pragma unroll
            for (int r = 0; r < 16; ++r) { const float p = fexp2(__builtin_fmaf(s[kt][r], SC, -mn)); s[kt][r] = p; sum += p; }
        l = l * alpha + sum;
        if (__builtin_amdgcn_ballot_w64(alpha != 1.0f) != 0ull) {
#pragma unroll
            for (int dt = 0; dt < 4; ++dt) O[dt] = O[dt] * alpha; }
        bf16x8 Pf[2][2];
#pragma unroll
        for (int kt = 0; kt < 2; ++kt)
#pragma unroll
            for (int s2 = 0; s2 < 2; ++s2) { u32x4 w; w.x = cvt_pk_bf16(s[kt][8 * s2], s[kt][8 * s2 + 1]); w.y = cvt_pk_bf16(s[kt][8 * s2 + 2], s[kt][8 * s2 + 3]);
                w.z = cvt_pk_bf16(s[kt][8 * s2 + 4], s[kt][8 * s2 + 5]); w.w = cvt_pk_bf16(s[kt][8 * s2 + 6], s[kt][8 * s2 + 7]); Pf[kt][s2] = __builtin_bit_cast(bf16x8, w); }
#pragma unroll
        for (int kt = 0; kt < 2; ++kt)
#pragma unroll
            for (int s2 = 0; s2 < 2; ++s2)
#pragma unroll
                for (int dt = 0; dt < 4; ++dt) { const LAS unsigned char* vp = vb + vrd + (32 * kt + 16 * s2) * MA_VSTR + dt * 64;
                    const bf16x8 vf = tr_pair(vp, vp + 8 * MA_VSTR);
                    O[dt] = MFMA32(vf, Pf[kt][s2], O[dt]); }
        if (t + 2 < ntiles) { if (F.wave >= 4 && F.wave <= 6) asm volatile("s_waitcnt vmcnt(6)" ::: "memory"); else asm volatile("s_waitcnt vmcnt(5)" ::: "memory"); }
        else asm volatile("s_waitcnt vmcnt(0)" ::: "memory");
        lds_barrier();
        sc = (sc == 2) ? 0 : sc + 1; sn2 = (sn2 == 2) ? 0 : sn2 + 1;
    }
#undef MLA_DMA
    {
        float lt = l;
        { const auto q2 = __builtin_amdgcn_permlane32_swap(__float_as_uint(lt), __float_as_uint(lt), false, false); lt = __uint_as_float(q2[0]) + __uint_as_float(q2[1]); }
        const float inv = 1.0f / lt;
        bf16_t* op = YC + (size_t)qr * 3072 + 1024 + h * VDIM + 4 * hh;
#pragma unroll
        for (int dt = 0; dt < 4; ++dt)
#pragma unroll
            for (int rg = 0; rg < 4; ++rg) { u32x2 w; w.x = cvt_pk_bf16(O[dt][4 * rg] * inv, O[dt][4 * rg + 1] * inv); w.y = cvt_pk_bf16(O[dt][4 * rg + 2] * inv, O[dt][4 * rg + 3] * inv);
                *(u32x2*)(op + 32 * dt + 8 * rg) = w; }
    }
}

constexpr int NA_KSTR = 288, NA_VSTR = 288, NA_KBUF = 64 * NA_KSTR, NA_VBUF = 64 * NA_VSTR;
constexpr int NA_K_OFF = 0, NA_V_OFF = 3 * NA_KBUF, NA_RPB_OFF = NA_V_OFF + 3 * NA_VBUF;
static_assert(NA_RPB_OFF + 4096 <= LDS_BAR_OFF - 64, "NA LDS map");

__device__ __forceinline__ void na_unit(const Frame& F, int l, int gi, int hp) {
    unsigned char* ws = F.ws;
    const bf16_t* U = (const bf16_t*)(ws + WS_U);
    bf16_t* YC = (bf16_t*)(ws + WS_YCAT);
    const int qi = F.lane & 15, g = F.lane >> 4, g4 = F.wave & 3, hh = F.wave >> 2, h = hp * 2 + hh;
    const bool lat = gi < 128;
    const int r0 = lat ? min(max(gi - 4, 0), 120) : 0;
    const int np = lat ? 12 : 4;
    const int qr = (lat ? gi * 64 : SEQ + (gi - 128) * 64) + 16 * g4 + qi;
    constexpr float SC = 0.125f * LOG2E;
    bf16x8 Qf[2];
#pragma unroll
    for (int kk = 0; kk < 2; ++kk) Qf[kk] = *(const bf16x8*)(U + (size_t)qr * IN_COLS + NA_OFF + h * 64 + 32 * kk + 8 * g);
    f32x4 O[4];
#pragma unroll
    for (int dt = 0; dt < 4; ++dt) O[dt] = zero4v();
    float m = NEG_BIG, lsum = 0.f;
    unsigned ko[3], vo[3];
#pragma unroll
    for (int i = 0; i < 3; ++i) { const int sl = ((i < 2) ? (F.wave + 8 * i) : (16 + (F.wave & 1))) * 64 + F.lane, key = sl / 18, part = sl - key * 18;
        const unsigned e = (unsigned)(key * IN_COLS + NA_OFF + hp * 128 + ((part < 16) ? part : 0) * 8);
        ko[i] = (e + 1024u) * 2u; vo[i] = (e + 2048u) * 2u; }
    const __amdgpu_buffer_rsrc_t rU = __builtin_amdgcn_make_buffer_rsrc((void*)U, 0, 0x7ffffff0, 0x00020000);
#define NA_PIECE_ROW(p) ((lat && (p) < 8) ? (r0 + (p)) * 64 : SEQ + ((p) - (lat ? 8 : 0)) * 64)
#define NA_DMA(p_, slot_) do { const int so_ = NA_PIECE_ROW(p_) * (IN_COLS * 2); \
        LAS unsigned char* kb_ = F.lds + NA_K_OFF + (slot_) * NA_KBUF; LAS unsigned char* vb_ = F.lds + NA_V_OFF + (slot_) * NA_VBUF; \
        _Pragma("unroll") for (int i = 0; i < 2; ++i) { __builtin_amdgcn_raw_ptr_buffer_load_lds(rU, (LAS void*)(kb_ + (F.wave + 8 * i) * 1024), 16, ko[i], so_, 0, 0); \
            __builtin_amdgcn_raw_ptr_buffer_load_lds(rU, (LAS void*)(vb_ + (F.wave + 8 * i) * 1024), 16, vo[i], so_, 0, 0); } \
        if (F.wave < 2) { __builtin_amdgcn_raw_ptr_buffer_load_lds(rU, (LAS void*)(kb_ + (16 + F.wave) * 1024), 16, ko[2], so_, 0, 0); \
            __builtin_amdgcn_raw_ptr_buffer_load_lds(rU, (LAS void*)(vb_ + (16 + F.wave) * 1024), 16, vo[2], so_, 0, 0); } } while (0)
    __syncthreads();
    if (lat) { LAS float* rp = (LAS float*)(F.lds + NA_RPB_OFF); const float* src = F.in[I_RPB] + ((size_t)l * 16 + hp * 2) * 465;
        for (int i = F.tid; i < 930; i += NTHREADS) rp[i] = src[i] * LOG2E; }
    NA_DMA(0, 0); NA_DMA(1, 1);
    asm volatile("s_waitcnt vmcnt(0)" ::: "memory");
    lds_barrier();
    const int c0 = (g4 == 0) ? 0 : (g4 == 1 ? 8 : (g4 == 2 ? 24 : 32));
    const int qc = 16 * g4 + qi, cs_ = min(max(qc - 8, 0), 48);
    const int krd = qi * NA_KSTR + hh * 128 + 16 * g;
    const int vrd = (4 * g + (qi >> 2)) * NA_VSTR + hh * 128 + (qi & 3) * 8;
    const LAS float* rpb = (const LAS float*)(F.lds + NA_RPB_OFF) + hh * 465;
    int sc = 0, sn2 = 2;
    for (int p = 0; p < np; ++p) {
        if (p + 2 < np) NA_DMA(p + 2, sn2);
        const LAS unsigned char* kb = F.lds + NA_K_OFF + sc * NA_KBUF;
        const LAS unsigned char* vb = F.lds + NA_V_OFF + sc * NA_VBUF;
        const bool win = lat && p < 8;
        const int ntl = win ? 1 : 2;
        for (int tl = 0; tl < ntl; ++tl) {
            const int kbase = win ? c0 : tl * 32;
            f32x4 s[2];
#pragma unroll
            for (int ks = 0; ks < 2; ++ks) {
                s[ks] = zero4v();
#pragma unroll
                for (int kk = 0; kk < 2; ++kk) {
                    const bf16x8 kf = *(const LAS bf16x8*)(kb + krd + (kbase + ks * 16) * NA_KSTR + kk * 64);
                    s[ks] = __builtin_amdgcn_mfma_f32_16x16x32_bf16(kf, Qf[kk], s[ks], 0, 0, 0);
                }
            }
            if (win) {
                const int dr = (r0 + p) - gi + 7;
#pragma unroll
                for (int ks = 0; ks < 2; ++ks)
#pragma unroll
                    for (int j = 0; j < 4; ++j) {
                        const int cc = c0 + 16 * ks + 4 * g + j, rel = cc - cs_;
                        const bool valid = (rel >= 0) && (rel < 16);
                        const int bi = min(max(cc - qc + 15, 0), 30);
                        const float bias = rpb[dr * 31 + bi];
                        s[ks][j] = valid ? (s[ks][j] * SC + bias) : NEG_BIG;
                    }
            } else {
#pragma unroll
                for (int ks = 0; ks < 2; ++ks) s[ks] = s[ks] * SC;
            }
            float alpha; sm_update<2>(s, m, lsum, alpha, F.lane, 1.0f);
#pragma unroll
            for (int dt = 0; dt < 4; ++dt) O[dt] = O[dt] * alpha;
            const bf16x8 P = pack_p(s[0], s[1]);
#pragma unroll
            for (int dt = 0; dt < 4; ++dt) {
                const LAS unsigned char* vp = vb + vrd + kbase * NA_VSTR + dt * 32;
                const bf16x8 vf = tr_pair(vp, vp + 16 * NA_VSTR);
                O[dt] = __builtin_amdgcn_mfma_f32_16x16x32_bf16(vf, P, O[dt], 0, 0, 0);
            }
        }
        if (p + 2 < np) { if (F.wave < 2) asm volatile("s_waitcnt vmcnt(6)" ::: "memory"); else asm volatile("s_waitcnt vmcnt(4)" ::: "memory"); }
        else asm volatile("s_waitcnt vmcnt(0)" ::: "memory");
        lds_barrier();
        sc = (sc == 2) ? 0 : sc + 1; sn2 = (sn2 == 2) ? 0 : sn2 + 1;
    }
#undef NA_DMA
#undef NA_PIECE_ROW
    const float lt = rows_sum(lsum);
    const float inv = 1.0f / lt;
    bf16_t* op = YC + (size_t)qr * 3072 + 2048 + h * 64 + 4 * g;
#pragma unroll
    for (int dt = 0; dt < 4; ++dt) { const f32x4 o = O[dt] * inv; u32x2 w; w.x = cvt_pk_bf16(o[0], o[1]); w.y = cvt_pk_bf16(o[2], o[3]); *(u32x2*)(op + dt * 16) = w; }
}

__device__ __forceinline__ void attn_phase(const Frame& F, int l, int flags) {
    if (!(flags & 2)) {
        for (int u = F.bid; u < 256; u += F.nb) mla_unit(F, u & 7, (u >> 3) * 256, 0, MROWS / 64);
        for (int v = F.nb - 1 - F.bid; v < 8; v += F.nb) mla_unit(F, v, SEQ, SEQ, CTXL / 64);
    }
    if (!(flags & 4)) {
        unsigned* q = (unsigned*)(F.ws + WS_CTL) + 8192 + l * 64;
        volatile LAS unsigned* slot = (volatile LAS unsigned*)(F.lds + LDS_BAR_OFF - 64);
        for (;;) {
            __syncthreads();
            if (F.tid == 0) *slot = __hip_atomic_fetch_add(q, 1u, __ATOMIC_RELAXED, __HIP_MEMORY_SCOPE_AGENT);
            __syncthreads();
            const int u = (int)*slot;
            if (u >= 1056) break;
            na_unit(F, l, u >> 3, u & 7);
        }
    }
}

constexpr int CH_NCH = MROWS / 64;
constexpr int CH_NTASK = 32 * CH_NCH;
constexpr int CS = 144;
constexpr int CF = 68;
constexpr int CIMG = 64 * CS;
constexpr int O_KT = 0, O_RT = CIMG, O_BH = 2 * CIMG, O_KH = 3 * CIMG, O_V = 4 * CIMG, O_BB = 5 * CIMG  , O_KB = 6 * CIMG  ,
              O_AAK = 7 * CIMG  , O_ARB = 8 * CIMG, O_ARK = 9 * CIMG, O_T = 10 * CIMG, O_AF = 11 * CIMG, O_TF = O_AF + 64 * CF * 4, O_TOT = O_TF + 64 * CF * 4,
              O_GL = O_TOT + 8 * 64 * 4, O_CHEND = O_GL + 256;
static_assert(O_CHEND <= LDS_BAR_OFF, "chunk LDS map");

__device__ __forceinline__ bf16x8 ch_rowread(const LAS unsigned char* img, int tile, int ks, int qi, int g) {
    return *(const LAS bf16x8*)(img + (16 * tile + qi) * CS + (32 * ks + 8 * g) * 2);
}
__device__ __forceinline__ bf16x8 ch_trread(const LAS unsigned char* img, int tile, int ks, int qi, int g) {
    const LAS unsigned char* p = img + (32 * ks + 8 * g + (qi >> 2)) * CS + (16 * tile + 4 * (qi & 3)) * 2;
    return tr_pair(p, p + 4 * CS);
}
__device__ __forceinline__ void ch_store_bf16(LAS unsigned char* img, int tr, int tc, int qi, int g, const f32x4 v) {
#pragma unroll
    for (int jj = 0; jj < 4; ++jj) *(LAS bf16_t*)(img + (16 * tr + 4 * g + jj) * CS + (16 * tc + qi) * 2) = f2bf(v[jj]);
}
#define MFMA_BF(a, b, c) __builtin_amdgcn_mfma_f32_16x16x32_bf16(a, b, c, 0, 0, 0)
#define MFMA_F32(a, b, c) __builtin_amdgcn_mfma_f32_16x16x4f32(a, b, c, 0, 0, 0)

__device__ __forceinline__ void rwkvA_phase(const Frame& F, int l) {
    unsigned char* ws = F.ws;
    const float* Rf = (const float*)(ws + WS_RF); const float* Kf = (const float*)(ws + WS_KF); const float* Vf = (const float*)(ws + WS_VF);
    float* MN = (float*)(ws + WS_MN); bf16_t* RY = (bf16_t*)(ws + WS_RY);
    const int qi = F.lane & 15, g = F.lane >> 4, tr = F.wave >> 1, tcb = (F.wave & 1) * 2;
    LAS unsigned char* L = F.lds;
    LAS float* Af = (LAS float*)(L + O_AF); LAS float* Tf = (LAS float*)(L + O_TF); LAS float* tot = (LAS float*)(L + O_TOT); LAS float* gL = (LAS float*)(L + O_GL);
    float pk_[8], pv_[8], pr_[8], pza_[8], pzw_[8];
#define RA_LOAD(task_) do { const int hd_ = (task_) / CH_NCH, c_ = (task_) - hd_ * CH_NCH, dir_ = hd_ & 1; \
        const size_t o0_ = (size_t)scan_row(dir_, c_ * 64 + F.wave * 8) * AW + (hd_ >> 1) * 64 + F.lane; const int ds_ = dir_ ? -AW : AW;        \
        const float* kp_ = Kf + o0_; const float* vp_ = Vf + o0_; const float* rp_ = Rf + o0_; \
        const float* zw_ = (const float*)(ws + WS_WD) + (size_t)dir_ * MROWS * AW + o0_; const float* za_ = (const float*)(ws + WS_AD) + (size_t)dir_ * MROWS * AW + o0_; \
        _Pragma("unroll") for (int e = 0; e < 8; ++e) { pk_[e] = kp_[e * ds_]; pv_[e] = vp_[e * ds_]; pr_[e] = rp_[e * ds_]; pza_[e] = za_[e * ds_]; pzw_[e] = zw_[e * ds_]; } } while (0)
    if (F.bid < CH_NTASK) RA_LOAD(F.bid);
    for (int task = F.bid; task < CH_NTASK; task += F.nb) {
        const f32x4 z4 = zero4v();
        const int hd = task / CH_NCH, c = task - hd * CH_NCH, head = hd >> 1, dir = hd & 1;
        const int ch = head * 64 + F.lane;
        const float kkc = F.in[I_KK][(size_t)l * AW + ch], kac = F.in[I_KA][(size_t)l * AW + ch];
        {
            float kk_[8], b_[8], kd_[8], r_[8], lw_[8], cl_[8];
            float run = 0.f;
#pragma unroll
            for (int e = 0; e < 8; ++e) {
                const int i = F.wave * 8 + e;
                const float k = pk_[e], a = sigmoidf_(pza_[e]);
                lw_[e] = -0.6065306597126334f * sigmoidf_(pzw_[e]);
                r_[e] = pr_[e];
                const float kkr = k * kkc;
                const float nrm = sqrtf(wave_sum(kkr * kkr, F.lane));
                kk_[e] = kkr * __builtin_amdgcn_rcpf(fmaxf(nrm, 1e-12f));
                b_[e] = kk_[e] * a;
                kd_[e] = k * (1.0f + (a - 1.0f) * kac);
                run += lw_[e]; cl_[e] = run;
                *(LAS bf16_t*)(L + O_V + i * CS + F.lane * 2) = f2bf(pv_[e]);
            }
            if (task + F.nb < CH_NTASK) RA_LOAD(task + F.nb);
            tot[F.wave * 64 + F.lane] = run;
            lds_barrier();
            float off = 0.f, all = 0.f;
#pragma unroll
            for (int w = 0; w < 8; ++w) { const float t = tot[w * 64 + F.lane]; all += t; off += (w < F.wave) ? t : 0.f; }
            if (F.wave == 0) gL[F.lane] = __expf(all);
#pragma unroll
            for (int e = 0; e < 8; ++e) {
                const int i = F.wave * 8 + e;
                const float cum = off + cl_[e], cumm = cum - lw_[e];
                const float ec = __expf(cum), em = __expf(cumm), ei = __expf(-cum), eh = __expf(all - cum);
                const int o = i * CS + F.lane * 2;
                *(LAS bf16_t*)(L + O_KT + o) = f2bf(kk_[e] * em);
                *(LAS bf16_t*)(L + O_RT + o) = f2bf(r_[e] * ec);
                *(LAS bf16_t*)(L + O_BB + o) = f2bf(b_[e] * ei);
                *(LAS bf16_t*)(L + O_KB + o) = f2bf(kd_[e] * ei);
                *(LAS bf16_t*)(L + O_BH + o) = f2bf(b_[e] * eh);
                *(LAS bf16_t*)(L + O_KH + o) = f2bf(kd_[e] * eh);
            }
        }
        lds_barrier();
        {
            f32x4 ab[2] = {z4, z4}, ak[2] = {z4, z4}, rb[2] = {z4, z4}, rk[2] = {z4, z4};
#pragma unroll
            for (int ks = 0; ks < 2; ++ks) {
                const bf16x8 aK = ch_rowread(L + O_KT, tr, ks, qi, g), aR = ch_rowread(L + O_RT, tr, ks, qi, g);
#pragma unroll
                for (int t = 0; t < 2; ++t) {
                    const bf16x8 bB = ch_rowread(L + O_BB, tcb + t, ks, qi, g), bK = ch_rowread(L + O_KB, tcb + t, ks, qi, g);
                    ab[t] = MFMA_BF(aK, bB, ab[t]); ak[t] = MFMA_BF(aK, bK, ak[t]); rb[t] = MFMA_BF(aR, bB, rb[t]); rk[t] = MFMA_BF(aR, bK, rk[t]);
                }
            }
#pragma unroll
            for (int t = 0; t < 2; ++t) {
                const int col = 16 * (tcb + t) + qi;
#pragma unroll
                for (int jj = 0; jj < 4; ++jj) {
                    const int row = 16 * tr + 4 * g + jj;
                    const bool lo = col < row, le = col <= row;
                    Af[row * CF + col] = lo ? ab[t][jj] : 0.f;
                    ak[t][jj] = lo ? ak[t][jj] : 0.f; rb[t][jj] = le ? rb[t][jj] : 0.f; rk[t][jj] = le ? rk[t][jj] : 0.f;
                }
                ch_store_bf16(L + O_AAK, tr, tcb + t, qi, g, ak[t]); ch_store_bf16(L + O_ARB, tr, tcb + t, qi, g, rb[t]); ch_store_bf16(L + O_ARK, tr, tcb + t, qi, g, rk[t]);
            }
        }
        lds_barrier();
        if (F.wave == 0) {
            float t[16];
#pragma unroll
            for (int i = 0; i < 16; ++i) {
                float acc = (i == qi) ? 1.f : 0.f;
                f32x4 ar[4];
#pragma unroll
                for (int q = 0; q < (i + 3) / 4; ++q) ar[q] = *(const LAS f32x4*)(Af + (16 * g + i) * CF + 16 * g + 4 * q);
#pragma unroll
                for (int j = 0; j < i; ++j) acc -= ar[j >> 2][j & 3] * t[j];
                t[i] = acc;
            }
#pragma unroll
            for (int i = 0; i < 16; ++i) Tf[(16 * g + i) * CF + 16 * g + qi] = t[i];
        }
        lds_barrier();
#pragma unroll 1
        for (int d = 1; d < 4; ++d) {
            if (F.wave < 4 - d) {
                const int bp = F.wave, b = bp + d;
                f32x4 X = z4;
                for (int bb = bp; bb < b; ++bb) {
#pragma unroll
                    for (int s = 0; s < 4; ++s) X = MFMA_F32(Af[(16 * b + qi) * CF + 16 * bb + 4 * s + g], Tf[(16 * bb + 4 * s + g) * CF + 16 * bp + qi], X);
                }
                f32x4 R = z4;
#pragma unroll
                for (int s = 0; s < 4; ++s) R = MFMA_F32(Tf[(16 * b + qi) * CF + 16 * b + 4 * g + s], X[s], R);
#pragma unroll
                for (int jj = 0; jj < 4; ++jj) Tf[(16 * b + 4 * g + jj) * CF + 16 * bp + qi] = -R[jj];
            }
            lds_barrier();
        }
        for (int idx = F.tid; idx < 4096; idx += NTHREADS) { const int row = idx >> 6, col = idx & 63;
            *(LAS bf16_t*)(L + O_T + row * CS + col * 2) = f2bf(((col >> 4) > (row >> 4)) ? 0.f : Tf[row * CF + col]); }
        lds_barrier();
        {
            f32x4 av[2] = {z4, z4}, p[2] = {z4, z4};
#pragma unroll
            for (int ks = 0; ks < 2; ++ks) {
                const bf16x8 aA = ch_rowread(L + O_AAK, tr, ks, qi, g), aT = ch_rowread(L + O_T, tr, ks, qi, g);
#pragma unroll
                for (int t = 0; t < 2; ++t) { av[t] = MFMA_BF(aA, ch_trread(L + O_V, tcb + t, ks, qi, g), av[t]); p[t] = MFMA_BF(aT, ch_trread(L + O_KT, tcb + t, ks, qi, g), p[t]); }
            }
#pragma unroll
            for (int t = 0; t < 2; ++t) { ch_store_bf16(L + O_BB, tr, tcb + t, qi, g, av[t]); ch_store_bf16(L + O_KB, tr, tcb + t, qi, g, p[t]); }
        }
        lds_barrier();
        {
            f32x4 q[2] = {z4, z4};
#pragma unroll
            for (int ks = 0; ks < 2; ++ks) {
                const bf16x8 aT = ch_rowread(L + O_T, tr, ks, qi, g);
#pragma unroll
                for (int t = 0; t < 2; ++t) q[t] = MFMA_BF(aT, ch_trread(L + O_BB, tcb + t, ks, qi, g), q[t]);
            }
#pragma unroll
            for (int t = 0; t < 2; ++t) ch_store_bf16(L + O_AAK, tr, tcb + t, qi, g, q[t]);
        }
        lds_barrier();
        {
            f32x4 m[2] = {z4, z4}, n1[2] = {z4, z4}, n2[2] = {z4, z4}, ry[2] = {z4, z4}, y1[2] = {z4, z4}, y2[2] = {z4, z4};
#pragma unroll
            for (int ks = 0; ks < 2; ++ks) {
                const bf16x8 aPt = ch_trread(L + O_KB, tr, ks, qi, g), aVt = ch_trread(L + O_V, tr, ks, qi, g), aQt = ch_trread(L + O_AAK, tr, ks, qi, g);
                const bf16x8 aRb = ch_rowread(L + O_ARB, tr, ks, qi, g), aRk = ch_rowread(L + O_ARK, tr, ks, qi, g);
#pragma unroll
                for (int t = 0; t < 2; ++t) {
                    const bf16x8 bBh = ch_trread(L + O_BH, tcb + t, ks, qi, g), bKh = ch_trread(L + O_KH, tcb + t, ks, qi, g);
                    const bf16x8 bP = ch_trread(L + O_KB, tcb + t, ks, qi, g), bV = ch_trread(L + O_V, tcb + t, ks, qi, g), bQ = ch_trread(L + O_AAK, tcb + t, ks, qi, g);
                    m[t] = MFMA_BF(aPt, bBh, m[t]); n1[t] = MFMA_BF(aVt, bKh, n1[t]); n2[t] = MFMA_BF(aQt, bBh, n2[t]);
                    ry[t] = MFMA_BF(aRb, bP, ry[t]); y1[t] = MFMA_BF(aRk, bV, y1[t]); y2[t] = MFMA_BF(aRb, bQ, y2[t]);
                }
            }
            const int lo = (16 * tr + 4 * g) * 64 + 16 * tcb + qi;
            float* Np = MN + (size_t)task * 2 * 4096 + 4096 + lo;
            bf16_t* MTh = (bf16_t*)(MN + (size_t)task * 2 * 4096); bf16_t* MTl = MTh + 4096;
            bf16_t* Rp = RY + (size_t)task * 4096 + lo;
            const LAS bf16_t* Rt = (const LAS bf16_t*)(L + O_RT + (16 * tr + 4 * g) * CS + (16 * tcb + qi) * 2);
            const int dstep = (dir == 0) ? AW : -AW;
            float* Yp = (float*)(ws + WS_Y) + (size_t)dir * MROWS * AW + (size_t)scan_row(dir, c * 64 + 16 * tr + 4 * g) * AW + head * 64 + 16 * tcb + qi;
#pragma unroll
            for (int t = 0; t < 2; ++t) {
#pragma unroll
                for (int jj = 0; jj < 4; ++jj) {
                    const bool dg = (16 * tr + 4 * g + jj) == (16 * (tcb + t) + qi);
                    m[t][jj] = (dg ? gL[16 * (tcb + t) + qi] : 0.f) - m[t][jj];
                    Np[jj * 64 + t * 16] = n1[t][jj] - n2[t][jj];
                    Rp[jj * 64 + t * 16] = f2bf(bf2f(Rt[jj * (CS / 2) + t * 16]) - ry[t][jj]);
                    Yp[jj * dstep + t * 16] = y1[t][jj] - y2[t][jj];
                }
                float hi_[4];
#pragma unroll
                for (int jj = 0; jj < 4; ++jj) hi_[jj] = bf2f(f2bf(m[t][jj]));
                u32x2 wh, wl; wh.x = cvt_pk_bf16(hi_[0], hi_[1]); wh.y = cvt_pk_bf16(hi_[2], hi_[3]);
                wl.x = cvt_pk_bf16(m[t][0] - hi_[0], m[t][1] - hi_[1]); wl.y = cvt_pk_bf16(m[t][2] - hi_[2], m[t][3] - hi_[3]);
                const int mo_ = (16 * (tcb + t) + qi) * 64 + 32 * (tr >> 1) + 8 * g + 4 * (tr & 1);
                *(u32x2*)(MTh + mo_) = wh; *(u32x2*)(MTl + mo_) = wl;
            }
        }
        lds_barrier();
    }
}

#undef RA_LOAD
constexpr int RB_BLOCKS = 32;
constexpr int RB_SLOT = 32768;
__device__ __forceinline__ void rwkvB_phase(const Frame& F) {
    if (F.bid >= RB_BLOCKS) return;
    unsigned char* ws = F.ws;
    bf16_t* SC = (bf16_t*)(ws + WS_SC);
    const int qi = F.lane & 15, g = F.lane >> 4, hd = F.bid, vt = F.wave & 3;
    const bool loader = F.wave >= 4;
    const __amdgpu_buffer_rsrc_t rM = __builtin_amdgcn_make_buffer_rsrc((void*)(ws + WS_MN), 0, 0x7ffffff0, 0x00020000);
    const unsigned lo_ = (unsigned)(F.lane * 16);
#define RB_DMA(c_) do { const int so_ = (hd * CH_NCH + (c_)) * RB_SLOT; LAS unsigned char* sb_ = F.lds + ((c_) & 3) * RB_SLOT; \
        _Pragma("unroll") for (int i = 0; i < 8; ++i) __builtin_amdgcn_raw_ptr_buffer_load_lds(rM, (LAS void*)(sb_ + (vt + 4 * i) * 1024), 16, lo_ + (unsigned)((vt + 4 * i) * 1024), so_, 0, 0); } while (0)
    __syncthreads();
    if (loader) { RB_DMA(0); RB_DMA(1); RB_DMA(2); asm volatile("s_waitcnt vmcnt(16)" ::: "memory"); }
    lds_barrier();
    f32x4 T[4];
#pragma unroll
    for (int kt = 0; kt < 4; ++kt) T[kt] = zero4v();
    for (int c = 0; c < CH_NCH; ++c) {
        if (loader) {
            if (c + 3 < CH_NCH) { RB_DMA(c + 3); asm volatile("s_waitcnt vmcnt(16)" ::: "memory"); }
            else asm volatile("s_waitcnt vmcnt(0)" ::: "memory");
        } else {
            const LAS unsigned char* sb = F.lds + (c & 3) * RB_SLOT;
            bf16_t* Sg = SC + (size_t)(hd * CH_NCH + c) * 4096 + (16 * vt + qi) * 64 + 4 * g;
            bf16x8 bh[2], bl[2];
#pragma unroll
            for (int ks = 0; ks < 2; ++ks) {
                u32x4 wh, wl;
#pragma unroll
                for (int h = 0; h < 2; ++h) {
                    const f32x4 x = T[2 * ks + h];
                    float xh[4];
#pragma unroll
                    for (int j = 0; j < 4; ++j) xh[j] = bf2f(f2bf(x[j]));
                    const unsigned h0 = cvt_pk_bf16(xh[0], xh[1]), h1 = cvt_pk_bf16(xh[2], xh[3]);
                    const unsigned l0 = cvt_pk_bf16(x[0] - xh[0], x[1] - xh[1]), l1 = cvt_pk_bf16(x[2] - xh[2], x[3] - xh[3]);
                    if (h == 0) { wh.x = h0; wh.y = h1; wl.x = l0; wl.y = l1; } else { wh.z = h0; wh.w = h1; wl.z = l0; wl.w = l1; }
                    u32x2 sv; sv.x = h0; sv.y = h1; *(u32x2*)(Sg + 16 * (2 * ks + h)) = sv;
                }
                bh[ks] = __builtin_bit_cast(bf16x8, wh); bl[ks] = __builtin_bit_cast(bf16x8, wl);
            }
#pragma unroll
            for (int kt = 0; kt < 4; ++kt) {
                f32x4 acc = *(const LAS f32x4*)(sb + 16384 + ((16 * vt + qi) * 64 + 16 * kt + 4 * g) * 4);
#pragma unroll
                for (int ks = 0; ks < 2; ++ks) {
                    const bf16x8 ah = *(const LAS bf16x8*)(sb + ((16 * kt + qi) * 64 + 32 * ks + 8 * g) * 2);
                    const bf16x8 al = *(const LAS bf16x8*)(sb + 8192 + ((16 * kt + qi) * 64 + 32 * ks + 8 * g) * 2);
                    acc = MFMA_BF(ah, bh[ks], acc); acc = MFMA_BF(ah, bl[ks], acc); acc = MFMA_BF(al, bh[ks], acc);
                }
                T[kt] = acc;
            }
        }
        lds_barrier();
    }
#undef RB_DMA
}

__device__ __forceinline__ void rwkvC_readout_phase(const Frame& F, int l) {
    unsigned char* ws = F.ws;
    const bf16_t* RY = (const bf16_t*)(ws + WS_RY); const bf16_t* SC = (const bf16_t*)(ws + WS_SC);
    const float* Rf = (const float*)(ws + WS_RF); const float* Kf = (const float*)(ws + WS_KF); const float* Vf = (const float*)(ws + WS_VF);
    const float* Z0 = (const float*)(ws + WS_AD); const float* Z1 = Z0 + (size_t)MROWS * AW;
    const float* Y0 = (const float*)(ws + WS_Y); const float* Y1 = Y0 + (size_t)MROWS * AW;
    const float* G = (const float*)(ws + WS_G);
    bf16_t* YC = (bf16_t*)(ws + WS_YCAT);
    const int qi = F.lane & 15, g = F.lane >> 4;
    for (int qtask = F.bid * 8 + F.wave; qtask < CH_NCH * 16 * 4; qtask += F.nb * 8) {
        const int task = qtask >> 2, tr = qtask & 3;
        const int rb = task >> 4, head = task & 15, R0 = rb * 64;
        const int cf = (R0 >= SEQ) ? (R0 - SEQ) / 64 : (R0 + CTXL) / 64, cb = (MROWS - 64 - R0) / 64;
        const int tf = (head * 2) * CH_NCH + cf, tb = (head * 2 + 1) * CH_NCH + cb;
        f32x4 y[1][4];
        {
            bf16x8 bS[4][2];
#pragma unroll
            for (int tc = 0; tc < 4; ++tc)
#pragma unroll
                for (int ks = 0; ks < 2; ++ks) bS[tc][ks] = *(const bf16x8*)(SC + (size_t)tf * 4096 + (16 * tc + qi) * 64 + 32 * ks + 8 * g);
            {
                const bf16_t* ap = RY + (size_t)tf * 4096 + (16 * tr + qi) * 64 + 8 * g;
                const bf16x8 a0 = *(const bf16x8*)ap, a1 = *(const bf16x8*)(ap + 32);
#pragma unroll
                for (int tc = 0; tc < 4; ++tc) { f32x4 acc = zero4v(); acc = MFMA_BF(a0, bS[tc][0], acc); y[0][tc] = MFMA_BF(a1, bS[tc][1], acc); }
            }
#pragma unroll
            for (int tc = 0; tc < 4; ++tc)
#pragma unroll
                for (int ks = 0; ks < 2; ++ks) bS[tc][ks] = *(const bf16x8*)(SC + (size_t)tb * 4096 + (16 * tc + qi) * 64 + 32 * ks + 8 * g);
            {
                const bf16_t* ap = RY + (size_t)tb * 4096 + (63 - (16 * tr + qi)) * 64 + 8 * g;
                const bf16x8 a0 = *(const bf16x8*)ap, a1 = *(const bf16x8*)(ap + 32);
#pragma unroll
                for (int tc = 0; tc < 4; ++tc) { f32x4 acc = y[0][tc]; acc = MFMA_BF(a0, bS[tc][0], acc); y[0][tc] = MFMA_BF(a1, bS[tc][1], acc); }
            }
        }
        const float* lng = F.in[I_LNG] + (size_t)l * AW + head * 64; const float* lnb = F.in[I_LNB] + (size_t)l * AW + head * 64;
        const float* ka = F.in[I_KA] + (size_t)l * AW + head * 64; const float* rk = F.in[I_RK] + (size_t)l * AW + head * 64;
        float lg[4], lb[4], kav[4], rkv[4];
#pragma unroll
        for (int tc = 0; tc < 4; ++tc) { lg[tc] = lng[16 * tc + qi]; lb[tc] = lnb[16 * tc + qi]; kav[tc] = ka[16 * tc + qi]; rkv[tc] = rk[16 * tc + qi]; }
        {
            float a_y0[4][4], a_y1[4][4], a_k[4][4], a_z0[4][4], a_z1[4][4], a_r[4][4], a_v[4][4], a_g[4][4];
#pragma unroll
            for (int jj = 0; jj < 4; ++jj) {
                const size_t o = (size_t)(R0 + 16 * tr + 4 * g + jj) * AW + head * 64 + qi;
#pragma unroll
                for (int tc = 0; tc < 4; ++tc) { a_y0[jj][tc] = Y0[o + 16 * tc]; a_y1[jj][tc] = Y1[o + 16 * tc]; a_k[jj][tc] = Kf[o + 16 * tc]; a_z0[jj][tc] = Z0[o + 16 * tc];
                    a_z1[jj][tc] = Z1[o + 16 * tc]; a_r[jj][tc] = Rf[o + 16 * tc]; a_v[jj][tc] = Vf[o + 16 * tc]; a_g[jj][tc] = G[o + 16 * tc]; }
            }
            asm volatile("" ::: "memory");
#pragma unroll
            for (int jj = 0; jj < 4; ++jj) {
                const int row = R0 + 16 * tr + 4 * g + jj;
                float yv[4], s1 = 0.f, bs = 0.f;
#pragma unroll
                for (int tc = 0; tc < 4; ++tc) {
                    yv[tc] = y[0][tc][jj] + a_y0[jj][tc] + a_y1[jj][tc]; s1 += yv[tc];
                    const float kmean = a_k[jj][tc] * (1.0f + (0.5f * (sigmoidf_(a_z0[jj][tc]) + sigmoidf_(a_z1[jj][tc])) - 1.0f) * kav[tc]);
                    bs += a_r[jj][tc] * kmean * rkv[tc];
                }
                s1 = dpp_allsum16(s1); bs = dpp_allsum16(bs);
                const float mu = s1 * (1.0f / 64.0f);
                float s2 = 0.f;
#pragma unroll
                for (int tc = 0; tc < 4; ++tc) { yv[tc] -= mu; s2 += yv[tc] * yv[tc]; }
                s2 = dpp_allsum16(s2);
                const float rstd = rsqrtf(s2 * (1.0f / 64.0f) + GN_EPS);
#pragma unroll
                for (int tc = 0; tc < 4; ++tc) {
                    const float outv = (yv[tc] * rstd * lg[tc] + lb[tc] + bs * a_v[jj][tc]) * a_g[jj][tc];
                    YC[(size_t)row * 3072 + head * 64 + 16 * tc + qi] = f2bf(outv);
                }
            }
        }
    }
}


#ifndef PROBE_PHASE
#define PROBE_PHASE -1
#endif
#define REP(k) for (int rep_ = 0; rep_ < ((PROBE_PHASE == (k)) ? 2 : 1); ++rep_)
constexpr int NPH = 12;
constexpr int PH_TOTAL = 2 + DEPTH * NPH;

__global__ void __launch_bounds__(NTHREADS, 2) fwd_kernel(Args args) {
    extern __shared__ __attribute__((aligned(16))) unsigned char lds_raw[];
    Frame F;
    F.lds = (LAS unsigned char*)lds_raw;
    F.tid = threadIdx.x; F.lane = F.tid & 63; F.wave = __builtin_amdgcn_readfirstlane(F.tid >> 6);
    F.bid = blockIdx.x; F.nb = gridDim.x;
    F.in = args.in; F.ws = args.ws; F.out = args.out;
    unsigned char* ws = args.ws;
    const int lo = args.ph_lo, hi = args.ph_hi;
    const bool multi = (hi - lo) > 1;
    volatile LAS unsigned* bst = (volatile LAS unsigned*)(F.lds + LDS_BAR_OFF);
    if (F.tid < 4) bst[F.tid] = 0u;
    __syncthreads();
    XcdBarrier bar; bar.bar = (unsigned*)(ws + WS_CTL); bar.x = 0; bar.st = bst;
    if (multi) bar = xcd_barrier_post((unsigned*)(ws + WS_CTL), bst);
#define IN(k) (lo <= (k) && (k) < hi)
#define FRESH() do { asm volatile("v_mbcnt_lo_u32_b32 %0, -1, 0\n\tv_mbcnt_hi_u32_b32 %0, -1, %0" : "=v"(F.lane)); asm volatile("" : "+s"(F.wave), "+s"(F.bid), "+s"(F.nb)); \
    F.tid = F.wave * 64 + F.lane; asm volatile("" : "+s"(F.ws), "+s"(F.out)); ws = F.ws; } while (0)
#define SEAM(k) do { if (IN(k) && IN((k) + 1)) { asm volatile("" : "+s"(bar.x)); xcd_barrier(bar); } } while (0)

    if (IN(0)) { FRESH(); p0_prologue(F); }
    SEAM(0);

    for (int l = 0; l < DEPTH; ++l) {
        const int pb = 1 + l * NPH;
        if (IN(pb + 0)) REP(0) { FRESH(); norm_phase(F, l, 0, (const float*)(ws + WS_P2), l > 0 ? 32 : 0); }
        SEAM(pb + 0);
        if (IN(pb + 1)) REP(1) { FRESH();
            pg8::Gemm g{(const bf16_t*)(ws + WS_H), (const bf16_t*)(ws + WS_WIN) + (size_t)l * IN_COLS * D, MROWS, IN_COLS, D, D, D};
            pg8::StaticOrder S; S.init(MROWS, IN_COLS, F.nb, F.bid);
            pg8::EpiBf16<0> E{(bf16_t*)(ws + WS_U), IN_COLS};
            pg8::gemm_phase(F.lds, g, S, E, F.tid);
        }
        SEAM(pb + 1);
        if (IN(pb + 2)) REP(2) { FRESH(); prep1_phase(F, l); }
        SEAM(pb + 2);
        if (IN(pb + 3)) REP(3) { FRESH();
            {
                pg8::Gemm g{(const bf16_t*)(ws + WS_LA), (const bf16_t*)(ws + WS_WLORA) + (size_t)l * 5120 * 256, 5 * MROWS, 5120, 256, 256, 256};
                pg8::LoraOrder S; S.init(F.nb, F.bid);
                pg8::EpiLora E{(float*)(ws + WS_WD), (const float*)(ws + WS_LBIAS) + (size_t)l * 5 * AW};
                pg8::gemm_phase(F.lds, g, S, E, F.tid);
            }
            FRESH();
            {
                pg8::Gemm g{(const bf16_t*)(ws + WS_QL), (const bf16_t*)(ws + WS_WUQ) + (size_t)l * 1536 * 512, MROWS, 1536, 512, 512, 512};
                pg8::StaticOrder S; S.init(MROWS, 1536, F.nb, F.bid);
                pg8::EpiBf16<0> E{(bf16_t*)(ws + WS_Q), 1536};
                pg8::gemm_phase(F.lds, g, S, E, F.tid);
            }
            FRESH();
            {
                pg8::Gemm g{(const bf16_t*)(ws + WS_KVL), (const bf16_t*)(ws + WS_WUKV) + (size_t)l * 2048 * 256, MROWS, 2048, 256, 256, 256};
                pg8::StaticOrder S; S.init(MROWS, 2048, F.nb, F.bid);
                pg8::EpiKV E{(bf16_t*)(ws + WS_KC), (bf16_t*)(ws + WS_VC)};
                pg8::gemm_phase(F.lds, g, S, E, F.tid);
            }
        }
        SEAM(pb + 3);
        if (IN(pb + 4)) REP(4) { FRESH(); rwkvA_phase(F, l); }
        SEAM(pb + 4);
        if (IN(pb + 5)) REP(5) { FRESH(); if (!(args.flags & 1)) rwkvB_phase(F); FRESH(); attn_phase(F, l, args.flags); }
        SEAM(pb + 5);
        if (IN(pb + 6)) REP(6) { FRESH(); rwkvC_readout_phase(F, l); }
        SEAM(pb + 6);
        if (IN(pb + 7)) REP(7) { FRESH();
            { pg8::Gemm g{(const bf16_t*)(ws + WS_YCAT), (const bf16_t*)(ws + WS_WB) + (size_t)l * D * 3072, SEQ, D, 3072, 3072, 3072};
              pg8::StaticOrder S; S.init(SEQ, D, F.nb, F.bid);
              pg8::EpiMerge E{(bf16_t*)(ws + WS_MRGB), (const bf16_t*)(ws + WS_U) + GATE_OFF};
              pg8::gemm_phase<pg8::EpiMerge, pg8::StaticOrder, 16>(F.lds, g, S, E, F.tid); }
            FRESH();
            if (l < DEPTH - 1)
            { pg8::Gemm g{(const bf16_t*)(ws + WS_YCAT) + (size_t)SEQ * 3072, (const bf16_t*)(ws + WS_WB) + (size_t)l * D * 3072, 3 * 256, D, 1024, 3072, 3072, 2048, -1, 2048};
              pg8::StaticOrder S; S.init(3 * 256, D, F.nb, F.nb - 1 - F.bid);
              pg8::EpiPartial<1> E{(float*)(ws + WS_PM), nullptr, (const bf16_t*)(ws + WS_U) + (size_t)SEQ * IN_COLS + GATE_OFF};
              pg8::gemm_phase(F.lds, g, S, E, F.tid); }
        }
        SEAM(pb + 7);
        if (IN(pb + 8)) REP(8) { FRESH();
            const float* mod = (const float*)(ws + WS_MOD) + (size_t)l * 2 * 6 * D;
            { pg8::Gemm g{(const bf16_t*)(ws + WS_MRGB), (const bf16_t*)(ws + WS_WO) + (size_t)l * D * D, SEQ, D, D, D, D};
              pg8::StaticOrder S; S.init(SEQ, D, F.nb, F.bid);
              pg8::EpiResid E{(float*)(ws + ((args.flags & 8) ? WS_Y : WS_X)), mod + 2 * D, mod + 6 * D + 2 * D};
              pg8::gemm_phase(F.lds, g, S, E, F.tid); }
            FRESH();
            {
                const int cu = F.nb - 1 - F.bid;
                if (cu < 64 && l < DEPTH - 1) {
                    pg8::StaticOrder S; S.init(8 * 256, D, F.nb, cu);
                    pg8::Unit u0; S.next(0, u0);
                    bf16_t* scr = (bf16_t*)(ws + WS_CSCR) + (size_t)cu * 65536;
                    const float* src = (const float*)(ws + WS_PM) + u0.pm * 256;
                    for (int i = F.tid; i < 256 * 64; i += NTHREADS) { const int r = i >> 6, c4 = (i & 63) * 4; f32x4 v = *(const f32x4*)(src + (size_t)r * D + c4);
#pragma unroll
                        for (int s = 1; s < 3; ++s) v += *(const f32x4*)(src + (size_t)s * CTXL * D + (size_t)r * D + c4);
                        u32x2 w; w.x = cvt_pk_bf16(v[0], v[1]); w.y = cvt_pk_bf16(v[2], v[3]); *(u32x2*)(scr + r * 256 + c4) = w; }
                    __builtin_amdgcn_fence(__ATOMIC_RELEASE, "agent"); asm volatile("s_waitcnt vmcnt(0)" ::: "memory"); __syncthreads();
                    __builtin_amdgcn_fence(__ATOMIC_ACQUIRE, "agent"); asm volatile("s_waitcnt vmcnt(0)" ::: "memory");
                    pg8::Gemm g{scr, (const bf16_t*)(ws + WS_WO) + (size_t)l * D * D, 8 * 256, D, 256, 256, D, 0, -1, 512};
                    pg8::EpiPartial<0> E{(float*)(ws + WS_PO), mod + 6 * D + 2 * D, nullptr};
                    pg8::gemm_phase(F.lds, g, S, E, F.tid);
                }
            }
        }
        SEAM(pb + 8);
        if (IN(pb + 9)) REP(9) { FRESH(); norm_phase(F, l, 1, (const float*)(ws + WS_PO), l < DEPTH - 1 ? 8 : 0); }
        SEAM(pb + 9);
        if (IN(pb + 10)) REP(10) { FRESH();
            const int mrows = (l < DEPTH - 1) ? MROWS : SEQ;
            pg8::Gemm g{(const bf16_t*)(ws + WS_H), (const bf16_t*)(ws + WS_W1) + (size_t)l * DFF * D, mrows, DFF, D, D, D};
            pg8::StaticOrder S; S.init(mrows, DFF, F.nb, F.bid);
            pg8::EpiBf16<1> E{(bf16_t*)(ws + WS_U), DFF};
            pg8::gemm_phase(F.lds, g, S, E, F.tid);
        }
        SEAM(pb + 10);
        if (IN(pb + 11)) REP(11) { FRESH();
            const float* mod = (const float*)(ws + WS_MOD) + (size_t)l * 2 * 6 * D;
            { pg8::Gemm g{(const bf16_t*)(ws + WS_U), (const bf16_t*)(ws + WS_W2) + (size_t)l * D * DFF, SEQ, D, DFF, DFF, DFF};
              pg8::StaticOrder S; S.init(SEQ, D, F.nb, F.bid);
              pg8::EpiResid E{(float*)(ws + ((args.flags & 8) ? WS_Y : WS_X)), mod + 5 * D, mod + 6 * D + 5 * D};
              pg8::gemm_phase(F.lds, g, S, E, F.tid); }
            FRESH();
            if (l < DEPTH - 1)
            { pg8::Gemm g{(const bf16_t*)(ws + WS_U) + (size_t)SEQ * DFF, (const bf16_t*)(ws + WS_W2) + (size_t)l * D * DFF, 32 * 256, D, 256, DFF, DFF, 512, -1, 512};
              pg8::StaticOrder S; S.init(32 * 256, D, F.nb, F.nb - 1 - F.bid);
              pg8::EpiPartial<0> E{(float*)(ws + WS_P2), mod + 6 * D + 5 * D, nullptr};
              pg8::gemm_phase(F.lds, g, S, E, F.tid); }
        }
        SEAM(pb + 11);
    }
    if (IN(PH_TOTAL - 1)) { FRESH(); final_norm_phase(F); }
#undef IN
#undef SEAM
}

#ifndef HOST_PROBE_FLAGS
#define HOST_PROBE_FLAGS 0
#endif
#ifndef HOST_PROBE_PHASE
#define HOST_PROBE_PHASE -1
#endif
#ifndef N_LAUNCH_MODE
#define N_LAUNCH_MODE 1
#endif
extern "C" void kernel_launch(void* const* d_in, const int* in_sizes, int n_in, void* d_out, int out_size, void* d_ws, size_t ws_size, hipStream_t stream) {
    static int grid = 0;
    if (grid == 0) {
        if (n_in != 30 || out_size != SEQ * D || ws_size < WS_END) { fprintf(stderr, "kernel_launch: unexpected shapes (n_in %d out %d ws %zu need %zu)\n", n_in, out_size, ws_size, (size_t)WS_END); grid = -1; return; }
        int dev = 0, cus = 0, per_cu = 0;
        if (hipGetDevice(&dev) != hipSuccess || hipDeviceGetAttribute(&cus, hipDeviceAttributeMultiprocessorCount, dev) != hipSuccess) { grid = -1; return; }
        if (hipFuncSetAttribute((const void*)fwd_kernel, hipFuncAttributeMaxDynamicSharedMemorySize, LDS_BYTES) != hipSuccess) { fprintf(stderr, "kernel_launch: hipFuncSetAttribute failed\n"); grid = -1; return; }
        if (hipOccupancyMaxActiveBlocksPerMultiprocessor(&per_cu, (const void*)fwd_kernel, NTHREADS, LDS_BYTES) != hipSuccess || per_cu < 1) { fprintf(stderr, "kernel_launch: occupancy query says %d\n", per_cu); (void)hipGetLastError(); grid = -1; return; }
        grid = cus;
    }
    if (grid < 0) return;
    (void)hipMemsetAsync((char*)d_ws + WS_CTL, 0, CTL_BYTES, stream);
    Args a{};
    for (int i = 0; i < 30; ++i) a.in[i] = (const float*)d_in[i];
    a.out = (float*)d_out; a.ws = (unsigned char*)d_ws;
#if N_LAUNCH_MODE == 1
    a.ph_lo = 0; a.ph_hi = PH_TOTAL;
    hipLaunchKernelGGL(fwd_kernel, dim3(grid), dim3(NTHREADS), LDS_BYTES, stream, a);
#else
    for (int p = 0; p < PH_TOTAL; ++p) { a.ph_lo = p; a.ph_hi = p + 1;
        const int reps = ((p >= 1 && p < PH_TOTAL - 1 && ((p - 1) % NPH) == HOST_PROBE_PHASE) || (p == 0 && HOST_PROBE_PHASE == 100)) ? 2 : 1;
        for (int r = 0; r < reps; ++r) { a.flags = (r == 1) ? HOST_PROBE_FLAGS : 0; hipLaunchKernelGGL(fwd_kernel, dim3(grid), dim3(NTHREADS), LDS_BYTES, stream, a); } }
#endif
}
```

```cpp
#include <hip/hip_runtime.h>
#include <cstdio>
#include <cstdint>

#define LAS __attribute__((address_space(3)))
typedef unsigned short bf16_t;
typedef short bf16x8 __attribute__((ext_vector_type(8)));
typedef short bf16x4 __attribute__((ext_vector_type(4)));
typedef float f32x4 __attribute__((ext_vector_type(4)));
typedef float f32x2 __attribute__((ext_vector_type(2)));
typedef unsigned u32x4 __attribute__((ext_vector_type(4)));
typedef unsigned u32x2 __attribute__((ext_vector_type(2)));

constexpr int D = 2048, SEQ = 8192, CTXL = 256, MROWS = SEQ + CTXL, DEPTH = 4, GRIDW = 64;
constexpr int IN_COLS = 13568, RWKV_COLS = 3712, MLA_OFF = 3712, NA_OFF = 4352, GATE_OFF = 7424, DFF = 8192;
constexpr int AW = 1024;
constexpr int QLORA = 448, KVLORA = 128, QKROPE = 64, QKNOPE = 128, VDIM = 128, BHEADS = 8, QHD = 192;
constexpr float RMS_EPS = 1e-6f, GN_EPS = 64e-5f;
constexpr float LOG2E = 1.4426950408889634f;

constexpr size_t al256(size_t x) { return (x + 255) & ~(size_t)255; }
constexpr size_t WS_CTL = 0;
constexpr size_t CTL_BYTES = 65536;
constexpr size_t WS_MOD = WS_CTL + CTL_BYTES;
constexpr size_t WS_LBIAS = al256(WS_MOD + (size_t)DEPTH * 2 * 6 * D * 4);
constexpr size_t WS_ROPE = al256(WS_LBIAS + (size_t)DEPTH * 5 * AW * 4);
constexpr size_t WS_X = al256(WS_ROPE + (size_t)SEQ * 32 * 2 * 4);
constexpr size_t WS_H = al256(WS_X + (size_t)MROWS * D * 4);
constexpr size_t WS_U = al256(WS_H + (size_t)MROWS * D * 2);
constexpr size_t WS_WIN = al256(WS_U + (size_t)MROWS * IN_COLS * 2);
constexpr size_t WS_W1 = al256(WS_WIN + (size_t)DEPTH * IN_COLS * D * 2);
constexpr size_t WS_W2 = al256(WS_W1 + (size_t)DEPTH * DFF * D * 2);
constexpr size_t WS_WB = al256(WS_W2 + (size_t)DEPTH * DFF * D * 2);
constexpr size_t WS_WO = al256(WS_WB + (size_t)DEPTH * D * 3072 * 2);
constexpr size_t WS_WUQ = al256(WS_WO + (size_t)DEPTH * D * D * 2);
constexpr size_t WS_WUKV = al256(WS_WUQ + (size_t)DEPTH * 1536 * 512 * 2);
constexpr size_t WS_WLORA = al256(WS_WUKV + (size_t)DEPTH * 2048 * 256 * 2);
constexpr size_t WS_RF = al256(WS_WLORA + (size_t)DEPTH * 5120 * 256 * 2);
constexpr size_t WS_KF = al256(WS_RF + (size_t)MROWS * AW * 4);
constexpr size_t WS_VF = al256(WS_KF + (size_t)MROWS * AW * 4);
constexpr size_t WS_WD = al256(WS_VF + (size_t)MROWS * AW * 4);
constexpr size_t WS_AD = al256(WS_WD + (size_t)2 * MROWS * AW * 4);
constexpr size_t WS_G = al256(WS_AD + (size_t)2 * MROWS * AW * 4);
constexpr size_t WS_Y = al256(WS_G + (size_t)MROWS * AW * 4);
constexpr size_t WS_LA = al256(WS_Y + (size_t)2 * MROWS * AW * 4);
constexpr size_t WS_QL = al256(WS_LA + (size_t)MROWS * 1280 * 2);
constexpr size_t WS_KVL = al256(WS_QL + (size_t)MROWS * 512 * 2);
constexpr size_t WS_KPE = al256(WS_KVL + (size_t)MROWS * 256 * 2);
constexpr size_t WS_Q = WS_KPE;
constexpr size_t WS_KC = al256(WS_Q + (size_t)MROWS * 1536 * 2);
constexpr size_t WS_VC = al256(WS_KC + (size_t)MROWS * 1536 * 2);
constexpr size_t WS_YCAT = al256(WS_VC + (size_t)MROWS * 1024 * 2);
constexpr size_t WS_MRG = WS_RF;
constexpr size_t WS_MRGB = al256(WS_YCAT + (size_t)MROWS * 3072 * 2);
constexpr size_t WS_MN = al256(WS_MRGB + (size_t)MROWS * D * 2);
constexpr size_t WS_RY = al256(WS_MN + (size_t)4224 * 2 * 4096 * 4);
constexpr size_t WS_SC = al256(WS_RY + (size_t)4224 * 4096 * 2);
constexpr size_t WS_CSCR = al256(WS_SC + (size_t)4224 * 4096 * 2);
constexpr size_t WS_PM = WS_MN;
constexpr size_t WS_PO = WS_PM + (size_t)12 * CTXL * D * 4;
constexpr size_t WS_P2 = WS_PO + (size_t)8 * CTXL * D * 4;
static_assert(WS_P2 + (size_t)32 * CTXL * D * 4 <= WS_RY, "partial slabs must fit the MN buffer");
constexpr size_t WS_END = al256(WS_CSCR + (size_t)64 * 65536 * 2);
static_assert(WS_KF == WS_RF + (size_t)MROWS * AW * 4, "MRG alias needs r|k contiguous");

constexpr int LDS_BYTES = 147456;
constexpr int LDS_BAR_OFF = LDS_BYTES - 16;
constexpr int NTHREADS = 512;

typedef __bf16 bf16x2n __attribute__((ext_vector_type(2)));
__device__ __forceinline__ unsigned cvt_pk_bf16(float lo, float hi) { return __builtin_bit_cast(unsigned, __builtin_convertvector((f32x2){lo, hi}, bf16x2n)); }
__device__ __forceinline__ bf16_t f2bf(float f) { return __builtin_bit_cast(bf16_t, (__bf16)f); }
__device__ __forceinline__ float bf2f(bf16_t h) { return __uint_as_float(((unsigned)h) << 16); }
__device__ __forceinline__ float bflo(unsigned w) { return __uint_as_float(w << 16); }
__device__ __forceinline__ float bfhi(unsigned w) { return __uint_as_float(w & 0xFFFF0000u); }
__device__ __forceinline__ float sigmoidf_(float x) { return __builtin_amdgcn_rcpf(1.0f + __expf(-x)); }
__device__ __forceinline__ void unpack8(const u32x4 w, float (&f)[8]) { f[0] = bflo(w.x); f[1] = bfhi(w.x); f[2] = bflo(w.y); f[3] = bfhi(w.y); f[4] = bflo(w.z); f[5] = bfhi(w.z); f[6] = bflo(w.w); f[7] = bfhi(w.w); }
__device__ __forceinline__ u32x4 pack8(const float (&f)[8]) { u32x4 w; w.x = cvt_pk_bf16(f[0], f[1]); w.y = cvt_pk_bf16(f[2], f[3]); w.z = cvt_pk_bf16(f[4], f[5]); w.w = cvt_pk_bf16(f[6], f[7]); return w; }

__device__ __forceinline__ void lds_barrier() { asm volatile("s_waitcnt lgkmcnt(0)\n\ts_barrier" ::: "memory"); }
__device__ __forceinline__ f32x4 zero4v() { f32x4 z = (f32x4){0.f, 0.f, 0.f, 0.f}; asm volatile("" : "+v"(z)); return z; }
__device__ __forceinline__ float shx(float v, int m, int lane) { return __int_as_float(__builtin_amdgcn_ds_bpermute((lane ^ m) << 2, __float_as_int(v))); }
__device__ __forceinline__ float rows_max(float x) {
    const auto r = __builtin_amdgcn_permlane16_swap(__float_as_uint(x), __float_as_uint(x), false, false); x = fmaxf(__uint_as_float(r[0]), __uint_as_float(r[1]));
    const auto q = __builtin_amdgcn_permlane32_swap(__float_as_uint(x), __float_as_uint(x), false, false); return fmaxf(__uint_as_float(q[0]), __uint_as_float(q[1]));
}
__device__ __forceinline__ float rows_sum(float x) {
    const auto r = __builtin_amdgcn_permlane16_swap(__float_as_uint(x), __float_as_uint(x), false, false); x = __uint_as_float(r[0]) + __uint_as_float(r[1]);
    const auto q = __builtin_amdgcn_permlane32_swap(__float_as_uint(x), __float_as_uint(x), false, false); return __uint_as_float(q[0]) + __uint_as_float(q[1]);
}
__device__ __forceinline__ float wave_sum(float x, int  ) {
    x += __int_as_float(__builtin_amdgcn_update_dpp(0, __float_as_int(x), 0xB1, 0xF, 0xF, true));
    x += __int_as_float(__builtin_amdgcn_update_dpp(0, __float_as_int(x), 0x4E, 0xF, 0xF, true));
    x += __int_as_float(__builtin_amdgcn_update_dpp(0, __float_as_int(x), 0x141, 0xF, 0xF, true));
    x += __int_as_float(__builtin_amdgcn_update_dpp(0, __float_as_int(x), 0x140, 0xF, 0xF, true));
    const int xi = __float_as_int(x);
    return (__int_as_float(__builtin_amdgcn_readlane(xi, 0)) + __int_as_float(__builtin_amdgcn_readlane(xi, 16))) +
           (__int_as_float(__builtin_amdgcn_readlane(xi, 32)) + __int_as_float(__builtin_amdgcn_readlane(xi, 48)));
}

#define XB_TMO      128
#define XB_XCNT(j)  (256  + 64 * (j))
#define XB_XSUB(j)  (1280 + 64 * (j))
#define XB_XGEN(j)  (2304 + 64 * (j))
#define XB_TOP      3328
#define XB_TOPGEN   3392
#define XCD_BAR_WORDS 3456
#define XB_SPIN_CAP (1u << 22)

__device__ __forceinline__ unsigned xb_ld(unsigned* p)              { return __hip_atomic_load(p, __ATOMIC_RELAXED, __HIP_MEMORY_SCOPE_AGENT); }
__device__ __forceinline__ unsigned xb_add(unsigned* p, unsigned v) { return __hip_atomic_fetch_add(p, v, __ATOMIC_RELAXED, __HIP_MEMORY_SCOPE_AGENT); }
__device__ __forceinline__ unsigned xb_xcc_id() { return (unsigned)__builtin_amdgcn_s_getreg((3 << 11) | 20) & 0xFu; }
#define XB_SPIN(cond, bar) do { unsigned _sp = 0; while (cond) { __builtin_amdgcn_s_sleep(1); \
    if ((++_sp & 255u) == 0u) { if (xb_ld(&(bar)[XB_TMO])) break; if (_sp > XB_SPIN_CAP) { atomicAdd(&(bar)[XB_TMO], 1u); break; } } } } while (0)

struct XcdBarrier { unsigned* bar; unsigned x; volatile LAS unsigned* st; };

__device__ __forceinline__ XcdBarrier xcd_barrier_post(unsigned* bar, volatile LAS unsigned* st) {
    XcdBarrier b; b.bar = bar; b.x = xb_xcc_id(); b.st = st;
    if (threadIdx.x == 0) (void)xb_add(&bar[XB_XCNT(b.x)], 1u);
    return b;
}
__device__ __forceinline__ void xcd_barrier_complete(unsigned* bar, unsigned x, unsigned& nloc, unsigned& nx) {
    const unsigned G = gridDim.x * gridDim.y * gridDim.z;
    unsigned sum, cnt, mine, sp = 0u;
    for (;;) {
        sum = 0u; cnt = 0u; mine = 0u;
#pragma unroll
        for (unsigned j = 0; j < 16; ++j) { const unsigned c = xb_ld(&bar[XB_XCNT(j)]); sum += c; cnt += (c > 0u) ? 1u : 0u; mine = (j == x) ? c : mine; }
        if (sum == G) break;
        __builtin_amdgcn_s_sleep(1);
        if ((++sp & 255u) == 0u) { if (xb_ld(&bar[XB_TMO])) break; if (sp > XB_SPIN_CAP) { atomicAdd(&bar[XB_TMO], 1u); break; } }
    }
    nloc = mine > 0u ? mine : 1u; nx = cnt > 0u ? cnt : 1u;
}
__device__ __forceinline__ void xcd_barrier(const XcdBarrier& b) {
    asm volatile("s_waitcnt vmcnt(0)" ::: "memory");
    __syncthreads();
    if (threadIdx.x == 0) {
        unsigned* bar = b.bar;
        __builtin_amdgcn_s_waitcnt(0);
        unsigned nloc = b.st[0], nx = b.st[1];
        if (nloc == 0u) { xcd_barrier_complete(bar, b.x, nloc, nx); b.st[0] = nloc; b.st[1] = nx; }
        const unsigned old = xb_add(&bar[XB_XSUB(b.x)], 1u);
        const unsigned gen = old / nloc;
        if (old + 1u == (gen + 1u) * nloc) {
            __builtin_amdgcn_fence(__ATOMIC_RELEASE, "agent");
            asm volatile("s_waitcnt vmcnt(0)" ::: "memory");
            const unsigned og = xb_add(&bar[XB_TOP], 1u);
            const unsigned tg = og / nx;
            if (og + 1u == (tg + 1u) * nx) xb_add(&bar[XB_TOPGEN], 1u);
            else XB_SPIN(xb_ld(&bar[XB_TOPGEN]) == tg, bar);
            __builtin_amdgcn_fence(__ATOMIC_ACQUIRE, "agent");
            xb_add(&bar[XB_XGEN(b.x)], 1u);
            asm volatile("s_waitcnt vmcnt(0)" ::: "memory");
        } else {
            XB_SPIN(xb_ld(&bar[XB_XGEN(b.x)]) == gen, bar);
            __builtin_amdgcn_fence(__ATOMIC_ACQUIRE, "agent");
            asm volatile("s_waitcnt vmcnt(0)" ::: "memory");
        }
    }
    __syncthreads();
}

namespace pg8 {
constexpr int BM = 256, BK = 64, HALF = 128, HTB = HALF * BK * 2, STAGE_BYTES = 8 * HTB, NXCD = 8, WGM = 4;
__host__ __device__ __forceinline__ int lds_byte(int r, int c) { const int st = (r >> 4) * 2 + (c >> 5), rr = r & 15, cc = c & 31, ob = rr * 64 + cc * 2; return st * 1024 + (ob ^ (((ob >> 9) & 1) << 5)); }
__host__ __device__ __forceinline__ void stage_rc(int b, int& R, int& C) { const int st = b / 1024, sb = b % 1024, swz = sb ^ (((sb >> 9) & 1) << 5); R = (st >> 1) * 16 + swz / 64; C = (st & 1) * 32 + (swz % 64) / 2; }
__host__ __device__ __forceinline__ int perm32(int rho) { const int n = rho >> 4, i = rho & 15; return 8 * (i >> 2) + 4 * n + (i & 3); }

struct Unit { int pm, pn; };
struct Gemm { const bf16_t* A; const bf16_t* Bt; int M, N, K, lda, ldb;
    long pstepA = -1, pstepB = -1, qstepB = 0; };

struct StaticOrder {
    int nM, nN, nwg, G, c;
    __device__ __forceinline__ void init(int M, int N, int G_, int c_) { nM = M / BM; nN = N / BM; nwg = nM * nN; G = G_; c = c_; }
    __device__ __forceinline__ bool next(int i, Unit& u) const {
        const long L = (long)i * G + c; if (L >= nwg) return false;
        int wgid = (int)L; { const int q = nwg / NXCD, r = nwg % NXCD, xcd = wgid % NXCD, off = wgid / NXCD; wgid = (xcd < r ? xcd * (q + 1) : r * (q + 1) + (xcd - r) * q) + off; }
        const int nig = WGM * nN, gid = wgid / nig, fm = gid * WGM, gsz = (nM - fm) < WGM ? (nM - fm) : WGM;
        u.pm = fm + ((wgid % nig) % gsz); u.pn = (wgid % nig) / gsz; return true;
    }
};

struct LoraOrder {
    int G, c;
    __device__ __forceinline__ void init(int G_, int c_) { G = G_; c = c_; }
    __device__ __forceinline__ bool next(int i, Unit& u) const {
        const int L = i * G + c; if (L >= 5 * 132) return false;
        const int grp = L / 132, r = L - grp * 132;
        u.pm = grp * (MROWS / 256) + (r % (MROWS / 256)); u.pn = grp * 4 + r / (MROWS / 256); return true;
    }
};

template <class Epi, class Sched, int MIDK = 0, bool ALIGN_EPI = true>
__device__ __forceinline__ void gemm_phase(LAS unsigned char* lds, const Gemm g, const Sched& S, const Epi& E, const int tid) {
    const int wid = __builtin_amdgcn_readfirstlane(tid >> 6), lane = tid & 63, wr = wid >> 2, wc = wid & 3, fr = lane & 15, fq = lane >> 4;
    int nt = g.K / BK; asm volatile("" : "+s"(nt));
    unsigned voffA[2], voffB[2];
#pragma unroll
    for (int i = 0; i < 2; ++i) { int R, C; stage_rc(tid * 16 + i * 8192, R, C); const int Rb = Epi::PERM ? ((R & ~31) + perm32(R & 31)) : R;
        voffA[i] = (unsigned)(R * g.lda + C) * 2u; voffB[i] = (unsigned)(Rb * g.ldb + C) * 2u; }
    const size_t kstep = (size_t)(BK * 2);
    const size_t hstepA = (size_t)HALF * g.lda * 2, hstepB = (size_t)HALF * g.ldb * 2;
    const size_t tstepA = g.pstepA < 0 ? 2 * hstepA : (size_t)g.pstepA, tstepB = g.pstepB < 0 ? 2 * hstepB : (size_t)g.pstepB, qB = (size_t)g.qstepB;
    const unsigned ldsw = (unsigned)wid * 1024u;
    const int aoff = lds_byte(wr * 64 + fr, fq * 8), boff = lds_byte(wc * 32 + fr, fq * 8);
#define PG8_SA(b, h) (((b) * 2 + (h)) * HTB)
#define PG8_SB(b, h) ((4 + (b) * 2 + (h)) * HTB)
#define PG8_STAGE(bufoff, gbase, voff) do { _Pragma("unroll") for (int _i = 0; _i < 2; ++_i) \
        __builtin_amdgcn_global_load_lds((const unsigned*)((const char*)(gbase) + (voff)[_i]), (LAS unsigned*)(lds + (bufoff) + ldsw + _i * 8192), 16, 0, 0); } while (0)
#define PG8_LDA(dst, b, h) do { _Pragma("unroll") for (int m = 0; m < 4; ++m) _Pragma("unroll") for (int k = 0; k < 2; ++k) dst[m][k] = *(const LAS bf16x8*)(lds + PG8_SA(b, h) + aoff + m * 2048 + k * 1024); } while (0)
#define PG8_LDB(dst, b, h) do { _Pragma("unroll") for (int n = 0; n < 2; ++n) _Pragma("unroll") for (int k = 0; k < 2; ++k) dst[n][k] = *(const LAS bf16x8*)(lds + PG8_SB(b, h) + boff + n * 2048 + k * 1024); } while (0)
#define PG8_MMA(ai, bj, At, Bt) do { __builtin_amdgcn_s_setprio(1); _Pragma("unroll") for (int m = 0; m < 4; ++m) _Pragma("unroll") for (int n = 0; n < 2; ++n) _Pragma("unroll") for (int k = 0; k < 2; ++k) \
        acc[ai][bj][m][n] = __builtin_amdgcn_mfma_f32_16x16x32_bf16(Bt[n][k], At[m][k], acc[ai][bj][m][n], 0, 0, 0); __builtin_amdgcn_s_setprio(0); } while (0)
#define PG8_WAIT_V(n) asm volatile("s_waitcnt vmcnt(" #n ")" ::: "memory")
#define PG8_WAIT_L(n) asm volatile("s_waitcnt lgkmcnt(" #n ")" ::: "memory")
#define PG8_BAR __builtin_amdgcn_s_barrier()
#define PG8_SCHED __builtin_amdgcn_sched_barrier(0)
    Unit cur, nxt; int ui = 0;
    if (!S.next(0, cur)) return;
    f32x4 acc[2][2][4][2];
#pragma unroll
    for (int a = 0; a < 2; ++a)
#pragma unroll
        for (int b = 0; b < 2; ++b)
#pragma unroll
            for (int m = 0; m < 4; ++m)
#pragma unroll
                for (int n = 0; n < 2; ++n) acc[a][b][m][n] = zero4v();
    bf16x8 At[4][2], B0[2][2], B1[2][2];
    const char* cA = (const char*)g.A + (size_t)cur.pm * tstepA; const char* cB = (const char*)g.Bt + (size_t)cur.pn * tstepB + (size_t)cur.pm * qB;
    PG8_STAGE(PG8_SB(0, 0), cB, voffB); PG8_STAGE(PG8_SB(0, 1), cB + hstepB, voffB); PG8_STAGE(PG8_SA(0, 0), cA, voffA); PG8_STAGE(PG8_SA(0, 1), cA + hstepA, voffA);
    if (wr == 1) PG8_BAR;
    PG8_WAIT_V(2); PG8_BAR;
    PG8_STAGE(PG8_SB(1, 0), cB + kstep, voffB); PG8_STAGE(PG8_SA(1, 0), cA + kstep, voffA); PG8_STAGE(PG8_SB(1, 1), cB + hstepB + kstep, voffB);
    PG8_WAIT_V(6); PG8_BAR;
    for (;;) {
        const bool has_next = S.next(ui + 1, nxt);
        const char* nA = has_next ? (const char*)g.A + (size_t)nxt.pm * tstepA : cA; const char* nB = has_next ? (const char*)g.Bt + (size_t)nxt.pn * tstepB + (size_t)nxt.pm * qB : cB;
        for (int t = 0; t < nt; t += 2) {
            const bool last = (t == nt - 2);
            const char* a1 = cA + (size_t)(t + 1) * kstep;
            const char* a2 = last ? nA : cA + (size_t)(t + 2) * kstep; const char* b2 = last ? nB : cB + (size_t)(t + 2) * kstep;
            const char* a3 = a2 + kstep; const char* b3 = b2 + kstep;
            PG8_LDB(B0, 0, 0); PG8_LDB(B1, 0, 1); PG8_SCHED; PG8_LDA(At, 0, 0); PG8_STAGE(PG8_SA(1, 1), a1 + hstepA, voffA);
            PG8_WAIT_V(8); PG8_WAIT_L(0); PG8_BAR; PG8_MMA(0, 0, At, B0); PG8_MMA(0, 1, At, B1); PG8_BAR; PG8_SCHED;
            PG8_LDA(At, 0, 1); PG8_STAGE(PG8_SB(0, 0), b2, voffB); PG8_STAGE(PG8_SB(0, 1), b2 + hstepB, voffB); PG8_STAGE(PG8_SA(0, 0), a2, voffA);
            PG8_WAIT_V(8); PG8_WAIT_L(0); PG8_BAR; PG8_MMA(1, 0, At, B0); PG8_MMA(1, 1, At, B1); PG8_BAR; PG8_SCHED;
            PG8_LDB(B0, 1, 0); PG8_LDB(B1, 1, 1); PG8_SCHED; PG8_LDA(At, 1, 0); PG8_STAGE(PG8_SA(0, 1), a2 + hstepA, voffA);
            PG8_WAIT_V(8); PG8_WAIT_L(0); PG8_BAR; PG8_MMA(0, 0, At, B0); PG8_MMA(0, 1, At, B1); PG8_BAR; PG8_SCHED;
            PG8_LDA(At, 1, 1); PG8_STAGE(PG8_SB(1, 0), b3, voffB); PG8_STAGE(PG8_SB(1, 1), b3 + hstepB, voffB); PG8_STAGE(PG8_SA(1, 0), a3, voffA);
            PG8_WAIT_V(8); PG8_WAIT_L(0); PG8_BAR; PG8_MMA(1, 0, At, B0); PG8_MMA(1, 1, At, B1); PG8_BAR; PG8_SCHED;
            if constexpr (MIDK > 0) { if (((t + 2) % MIDK) == 0 && t + 2 < nt) { int ln_; asm volatile("v_mbcnt_lo_u32_b32 %0, -1, 0\n\tv_mbcnt_hi_u32_b32 %0, -1, %0" : "=v"(ln_)); E.mid(acc, cur, (t + 2) / MIDK - 1, wr, wc, ln_ & 15, ln_ >> 4); } }
        }
        if constexpr (ALIGN_EPI) { if (wr == 0) PG8_BAR; }
        { int ln_; asm volatile("v_mbcnt_lo_u32_b32 %0, -1, 0\n\tv_mbcnt_hi_u32_b32 %0, -1, %0" : "=v"(ln_)); E(acc, cur, wr, wc, ln_ & 15, ln_ >> 4); }
        if (!has_next) break;
#pragma unroll
        for (int a = 0; a < 2; ++a)
#pragma unroll
            for (int b = 0; b < 2; ++b)
#pragma unroll
                for (int m = 0; m < 4; ++m)
#pragma unroll
                    for (int n = 0; n < 2; ++n) acc[a][b][m][n] = zero4v();
        cur = nxt; cA = nA; cB = nB; ++ui;
        if constexpr (ALIGN_EPI) { if (wr == 1) PG8_BAR; }
    }
    PG8_WAIT_V(0);
    if constexpr (!ALIGN_EPI) { if (wr == 0) PG8_BAR; }
    PG8_BAR;
#undef PG8_SA
#undef PG8_SB
#undef PG8_STAGE
#undef PG8_LDA
#undef PG8_LDB
#undef PG8_MMA
#undef PG8_WAIT_V
#undef PG8_WAIT_L
#undef PG8_BAR
#undef PG8_SCHED
}

template <int ACT  > struct EpiBf16 {
    static constexpr bool PERM = true;
    bf16_t* O; int ldc;
    __device__ __forceinline__ void operator()(const f32x4 (&acc)[2][2][4][2], const Unit& u, int wr, int wc, int fr, int fq) const {
        const int row0 = u.pm * BM + wr * 64 + fr, col0 = u.pn * BM + wc * 32 + 8 * fq;
#pragma unroll
        for (int ai = 0; ai < 2; ++ai)
#pragma unroll
            for (int m = 0; m < 4; ++m) { bf16_t* rowp = O + (size_t)(row0 + ai * HALF + m * 16) * ldc + col0;
#pragma unroll
                for (int bj = 0; bj < 2; ++bj) { f32x4 v0 = acc[ai][bj][m][0], v1 = acc[ai][bj][m][1];
                    if (ACT == 1) {
#pragma unroll
                        for (int j = 0; j < 4; ++j) { const float a = fmaxf(v0[j], 0.f), b = fmaxf(v1[j], 0.f); v0[j] = a * a; v1[j] = b * b; } }
                    u32x4 w; w.x = cvt_pk_bf16(v0[0], v0[1]); w.y = cvt_pk_bf16(v0[2], v0[3]); w.z = cvt_pk_bf16(v1[0], v1[1]); w.w = cvt_pk_bf16(v1[2], v1[3]);
                    *(u32x4*)(rowp + bj * HALF) = w; } }
    }
};

struct EpiKV {
    static constexpr bool PERM = true;
    bf16_t* KC; bf16_t* VC;
    __device__ __forceinline__ void operator()(const f32x4 (&acc)[2][2][4][2], const Unit& u, int wr, int wc, int fr, int fq) const {
        const int row0 = u.pm * BM + wr * 64 + fr, c0 = wc * 32 + 8 * fq;
#pragma unroll
        for (int ai = 0; ai < 2; ++ai)
#pragma unroll
            for (int m = 0; m < 4; ++m) { const size_t row = (size_t)(row0 + ai * HALF + m * 16);
#pragma unroll
                for (int bj = 0; bj < 2; ++bj) { const f32x4 v0 = acc[ai][bj][m][0], v1 = acc[ai][bj][m][1];
                    u32x4 w; w.x = cvt_pk_bf16(v0[0], v0[1]); w.y = cvt_pk_bf16(v0[2], v0[3]); w.z = cvt_pk_bf16(v1[0], v1[1]); w.w = cvt_pk_bf16(v1[2], v1[3]);
                    bf16_t* dst = (bj == 0) ? KC + row * 1536 + u.pn * 192 + c0 : VC + row * 1024 + u.pn * 128 + c0;
                    *(u32x4*)dst = w; } }
    }
};

struct EpiLora {
    static constexpr bool PERM = false;
    float* Z; const float* bias;
    __device__ __forceinline__ void operator()(const f32x4 (&acc)[2][2][4][2], const Unit& u, int wr, int wc, int fr, int fq) const {
        const int grp = u.pn >> 2;
        const int row0 = (u.pm - grp * (MROWS / 256)) * BM + wr * 64 + fr, col0 = (u.pn & 3) * BM + wc * 32 + 4 * fq;
        float* base = Z + (size_t)grp * MROWS * AW; const float* bp = bias + grp * AW + col0;
        f32x4 bv[2][2];
#pragma unroll
        for (int bj = 0; bj < 2; ++bj)
#pragma unroll
            for (int n = 0; n < 2; ++n) bv[bj][n] = *(const f32x4*)(bp + bj * HALF + n * 16);
#pragma unroll
        for (int ai = 0; ai < 2; ++ai)
#pragma unroll
            for (int m = 0; m < 4; ++m) { float* rowp = base + (size_t)(row0 + ai * HALF + m * 16) * AW + col0;
#pragma unroll
                for (int bj = 0; bj < 2; ++bj)
#pragma unroll
                    for (int n = 0; n < 2; ++n) *(f32x4*)(rowp + bj * HALF + n * 16) = acc[ai][bj][m][n] + bv[bj][n]; }
    }
};

struct EpiMerge {
    static constexpr bool PERM = true;
    bf16_t* Mb; const bf16_t* Ug;
    __device__ __forceinline__ void mid(f32x4 (&acc)[2][2][4][2], const Unit& u, int seg, int wr, int wc, int fr, int fq) const {
        const int row0 = u.pm * BM + wr * 64 + fr, col0 = u.pn * BM + wc * 32 + 8 * fq;
#pragma unroll
        for (int ai = 0; ai < 2; ++ai) {
            u32x4 ga[4][2], gb[4][2];
#pragma unroll
            for (int m = 0; m < 4; ++m) { const bf16_t* gp = Ug + (size_t)(row0 + ai * HALF + m * 16) * IN_COLS + seg * 2048 + col0;
#pragma unroll
                for (int bj = 0; bj < 2; ++bj) { ga[m][bj] = *(const u32x4*)(gp + bj * HALF); gb[m][bj] = *(const u32x4*)(gp + 2048 + bj * HALF); } }
            asm volatile("" ::: "memory");
#pragma unroll
            for (int m = 0; m < 4; ++m)
#pragma unroll
                for (int bj = 0; bj < 2; ++bj) {
                    float a[8], b[8]; unpack8(ga[m][bj], a); unpack8(gb[m][bj], b);
#pragma unroll
                    for (int e = 0; e < 8; ++e) { const float ea = __expf(-fminf(fmaxf(a[e], -30.f), 30.f)), eb = __expf(-fminf(fmaxf(b[e], -30.f), 30.f));
                        const float ratio = (1.0f + eb) * __builtin_amdgcn_rcpf(1.0f + ea);
                        acc[ai][bj][m][e >> 2][e & 3] *= ratio; }
                }
        }
    }
    __device__ __forceinline__ void operator()(const f32x4 (&acc)[2][2][4][2], const Unit& u, int wr, int wc, int fr, int fq) const {
        const int row0 = u.pm * BM + wr * 64 + fr, col0 = u.pn * BM + wc * 32 + 8 * fq;
#pragma unroll
        for (int ai = 0; ai < 2; ++ai) {
            u32x4 gq_[4][2];
#pragma unroll
            for (int m = 0; m < 4; ++m)
#pragma unroll
                for (int bj = 0; bj < 2; ++bj) gq_[m][bj] = *(const u32x4*)(Ug + (size_t)(row0 + ai * HALF + m * 16) * IN_COLS + 4096 + col0 + bj * HALF);
            asm volatile("" ::: "memory");
#pragma unroll
            for (int m = 0; m < 4; ++m) { const size_t row = (size_t)(row0 + ai * HALF + m * 16);
#pragma unroll
                for (int bj = 0; bj < 2; ++bj) { const int col = col0 + bj * HALF;
                    float gq[8]; unpack8(gq_[m][bj], gq);
                    f32x4 v0 = acc[ai][bj][m][0], v1 = acc[ai][bj][m][1];
#pragma unroll
                    for (int e = 0; e < 4; ++e) { v0[e] *= sigmoidf_(gq[e]); v1[e] *= sigmoidf_(gq[4 + e]); }
                    u32x4 w; w.x = cvt_pk_bf16(v0[0], v0[1]); w.y = cvt_pk_bf16(v0[2], v0[3]); w.z = cvt_pk_bf16(v1[0], v1[1]); w.w = cvt_pk_bf16(v1[2], v1[3]);
                    *(u32x4*)(Mb + row * D + col) = w; } }
        }
    }
};

struct EpiResid {
    static constexpr bool PERM = false;
    float* X; const float* gl; const float* gc;
    __device__ __forceinline__ void operator()(const f32x4 (&acc)[2][2][4][2], const Unit& u, int wr, int wc, int fr, int fq) const {
        const int row0 = u.pm * BM + wr * 64 + fr, col0 = u.pn * BM + wc * 32 + 4 * fq;
        const float* gate = (u.pm * BM < SEQ) ? gl : gc;
        f32x4 gv[2][2];
#pragma unroll
        for (int bj = 0; bj < 2; ++bj)
#pragma unroll
            for (int n = 0; n < 2; ++n) gv[bj][n] = *(const f32x4*)(gate + col0 + bj * HALF + n * 16);
#pragma unroll
        for (int ai = 0; ai < 2; ++ai) {
            f32x4 xv[4][2][2];
#pragma unroll
            for (int m = 0; m < 4; ++m)
#pragma unroll
                for (int bj = 0; bj < 2; ++bj)
#pragma unroll
                    for (int n = 0; n < 2; ++n) xv[m][bj][n] = *(const f32x4*)(X + (size_t)(row0 + ai * HALF + m * 16) * D + col0 + bj * HALF + n * 16);
            asm volatile("" ::: "memory");
#pragma unroll
            for (int m = 0; m < 4; ++m)
#pragma unroll
                for (int bj = 0; bj < 2; ++bj)
#pragma unroll
                    for (int n = 0; n < 2; ++n) *(f32x4*)(X + (size_t)(row0 + ai * HALF + m * 16) * D + col0 + bj * HALF + n * 16) = xv[m][bj][n] + acc[ai][bj][m][n] * gv[bj][n];
            asm volatile("" ::: "memory");
        }
    }
};

template <int GATE> struct EpiPartial {
    static constexpr bool PERM = false;
    float* P; const float* gate; const bf16_t* Ugc;
    __device__ __forceinline__ void operator()(const f32x4 (&acc)[2][2][4][2], const Unit& u, int wr, int wc, int fr, int fq) const {
        const int row0 = wr * 64 + fr, col0 = u.pn * BM + wc * 32 + 4 * fq;
        float* base = P + (size_t)u.pm * CTXL * D;
#pragma unroll
        for (int ai = 0; ai < 2; ++ai)
#pragma unroll
            for (int m = 0; m < 4; ++m) { const int row = row0 + ai * HALF + m * 16;
#pragma unroll
                for (int bj = 0; bj < 2; ++bj)
#pragma unroll
                    for (int n = 0; n < 2; ++n) { const int col = col0 + bj * HALF + n * 16;
                        f32x4 gv;
                        if (GATE == 0) gv = *(const f32x4*)(gate + col);
                        else { const u32x2 gw = *(const u32x2*)(Ugc + (size_t)row * IN_COLS + u.pm * 2048 + col);
                            gv[0] = sigmoidf_(bflo(gw.x)); gv[1] = sigmoidf_(bfhi(gw.x)); gv[2] = sigmoidf_(bflo(gw.y)); gv[3] = sigmoidf_(bfhi(gw.y)); }
                        *(f32x4*)(base + (size_t)row * D + col) = acc[ai][bj][m][n] * gv; } }
    }
};
}

struct Args { const float* in[30]; float* out; unsigned char* ws; int ph_lo, ph_hi, flags, pad_; };
enum { I_X = 0, I_C, I_CTX, I_CCTX, I_ADAW, I_ADAB, I_NMIXG, I_NMLPG, I_WIN, I_CONV, I_W0, I_WUP, I_A0, I_AUP, I_GUP, I_KK, I_KA, I_RK, I_LNG, I_LNB,
       I_QNG, I_WUQ, I_KVNG, I_WUKV, I_RPB, I_WBR, I_WOUT, I_W1, I_W2, I_FNG };

struct Frame {
    LAS unsigned char* lds; int tid, lane, wave, bid, nb;
    const float* const* in; unsigned char* ws; float* out;
};

struct TJob { const float* src; bf16_t* dst; int K, Kpad, N, ldd; };

__device__ __forceinline__ TJob make_job(const Frame& F, int l, int j) {
    TJob t; unsigned char* ws = F.ws;
    switch (j) {
    case 0: t.src = F.in[I_WIN] + (size_t)l * D * IN_COLS; t.dst = (bf16_t*)(ws + WS_WIN) + (size_t)l * IN_COLS * D; t.K = D; t.Kpad = D; t.N = IN_COLS; t.ldd = D; break;
    case 1: t.src = F.in[I_W1] + (size_t)l * D * DFF; t.dst = (bf16_t*)(ws + WS_W1) + (size_t)l * DFF * D; t.K = D; t.Kpad = D; t.N = DFF; t.ldd = D; break;
    case 2: t.src = F.in[I_W2] + (size_t)l * DFF * D; t.dst = (bf16_t*)(ws + WS_W2) + (size_t)l * D * DFF; t.K = DFF; t.Kpad = DFF; t.N = D; t.ldd = DFF; break;
    case 3: case 4: case 5: t.src = F.in[I_WBR] + ((size_t)l * 3 + (j - 3)) * 1024 * D; t.dst = (bf16_t*)(ws + WS_WB) + (size_t)l * D * 3072 + (j - 3) * 1024; t.K = 1024; t.Kpad = 1024; t.N = D; t.ldd = 3072; break;
    case 6: t.src = F.in[I_WOUT] + (size_t)l * D * D; t.dst = (bf16_t*)(ws + WS_WO) + (size_t)l * D * D; t.K = D; t.Kpad = D; t.N = D; t.ldd = D; break;
    case 7: t.src = F.in[I_WUQ] + (size_t)l * QLORA * 1536; t.dst = (bf16_t*)(ws + WS_WUQ) + (size_t)l * 1536 * 512; t.K = QLORA; t.Kpad = 512; t.N = 1536; t.ldd = 512; break;
    case 8: t.src = F.in[I_WUKV] + (size_t)l * KVLORA * 2048; t.dst = (bf16_t*)(ws + WS_WUKV) + (size_t)l * 2048 * 256; t.K = KVLORA; t.Kpad = 256; t.N = 2048; t.ldd = 256; break;
    case 9: case 10: t.src = F.in[I_WUP] + ((size_t)l * 2 + (j - 9)) * 96 * AW; t.dst = (bf16_t*)(ws + WS_WLORA) + ((size_t)l * 5 + (j - 9)) * 1024 * 256; t.K = 96; t.Kpad = 256; t.N = AW; t.ldd = 256; break;
    case 11: case 12: t.src = F.in[I_AUP] + ((size_t)l * 2 + (j - 11)) * 96 * AW; t.dst = (bf16_t*)(ws + WS_WLORA) + ((size_t)l * 5 + 2 + (j - 11)) * 1024 * 256; t.K = 96; t.Kpad = 256; t.N = AW; t.ldd = 256; break;
    default: t.src = F.in[I_GUP] + (size_t)l * 256 * AW; t.dst = (bf16_t*)(ws + WS_WLORA) + ((size_t)l * 5 + 4) * 1024 * 256; t.K = 256; t.Kpad = 256; t.N = AW; t.ldd = 256; break;
    }
    return t;
}

__device__ __forceinline__ void transpose_job(const Frame& F, const TJob& J, int rot) {
    LAS float* tile = (LAS float*)F.lds;
    const int ntk = J.Kpad / 128, ntn = J.N / 64, ntiles = ntk * ntn;
    const int kr = F.tid >> 4, c4 = (F.tid & 15) * 4;
    const int sn = F.tid >> 3, k16 = (F.tid & 7) * 16;
    int start = F.bid - rot; if (start < 0) start += F.nb;
    f32x4 nx[4];
#define TJ_LOAD(ti_) do { const int tk_ = (ti_) / ntn, tn_ = (ti_) % ntn; \
        _Pragma("unroll") for (int it = 0; it < 4; ++it) { const int k = tk_ * 128 + kr + 32 * it; nx[it] = zero4v(); \
            if (k < J.K) nx[it] = *(const f32x4*)(J.src + (size_t)k * J.N + tn_ * 64 + c4); } } while (0)
    if (start < ntiles) TJ_LOAD(start);
    for (int ti = start; ti < ntiles; ti += F.nb) {
        const int tk = ti / ntn, tn = ti % ntn;
        f32x4 v[4];
#pragma unroll
        for (int it = 0; it < 4; ++it) v[it] = nx[it];
        if (ti + F.nb < ntiles) TJ_LOAD(ti + F.nb);
#pragma unroll
        for (int it = 0; it < 4; ++it) { LAS float* tp = tile + (kr + 32 * it) * 65 + c4; tp[0] = v[it][0]; tp[1] = v[it][1]; tp[2] = v[it][2]; tp[3] = v[it][3]; }
        lds_barrier();
        float e[16];
#pragma unroll
        for (int j = 0; j < 16; ++j) e[j] = tile[(k16 + j) * 65 + sn];
        u32x4 w0, w1; w0.x = cvt_pk_bf16(e[0], e[1]); w0.y = cvt_pk_bf16(e[2], e[3]); w0.z = cvt_pk_bf16(e[4], e[5]); w0.w = cvt_pk_bf16(e[6], e[7]);
        w1.x = cvt_pk_bf16(e[8], e[9]); w1.y = cvt_pk_bf16(e[10], e[11]); w1.z = cvt_pk_bf16(e[12], e[13]); w1.w = cvt_pk_bf16(e[14], e[15]);
        bf16_t* dp = J.dst + (size_t)(tn * 64 + sn) * J.ldd + tk * 128 + k16;
        *(u32x4*)dp = w0; *(u32x4*)(dp + 8) = w1;
        lds_barrier();
    }
#undef TJ_LOAD
}

__device__ __forceinline__ void p0_prologue(const Frame& F) {
    unsigned char* ws = F.ws;
    int rot = 0;
    for (int l = 0; l < DEPTH; ++l)
        for (int j = 0; j < 14; ++j) { const TJob J = make_job(F, l, j); transpose_job(F, J, rot); rot = (rot + ((J.Kpad / 128) * (J.N / 64)) % F.nb) % F.nb; }
    {
        LAS float* sv = (LAS float*)F.lds;
        LAS float* red = (LAS float*)(F.lds + 16384);
        for (int i = F.tid; i < 2 * D; i += NTHREADS) { const float x = (i < D) ? F.in[I_C][i] : F.in[I_CCTX][i - D]; sv[i] = x * sigmoidf_(x); }
        __syncthreads();
        const int cg = F.tid & 15, ks = F.tid >> 4;
        for (int u = F.bid; u < DEPTH * 192; u += F.nb) {
            const int l = u / 192, cb = (u % 192) * 64;
            const float* wp = F.in[I_ADAW] + (size_t)l * D * (6 * D) + cb + cg * 4;
            f32x4 a0 = zero4v(), a1 = a0;
#pragma unroll 4
            for (int k = ks; k < D; k += 32) { const f32x4 w = *(const f32x4*)(wp + (size_t)k * (6 * D)); a0 += w * sv[k]; a1 += w * sv[D + k]; }
            LAS float* rp = red + (ks * 16 + cg) * 8;
#pragma unroll
            for (int j = 0; j < 4; ++j) { rp[j] = a0[j]; rp[4 + j] = a1[j]; }
            __syncthreads();
            if (F.tid < 128) {
                const int g2 = F.tid >> 3, e = F.tid & 7; float s = 0.f;
#pragma unroll 8
                for (int q = 0; q < 32; ++q) s += red[(q * 16 + g2) * 8 + e];
                const int col = cb + g2 * 4 + (e & 3), sidx = e >> 2;
                ((float*)(ws + WS_MOD))[((size_t)l * 2 + sidx) * (6 * D) + col] = s + F.in[I_ADAB][(size_t)l * (6 * D) + col];
            }
            __syncthreads();
        }
    }
    {
        float* rt = (float*)(ws + WS_ROPE);
        for (int i = F.bid * NTHREADS + F.tid; i < SEQ * 32; i += F.nb * NTHREADS) {
            const int t = i >> 5, j = i & 31;
            const float inv = powf(10000.0f, -(float)(j & 15) / 16.0f);
            const float pos = (j < 16) ? (float)(t / GRIDW) : (float)(t % GRIDW);
            const float ang = pos * inv;
            rt[2 * i] = cosf(ang); rt[2 * i + 1] = sinf(ang);
        }
    }
    {
        float* lb = (float*)(ws + WS_LBIAS);
        for (int i = F.bid * NTHREADS + F.tid; i < DEPTH * 5 * AW; i += F.nb * NTHREADS) { const int l = i / (5 * AW), r = i % (5 * AW), grp = r / AW, c = r % AW;
            lb[i] = grp < 2 ? F.in[I_W0][((size_t)l * 2 + grp) * AW + c] : (grp < 4 ? F.in[I_A0][((size_t)l * 2 + grp - 2) * AW + c] : 0.f); }
        f32x4* X = (f32x4*)(ws + WS_X);
        const f32x4* x = (const f32x4*)F.in[I_X]; const f32x4* cx = (const f32x4*)F.in[I_CTX];
        const size_t n1 = (size_t)SEQ * D / 4, n2 = (size_t)CTXL * D / 4;
        for (size_t i = (size_t)F.bid * NTHREADS + F.tid; i < n1 + n2; i += (size_t)F.nb * NTHREADS) X[i] = (i < n1) ? x[i] : cx[i - n1];
        u32x4* z = (u32x4*)(ws + WS_LA); const size_t nz = (WS_KPE - WS_LA) / 16;
        for (size_t i = (size_t)F.bid * NTHREADS + F.tid; i < nz; i += (size_t)F.nb * NTHREADS) z[i] = __builtin_bit_cast(u32x4, zero4v());
    }
}

__device__ __forceinline__ void norm_phase(const Frame& F, int l, int which, const float* parts, int nparts) {
    float* X = (float*)(F.ws + WS_X); bf16_t* H = (bf16_t*)(F.ws + WS_H);
    const float* g = F.in[which ? I_NMLPG : I_NMIXG] + (size_t)l * D;
    const float* mod = (const float*)(F.ws + WS_MOD) + (size_t)l * 2 * 6 * D;
    f32x4 ga[8], sh[8];
#pragma unroll
    for (int i = 0; i < 8; ++i) { const int c = i * 256 + F.lane * 4; const float* m = mod + which * 3 * D;
        ga[i] = *(const f32x4*)(g + c) * (*(const f32x4*)(m + D + c) + 1.0f); sh[i] = *(const f32x4*)(m + c); }
    bool ctxp = false;
    const int row0 = F.bid * 8 + F.wave, rstep = F.nb * 8;
    f32x4 nx[8];
    if (row0 < MROWS) {
#pragma unroll
        for (int i = 0; i < 8; ++i) nx[i] = *(const f32x4*)(X + (size_t)row0 * D + i * 256 + F.lane * 4);
    }
    for (int row = row0; row < MROWS; row += rstep) {
        float* xr = X + (size_t)row * D;
        f32x4 v[8]; float ss = 0.f;
#pragma unroll
        for (int i = 0; i < 8; ++i) v[i] = nx[i];
        if (row + rstep < MROWS) {
#pragma unroll
            for (int i = 0; i < 8; ++i) nx[i] = *(const f32x4*)(xr + (size_t)rstep * D + i * 256 + F.lane * 4);
        }
        if (row >= SEQ) {
            if (!ctxp) { ctxp = true; const float* m = mod + 6 * D + which * 3 * D;
#pragma unroll
                for (int i = 0; i < 8; ++i) { const int c = i * 256 + F.lane * 4; ga[i] = *(const f32x4*)(g + c) * (*(const f32x4*)(m + D + c) + 1.0f); sh[i] = *(const f32x4*)(m + c); } }
            if (nparts > 0) {
                const float* pp = parts + (size_t)(row - SEQ) * D + F.lane * 4;
                for (int s = 0; s < nparts; ++s) {
#pragma unroll
                    for (int i = 0; i < 8; ++i) v[i] += *(const f32x4*)(pp + (size_t)s * CTXL * D + i * 256);
                }
#pragma unroll
                for (int i = 0; i < 8; ++i) *(f32x4*)(xr + i * 256 + F.lane * 4) = v[i];
            }
        }
#pragma unroll
        for (int i = 0; i < 8; ++i) ss += v[i][0] * v[i][0] + v[i][1] * v[i][1] + v[i][2] * v[i][2] + v[i][3] * v[i][3];
        ss = wave_sum(ss, F.lane);
        const float rstd = rsqrtf(ss * (1.0f / D) + RMS_EPS);
#pragma unroll
        for (int i = 0; i < 8; ++i) {
            const f32x4 h = (v[i] * rstd) * ga[i] + sh[i];
            u32x2 w; w.x = cvt_pk_bf16(h[0], h[1]); w.y = cvt_pk_bf16(h[2], h[3]);
            *(u32x2*)(H + (size_t)row * D + i * 256 + F.lane * 4) = w;
        }
    }
}

__device__ __forceinline__ void final_norm_phase(const Frame& F) {
    const float* X = (const float*)(F.ws + WS_X); const float* g = F.in[I_FNG];
    for (int row = F.bid * 8 + F.wave; row < SEQ; row += F.nb * 8) {
        const float* xr = X + (size_t)row * D;
        f32x4 v[8]; float ss = 0.f;
#pragma unroll
        for (int i = 0; i < 8; ++i) { v[i] = *(const f32x4*)(xr + i * 256 + F.lane * 4); ss += v[i][0] * v[i][0] + v[i][1] * v[i][1] + v[i][2] * v[i][2] + v[i][3] * v[i][3]; }
        ss = wave_sum(ss, F.lane);
        const float rstd = rsqrtf(ss * (1.0f / D) + RMS_EPS);
#pragma unroll
        for (int i = 0; i < 8; ++i) { const int c = i * 256 + F.lane * 4; *(f32x4*)(F.out + (size_t)row * D + c) = (v[i] * rstd) * *(const f32x4*)(g + c); }
    }
}

__device__ __forceinline__ void prep1_phase(const Frame& F, int l) {
    unsigned char* ws = F.ws;
    const bf16_t* U = (const bf16_t*)(ws + WS_U);
    float* Rf = (float*)(ws + WS_RF); float* Kf = (float*)(ws + WS_KF); float* Vf = (float*)(ws + WS_VF);
    bf16_t* LA = (bf16_t*)(ws + WS_LA); bf16_t* QL = (bf16_t*)(ws + WS_QL); bf16_t* KVL = (bf16_t*)(ws + WS_KVL); bf16_t* KC = (bf16_t*)(ws + WS_KC);
    const float* conv = F.in[I_CONV] + (size_t)l * 3 * RWKV_COLS;
    const float* qg = F.in[I_QNG] + (size_t)l * QLORA; const float* kvg = F.in[I_KVNG] + (size_t)l * KVLORA;
    const float* rope = (const float*)(ws + WS_ROPE);
    const u32x4 zero4 = __builtin_bit_cast(u32x4, zero4v());
    LAS float* cw = (LAS float*)F.lds;
    __syncthreads();
    for (int i = F.tid; i < 3 * RWKV_COLS / 4; i += NTHREADS) *(LAS f32x4*)(cw + 4 * i) = *(const f32x4*)(conv + 4 * i);
    __syncthreads();
    for (int row = F.bid * 8 + F.wave; row < MROWS; row += F.nb * 8) {
        const bool lat = row < SEQ; const int rr = lat ? row : row - SEQ, slen = lat ? SEQ : CTXL;
        const bool hp = rr > 0, hn = rr < slen - 1;
        const bf16_t* uc = U + (size_t)row * IN_COLS;
        u32x4 wc_[8], wp_[8], wn_[8];
#pragma unroll
        for (int it = 0; it < 8; ++it) {
            const int gi = it * 64 + F.lane, col = (gi < RWKV_COLS / 8 ? gi : 0) * 8;
            wc_[it] = *(const u32x4*)(uc + col);
            wp_[it] = hp ? *(const u32x4*)(uc - IN_COLS + col) : zero4;
            wn_[it] = hn ? *(const u32x4*)(uc + IN_COLS + col) : zero4;
        }
        asm volatile("" ::: "memory");
#pragma unroll
        for (int it = 0; it < 8; ++it) {
            const int gi = it * 64 + F.lane;
            if (gi < RWKV_COLS / 8) {
                const int col = gi * 8;
                float c[8], p[8], n[8], o[8]; unpack8(wc_[it], c); unpack8(wp_[it], p); unpack8(wn_[it], n);
                const f32x4 k0a = *(const LAS f32x4*)(cw + col), k0b = *(const LAS f32x4*)(cw + col + 4);
                const f32x4 k1a = *(const LAS f32x4*)(cw + RWKV_COLS + col), k1b = *(const LAS f32x4*)(cw + RWKV_COLS + col + 4);
                const f32x4 k2a = *(const LAS f32x4*)(cw + 2 * RWKV_COLS + col), k2b = *(const LAS f32x4*)(cw + 2 * RWKV_COLS + col + 4);
#pragma unroll
                for (int j = 0; j < 4; ++j) { o[j] = k0a[j] * p[j] + k1a[j] * c[j] + k2a[j] * n[j]; o[4 + j] = k0b[j] * p[4 + j] + k1b[j] * c[4 + j] + k2b[j] * n[4 + j]; }
                if (it < 6) {
                    float* dst = (it < 2 ? Rf : (it < 4 ? Kf : Vf)) + (size_t)row * AW + (it & 1) * 512 + F.lane * 8;
                    *(f32x4*)dst = (f32x4){o[0], o[1], o[2], o[3]}; *(f32x4*)(dst + 4) = (f32x4){o[4], o[5], o[6], o[7]};
                } else if (col < 3264) {
                    const int d = (col - 3072) >= 96 ? 1 : 0, cc = (col - 3072) - 96 * d;
#pragma unroll
                    for (int j = 0; j < 8; ++j) o[j] = tanhf(o[j]);
                    *(u32x4*)(LA + ((size_t)d * MROWS + row) * 256 + cc) = pack8(o);
                } else if (col < 3456) {
                    const int d = (col - 3264) >= 96 ? 1 : 0, cc = (col - 3264) - 96 * d;
                    *(u32x4*)(LA + ((size_t)(2 + d) * MROWS + row) * 256 + cc) = pack8(o);
                } else {
#pragma unroll
                    for (int j = 0; j < 8; ++j) o[j] = sigmoidf_(o[j]);
                    *(u32x4*)(LA + ((size_t)4 * MROWS + row) * 256 + (col - 3456)) = pack8(o);
                }
            }
        }
        {
            float x[8]; float ss = 0.f;
            if (F.lane < 56) { unpack8(*(const u32x4*)(uc + MLA_OFF + F.lane * 8), x);
#pragma unroll
                for (int j = 0; j < 8; ++j) ss += x[j] * x[j]; }
            ss = wave_sum(ss, F.lane);
            const float rstd = rsqrtf(ss * (1.0f / QLORA) + RMS_EPS);
            if (F.lane < 56) {
#pragma unroll
                for (int j = 0; j < 8; ++j) x[j] = x[j] * rstd * qg[F.lane * 8 + j];
                *(u32x4*)(QL + (size_t)row * 512 + F.lane * 8) = pack8(x);
            }
            float y[8]; float s2 = 0.f;
            if (F.lane < 16) { unpack8(*(const u32x4*)(uc + MLA_OFF + QLORA + F.lane * 8), y);
#pragma unroll
                for (int j = 0; j < 8; ++j) s2 += y[j] * y[j]; }
            s2 = wave_sum(s2, F.lane);
            const float rstd2 = rsqrtf(s2 * (1.0f / KVLORA) + RMS_EPS);
            if (F.lane < 16) {
#pragma unroll
                for (int j = 0; j < 8; ++j) y[j] = y[j] * rstd2 * kvg[F.lane * 8 + j];
                *(u32x4*)(KVL + (size_t)row * 256 + F.lane * 8) = pack8(y);
            }
        }
        {
            const float xv = bf2f(uc[MLA_OFF + QLORA + KVLORA + F.lane]);
            const float pv = shx(xv, 16, F.lane);
            float o = xv;
            if (lat) {
                const int ai = (F.lane < 32 ? 0 : 16) + (F.lane & 15);
                const float cs = rope[((size_t)row * 32 + ai) * 2], sn = rope[((size_t)row * 32 + ai) * 2 + 1];
                o = ((F.lane & 16) == 0) ? (xv * cs - pv * sn) : (pv * sn + xv * cs);
            }
            const bf16_t ob = f2bf(o);
#pragma unroll
            for (int hh = 0; hh < 8; ++hh) KC[(size_t)row * 1536 + hh * 192 + 128 + F.lane] = ob;
        }
    }
}

constexpr int SC_TC = 32;
constexpr int SC_STEP_FLOATS = 6 * 64;
constexpr int SC_BUF_BYTES = SC_TC * SC_STEP_FLOATS * 4;
constexpr int SC_CS_OFF = 2 * SC_BUF_BYTES;
constexpr int SC_Y_OFF = SC_CS_OFF + 2 * SC_TC * 2 * 4;

__device__ __forceinline__ float dpp_allsum16(float x) {
    x += __int_as_float(__builtin_amdgcn_update_dpp(0, __float_as_int(x), 0xB1, 0xF, 0xF, true));
    x += __int_as_float(__builtin_amdgcn_update_dpp(0, __float_as_int(x), 0x4E, 0xF, 0xF, true));
    x += __int_as_float(__builtin_amdgcn_update_dpp(0, __float_as_int(x), 0x141, 0xF, 0xF, true));
    x += __int_as_float(__builtin_amdgcn_update_dpp(0, __float_as_int(x), 0x140, 0xF, 0xF, true));
    return x;
}

__device__ __forceinline__ int scan_row(int dir, int s) {
    if (dir == 0) return s < CTXL ? SEQ + s : s - CTXL;
    return s < CTXL ? SEQ + (CTXL - 1) - s : (SEQ - 1) - (s - CTXL);
}

__device__ __forceinline__ void readout_phase(const Frame& F, int l) {
    unsigned char* ws = F.ws;
    const float* Rf = (const float*)(ws + WS_RF); const float* Kf = (const float*)(ws + WS_KF); const float* Vf = (const float*)(ws + WS_VF);
    const float* A0 = (const float*)(ws + WS_AD); const float* A1 = A0 + (size_t)MROWS * AW;
    const float* Y0 = (const float*)(ws + WS_Y); const float* Y1 = Y0 + (size_t)MROWS * AW;
    const float* G = (const float*)(ws + WS_G);
    bf16_t* YC = (bf16_t*)(ws + WS_YCAT);
    const float* lng = F.in[I_LNG] + (size_t)l * AW; const float* lnb = F.in[I_LNB] + (size_t)l * AW;
    const float* ka = F.in[I_KA] + (size_t)l * AW; const float* rk = F.in[I_RK] + (size_t)l * AW;
    for (int it = F.bid * 8 + F.wave; it < MROWS * 16; it += F.nb * 8) {
        const int row = it >> 4, head = it & 15, c = head * 64 + F.lane;
        const size_t o = (size_t)row * AW + c;
        const float y = Y0[o] + Y1[o];
        const float mu = wave_sum(y, F.lane) * (1.0f / 64.0f);
        const float dv = y - mu;
        const float var = wave_sum(dv * dv, F.lane) * (1.0f / 64.0f);
        const float yn = dv * rsqrtf(var + GN_EPS) * lng[c] + lnb[c];
        const float k = Kf[o], kac = ka[c];
        const float kmean = 0.5f * (k * (1.0f + (sigmoidf_(A0[o]) - 1.0f) * kac) + k * (1.0f + (sigmoidf_(A1[o]) - 1.0f) * kac));
        const float bsum = wave_sum(Rf[o] * kmean * rk[c], F.lane);
        const float outv = (yn + bsum * Vf[o]) * G[o];
        YC[(size_t)row * 3072 + c] = f2bf(outv);
    }
}

constexpr float NEG_BIG = -1.0e30f;
__device__ __forceinline__ float fexp2(float x) { return __builtin_amdgcn_exp2f(x); }
__device__ __forceinline__ bf16x8 tr_pair(const LAS unsigned char* p0, const LAS unsigned char* p1) {
    const bf16x4 a = __builtin_amdgcn_ds_read_tr16_b64_v4i16((LAS bf16x4*)p0), b = __builtin_amdgcn_ds_read_tr16_b64_v4i16((LAS bf16x4*)p1);
    return (bf16x8){a[0], a[1], a[2], a[3], b[0], b[1], b[2], b[3]};
}
template <int NKS> __device__ __forceinline__ void sm_update(f32x4 (&s)[NKS], float& m, float& l, float& alpha, int lane, float sc) {
    float mx = fmaxf(fmaxf(s[0][0], s[0][1]), fmaxf(s[0][2], s[0][3]));
#pragma unroll
    for (int k = 1; k < NKS; ++k) mx = fmaxf(fmaxf(mx, s[k][0]), fmaxf(fmaxf(s[k][1], s[k][2]), s[k][3]));
    mx = rows_max(mx);
    const float mn = fmaxf(m, mx * sc); alpha = fexp2(m - mn); m = mn;
    float sum = 0.f;
#pragma unroll
    for (int k = 0; k < NKS; ++k) {
#pragma unroll
        for (int j = 0; j < 4; ++j) { const float p = fexp2(__builtin_fmaf(s[k][j], sc, -mn)); s[k][j] = p; sum += p; } }
    l = l * alpha + sum;
}
__device__ __forceinline__ bf16x8 pack_p(const f32x4 a, const f32x4 b) {
    u32x4 w; w.x = cvt_pk_bf16(a[0], a[1]); w.y = cvt_pk_bf16(a[2], a[3]); w.z = cvt_pk_bf16(b[0], b[1]); w.w = cvt_pk_bf16(b[2], b[3]);
    return __builtin_bit_cast(bf16x8, w);
}

typedef float f32x16 __attribute__((ext_vector_type(16)));
constexpr int MA_KSTR = 400, MA_VSTR = 288, MA_KBUF = 64 * MA_KSTR, MA_VBUF = 64 * MA_VSTR;
constexpr int MA_K_OFF = 0, MA_V_OFF = 3 * MA_KBUF;
static_assert(MA_V_OFF + 3 * MA_VBUF <= LDS_BAR_OFF - 64, "MLA LDS map");
#define MFMA32(a, b, c) __builtin_amdgcn_mfma_f32_32x32x16_bf16(a, b, c, 0, 0, 0)

__device__ __forceinline__ void mla_unit(const Frame& F, int h, int q0, int key0, int ntiles) {
    unsigned char* ws = F.ws;
    const bf16_t* Q = (const bf16_t*)(ws + WS_Q); const bf16_t* KC = (const bf16_t*)(ws + WS_KC); const bf16_t* VC = (const bf16_t*)(ws + WS_VC);
    const float* rope = (const float*)(ws + WS_ROPE);
    bf16_t* YC = (bf16_t*)(ws + WS_YCAT);
    const int ql = F.lane & 31, hh = F.lane >> 5, qr = q0 + F.wave * 32 + ql;
    constexpr float SC = 0.07216878364870322f * LOG2E;
    bf16x8 Qf[12];
    {
        const bf16_t* qp = Q + (size_t)qr * 1536 + h * QHD;
#pragma unroll
        for (int ks = 0; ks < 8; ++ks) Qf[ks] = *(const bf16x8*)(qp + 16 * ks + 8 * hh);
#pragma unroll
        for (int ks = 8; ks < 12; ++ks) {
            const int d0 = 16 * ks + 8 * hh;
            const u32x4 own = *(const u32x4*)(qp + d0);
            if (qr < SEQ) {
                const u32x4 par = *(const u32x4*)(qp + d0 + ((ks & 1) ? -16 : 16));
                float xo[8], xp[8], o[8]; unpack8(own, xo); unpack8(par, xp);
                const float* rp = rope + ((size_t)qr * 32 + ((ks - 8) >> 1) * 16 + 8 * hh) * 2;
#pragma unroll
                for (int j = 0; j < 8; ++j) { const float cs = rp[2 * j], sn = rp[2 * j + 1]; o[j] = (ks & 1) ? (xp[j] * sn + xo[j] * cs) : (xo[j] * cs - xp[j] * sn); }
                Qf[ks] = __builtin_bit_cast(bf16x8, pack8(o));
            } else Qf[ks] = __builtin_bit_cast(bf16x8, own);
        }
    }
    f32x16 O[4];
#pragma unroll
    for (int dt = 0; dt < 4; ++dt) { const f32x4 z = zero4v();
#pragma unroll
        for (int r = 0; r < 16; ++r) O[dt][r] = z[r & 3]; }
    float m = NEG_BIG, l = 0.f;
    unsigned ko[4], vo[3];
#pragma unroll
    for (int i = 0; i < 4; ++i) { const int sl = ((i < 3) ? (F.wave + 8 * i) : 24) * 64 + F.lane, key = sl / 25, part = sl - key * 25;
        ko[i] = (unsigned)((key0 + key) * 1536 + h * 192 + ((part < 24) ? part : 0) * 8) * 2u; }
#pragma unroll
    for (int i = 0; i < 3; ++i) { const int sl = ((i < 2) ? (F.wave + 8 * i) : (16 + (F.wave & 1))) * 64 + F.lane, key = sl / 18, part = sl - key * 18;
        vo[i] = (unsigned)((key0 + key) * 1024 + h * 128 + ((part < 16) ? part : 0) * 8) * 2u; }
    const __amdgpu_buffer_rsrc_t rK = __builtin_amdgcn_make_buffer_rsrc((void*)KC, 0, 0x7ffffff0, 0x00020000), rV = __builtin_amdgcn_make_buffer_rsrc((void*)VC, 0, 0x7ffffff0, 0x00020000);
#define MLA_DMA(t_, slot_) do { const int ks_ = (t_) * (64 * 1536 * 2), vs_ = (t_) * (64 * 1024 * 2); \
        LAS unsigned char* kb_ = F.lds + MA_K_OFF + (slot_) * MA_KBUF; LAS unsigned char* vb_ = F.lds + MA_V_OFF + (slot_) * MA_VBUF; \
        _Pragma("unroll") for (int i = 0; i < 3; ++i) __builtin_amdgcn_raw_ptr_buffer_load_lds(rK, (LAS void*)(kb_ + (F.wave + 8 * i) * 1024), 16, ko[i], ks_, 0, 0); \
        if (F.wave == 6) __builtin_amdgcn_raw_ptr_buffer_load_lds(rK, (LAS void*)(kb_ + 24 * 1024), 16, ko[3], ks_, 0, 0); \
        _Pragma("unroll") for (int i = 0; i < 2; ++i) __builtin_amdgcn_raw_ptr_buffer_load_lds(rV, (LAS void*)(vb_ + (F.wave + 8 * i) * 1024), 16, vo[i], vs_, 0, 0); \
        if (F.wave == 4 || F.wave == 5) __builtin_amdgcn_raw_ptr_buffer_load_lds(rV, (LAS void*)(vb_ + (16 + (F.wave & 1)) * 1024), 16, vo[2], vs_, 0, 0); } while (0)
    __syncthreads();
    MLA_DMA(0, 0); MLA_DMA(1, 1);
    asm volatile("s_waitcnt vmcnt(0)" ::: "memory");
    lds_barrier();
    const int krd = ql * MA_KSTR + 16 * hh;
    const int vrd = (4 * hh + ((F.lane & 15) >> 2)) * MA_VSTR + (((F.lane >> 4) & 1) * 16 + (F.lane & 3) * 4) * 2;
    f32x16 sA[2], sB[2];
    {   const LAS unsigned char* kb = F.lds + MA_K_OFF + krd;
#pragma unroll
        for (int kt = 0; kt < 2; ++kt) { { const f32x4 z = zero4v();
#pragma unroll
            for (int r = 0; r < 16; ++r) sA[kt][r] = z[r & 3]; }
#pragma unroll
            for (int ks = 0; ks < 12; ++ks) { const bf16x8 kf = *(const LAS bf16x8*)(kb + kt * 32 * MA_KSTR + ks * 32); sA[kt] = MFMA32(kf, Qf[ks], sA[kt]); } } }
    int c0 = 0, c1 = 1, c2 = 2;
    static_assert(((SEQ + CTXL) / 64) % 2 == 0, "tile loop is unrolled by two");
#define MLA_KOFF(i_) (((i_) / 12) * 32 * MA_KSTR + ((i_) % 12) * 32)
#define MLA_STEP(s, sn, t) do { \
        if ((t) + 2 < ntiles) MLA_DMA((t) + 2, c2); \
        const LAS unsigned char* kb = F.lds + MA_K_OFF + c1 * MA_KBUF + krd; \
        const LAS unsigned char* vb = F.lds + MA_V_OFF + c0 * MA_VBUF + vrd; \
        bf16x8 kq[3]; kq[0] = *(const LAS bf16x8*)(kb + MLA_KOFF(0)); kq[1] = *(const LAS bf16x8*)(kb + MLA_KOFF(1)); \
        f32x16 zc; { const f32x4 z = zero4v(); _Pragma("unroll") for (int r = 0; r < 16; ++r) zc[r] = z[r & 3]; } \
        float mx = s[0][0], mn = 0.f, alpha = 1.f, sum = 0.f; \
        u32x4 Pw[2][2]; \
        _Pragma("unroll") for (int i = 0; i < 24; ++i) { \
            if (i + 2 < 24) kq[(i + 2) % 3] = *(const LAS bf16x8*)(kb + MLA_KOFF(i + 2)); \
            sn[i / 12] = MFMA32(kq[i % 3], Qf[i % 12], (i % 12 == 0) ? zc : sn[i / 12]);                      \
            if (i < 4) { _Pragma("unroll") for (int r = 0; r < 8; ++r) mx = fmaxf(mx, s[i >> 1][8 * (i & 1) + r]); } \
            else if (i == 4) { const auto q2 = __builtin_amdgcn_permlane32_swap(__float_as_uint(mx), __float_as_uint(mx), false, false); mx = fmaxf(__uint_as_float(q2[0]), __uint_as_float(q2[1])); \
                mn = fmaxf(m, mx * SC); alpha = fexp2(m - mn); m = mn; } \
            else if (i < 21) { const int j = i - 5, kt = j >> 3, r0 = 2 * (j & 7); \
                const float p0 = fexp2(__builtin_fmaf(s[kt][r0], SC, -mn)), p1 = fexp2(__builtin_fmaf(s[kt][r0 + 1], SC, -mn)); sum += p0 + p1; \
                Pw[kt][(j & 7) >> 2][j & 3] = cvt_pk_bf16(p0, p1); \
                _Pragma("unroll") for (int r = 0; r < 4; ++r) O[j >> 2][4 * (j & 3) + r] *= alpha; } \
            else if (i == 21) { l = l * alpha + sum; asm volatile("" : "+v"(l)); } \
            __builtin_amdgcn_sched_barrier(0); \
        } \
          \
        _Pragma("unroll") for (int kt = 0; kt < 2; ++kt) \
            _Pragma("unroll") for (int s2 = 0; s2 < 2; ++s2) \
                _Pragma("unroll") for (int dt = 0; dt < 4; ++dt) { const LAS unsigned char* vp = vb + (32 * kt + 16 * s2) * MA_VSTR + dt * 64; \
                    const bf16x8 vf = tr_pair(vp, vp + 8 * MA_VSTR); \
                    O[dt] = MFMA32(vf, __builtin_bit_cast(bf16x8, Pw[kt][s2]), O[dt]); } \
        asm volatile("s_waitcnt vmcnt(0)" ::: "memory");                                         \
        lds_barrier(); \
        { const int x = c0; c0 = c1; c1 = c2; c2 = x; } } while (0)
    for (int t = 0; t < ntiles; t += 2) { MLA_STEP(sA, sB, t); MLA_STEP(sB, sA, t + 1); }
#undef MLA_STEP
#undef MLA_KOFF
#undef MLA_DMA
    {
        float lt = l;
        { const auto q2 = __builtin_amdgcn_permlane32_swap(__float_as_uint(lt), __float_as_uint(lt), false, false); lt = __uint_as_float(q2[0]) + __uint_as_float(q2[1]); }
        const float inv = 1.0f / lt;
        bf16_t* op = YC + (size_t)qr * 3072 + 1024 + h * VDIM + 4 * hh;
#pragma unroll
        for (int dt = 0; dt < 4; ++dt)
#pragma unroll
            for (int rg = 0; rg < 4; ++rg) { u32x2 w; w.x = cvt_pk_bf16(O[dt][4 * rg] * inv, O[dt][4 * rg + 1] * inv); w.y = cvt_pk_bf16(O[dt][4 * rg + 2] * inv, O[dt][4 * rg + 3] * inv);
                *(u32x2*)(op + 32 * dt + 8 * rg) = w; }
    }
}

constexpr int NA_KSTR = 288, NA_VSTR = 288, NA_KBUF = 64 * NA_KSTR, NA_VBUF = 64 * NA_VSTR;
constexpr int NA_K_OFF = 0, NA_V_OFF = 3 * NA_KBUF, NA_RPB_OFF = NA_V_OFF + 3 * NA_VBUF;
static_assert(NA_RPB_OFF + 4096 <= LDS_BAR_OFF - 64, "NA LDS map");

__device__ __forceinline__ void na_unit(const Frame& F, int l, int gi, int hp) {
    unsigned char* ws = F.ws;
    const bf16_t* U = (const bf16_t*)(ws + WS_U);
    bf16_t* YC = (bf16_t*)(ws + WS_YCAT);
    const int qi = F.lane & 15, g = F.lane >> 4, g4 = F.wave & 3, hh = F.wave >> 2, h = hp * 2 + hh;
    const bool lat = gi < 128;
    const int r0 = lat ? min(max(gi - 4, 0), 120) : 0;
    const int np = lat ? 12 : 4;
    const int qr = (lat ? gi * 64 : SEQ + (gi - 128) * 64) + 16 * g4 + qi;
    constexpr float SC = 0.125f * LOG2E;
    bf16x8 Qf[2];
#pragma unroll
    for (int kk = 0; kk < 2; ++kk) Qf[kk] = *(const bf16x8*)(U + (size_t)qr * IN_COLS + NA_OFF + h * 64 + 32 * kk + 8 * g);
    f32x4 O[4];
#pragma unroll
    for (int dt = 0; dt < 4; ++dt) O[dt] = zero4v();
    float m = NEG_BIG, lsum = 0.f;
    unsigned ko[3], vo[3];
#pragma unroll
    for (int i = 0; i < 3; ++i) { const int sl = ((i < 2) ? (F.wave + 8 * i) : (16 + (F.wave & 1))) * 64 + F.lane, key = sl / 18, part = sl - key * 18;
        const unsigned e = (unsigned)(key * IN_COLS + NA_OFF + hp * 128 + ((part < 16) ? part : 0) * 8);
        ko[i] = (e + 1024u) * 2u; vo[i] = (e + 2048u) * 2u; }
    const __amdgpu_buffer_rsrc_t rU = __builtin_amdgcn_make_buffer_rsrc((void*)U, 0, 0x7ffffff0, 0x00020000);
#define NA_PIECE_ROW(p) ((lat && (p) < 8) ? (r0 + (p)) * 64 : SEQ + ((p) - (lat ? 8 : 0)) * 64)
#define NA_DMA(p_, slot_) do { const int so_ = NA_PIECE_ROW(p_) * (IN_COLS * 2); \
        LAS unsigned char* kb_ = F.lds + NA_K_OFF + (slot_) * NA_KBUF; LAS unsigned char* vb_ = F.lds + NA_V_OFF + (slot_) * NA_VBUF; \
        _Pragma("unroll") for (int i = 0; i < 2; ++i) { __builtin_amdgcn_raw_ptr_buffer_load_lds(rU, (LAS void*)(kb_ + (F.wave + 8 * i) * 1024), 16, ko[i], so_, 0, 0); \
            __builtin_amdgcn_raw_ptr_buffer_load_lds(rU, (LAS void*)(vb_ + (F.wave + 8 * i) * 1024), 16, vo[i], so_, 0, 0); } \
        if (F.wave < 2) { __builtin_amdgcn_raw_ptr_buffer_load_lds(rU, (LAS void*)(kb_ + (16 + F.wave) * 1024), 16, ko[2], so_, 0, 0); \
            __builtin_amdgcn_raw_ptr_buffer_load_lds(rU, (LAS void*)(vb_ + (16 + F.wave) * 1024), 16, vo[2], so_, 0, 0); } } while (0)
    __syncthreads();
    if (lat) { LAS float* rp = (LAS float*)(F.lds + NA_RPB_OFF); const float* src = F.in[I_RPB] + ((size_t)l * 16 + hp * 2) * 465;
        for (int i = F.tid; i < 930; i += NTHREADS) rp[i] = src[i] * LOG2E; }
    NA_DMA(0, 0); NA_DMA(1, 1);
    asm volatile("s_waitcnt vmcnt(0)" ::: "memory");
    lds_barrier();
    const int c0 = (g4 == 0) ? 0 : (g4 == 1 ? 8 : (g4 == 2 ? 24 : 32));
    const int qc = 16 * g4 + qi, cs_ = min(max(qc - 8, 0), 48);
    const int krd = qi * NA_KSTR + hh * 128 + 16 * g;
    const int vrd = (4 * g + (qi >> 2)) * NA_VSTR + hh * 128 + (qi & 3) * 8;
    const LAS float* rpb = (const LAS float*)(F.lds + NA_RPB_OFF) + hh * 465;
    int sc = 0, sn2 = 2;
    for (int p = 0; p < np; ++p) {
        if (p + 2 < np) NA_DMA(p + 2, sn2);
        const LAS unsigned char* kb = F.lds + NA_K_OFF + sc * NA_KBUF;
        const LAS unsigned char* vb = F.lds + NA_V_OFF + sc * NA_VBUF;
        const bool win = lat && p < 8;
        const int ntl = win ? 1 : 2;
        for (int tl = 0; tl < ntl; ++tl) {
            const int kbase = win ? c0 : tl * 32;
            f32x4 s[2];
#pragma unroll
            for (int ks = 0; ks < 2; ++ks) {
                s[ks] = zero4v();
#pragma unroll
                for (int kk = 0; kk < 2; ++kk) {
                    const bf16x8 kf = *(const LAS bf16x8*)(kb + krd + (kbase + ks * 16) * NA_KSTR + kk * 64);
                    s[ks] = __builtin_amdgcn_mfma_f32_16x16x32_bf16(kf, Qf[kk], s[ks], 0, 0, 0);
                }
            }
            if (win) {
                const int dr = (r0 + p) - gi + 7;
#pragma unroll
                for (int ks = 0; ks < 2; ++ks)
#pragma unroll
                    for (int j = 0; j < 4; ++j) {
                        const int cc = c0 + 16 * ks + 4 * g + j, rel = cc - cs_;
                        const bool valid = (rel >= 0) && (rel < 16);
                        const int bi = min(max(cc - qc + 15, 0), 30);
                        const float bias = rpb[dr * 31 + bi];
                        s[ks][j] = valid ? (s[ks][j] * SC + bias) : NEG_BIG;
                    }
            } else {
#pragma unroll
                for (int ks = 0; ks < 2; ++ks) s[ks] = s[ks] * SC;
            }
            float alpha; sm_update<2>(s, m, lsum, alpha, F.lane, 1.0f);
#pragma unroll
            for (int dt = 0; dt < 4; ++dt) O[dt] = O[dt] * alpha;
            const bf16x8 P = pack_p(s[0], s[1]);
#pragma unroll
            for (int dt = 0; dt < 4; ++dt) {
                const LAS unsigned char* vp = vb + vrd + kbase * NA_VSTR + dt * 32;
                const bf16x8 vf = tr_pair(vp, vp + 16 * NA_VSTR);
                O[dt] = __builtin_amdgcn_mfma_f32_16x16x32_bf16(vf, P, O[dt], 0, 0, 0);
            }
        }
        if (p + 2 < np) { if (F.wave < 2) asm volatile("s_waitcnt vmcnt(6)" ::: "memory"); else asm volatile("s_waitcnt vmcnt(4)" ::: "memory"); }
        else asm volatile("s_waitcnt vmcnt(0)" ::: "memory");
        lds_barrier();
        sc = (sc == 2) ? 0 : sc + 1; sn2 = (sn2 == 2) ? 0 : sn2 + 1;
    }
#undef NA_DMA
#undef NA_PIECE_ROW
    const float lt = rows_sum(lsum);
    const float inv = 1.0f / lt;
    bf16_t* op = YC + (size_t)qr * 3072 + 2048 + h * 64 + 4 * g;
#pragma unroll
    for (int dt = 0; dt < 4; ++dt) { const f32x4 o = O[dt] * inv; u32x2 w; w.x = cvt_pk_bf16(o[0], o[1]); w.y = cvt_pk_bf16(o[2], o[3]); *(u32x2*)(op + dt * 16) = w; }
}

__device__ __forceinline__ void attn_phase(const Frame& F, int l, int flags) {
    if (!(flags & 2)) {
        for (int u = F.bid; u < 256; u += F.nb) mla_unit(F, u & 7, (u >> 3) * 256, 0, MROWS / 64);
        for (int v = F.nb - 1 - F.bid; v < 8; v += F.nb) mla_unit(F, v, SEQ, SEQ, CTXL / 64);
    }
    if (!(flags & 4)) {
        unsigned* q = (unsigned*)(F.ws + WS_CTL) + 8192 + l * 64;
        volatile LAS unsigned* slot = (volatile LAS unsigned*)(F.lds + LDS_BAR_OFF - 64);
        for (;;) {
            __syncthreads();
            if (F.tid == 0) *slot = __hip_atomic_fetch_add(q, 1u, __ATOMIC_RELAXED, __HIP_MEMORY_SCOPE_AGENT);
            __syncthreads();
            const int u = (int)*slot;
            if (u >= 1056) break;
            na_unit(F, l, u >> 3, u & 7);
        }
    }
}

constexpr int CH_NCH = MROWS / 64;
constexpr int CH_NTASK = 32 * CH_NCH;
constexpr int CS = 144;
constexpr int CF = 68;
constexpr int CIMG = 64 * CS;
constexpr int O_KT = 0, O_RT = CIMG, O_BH = 2 * CIMG, O_KH = 3 * CIMG, O_V = 4 * CIMG, O_BB = 5 * CIMG  , O_KB = 6 * CIMG  ,
              O_AAK = 7 * CIMG  , O_ARB = 8 * CIMG, O_ARK = 9 * CIMG, O_T = 10 * CIMG, O_AF = 11 * CIMG, O_TF = O_AF + 64 * CF * 4, O_TOT = O_TF + 64 * CF * 4,
              O_GL = O_TOT + 8 * 64 * 4, O_CHEND = O_GL + 256;
static_assert(O_CHEND <= LDS_BAR_OFF, "chunk LDS map");

__device__ __forceinline__ bf16x8 ch_rowread(const LAS unsigned char* img, int tile, int ks, int qi, int g) {
    return *(const LAS bf16x8*)(img + (16 * tile + qi) * CS + (32 * ks + 8 * g) * 2);
}
__device__ __forceinline__ bf16x8 ch_trread(const LAS unsigned char* img, int tile, int ks, int qi, int g) {
    const LAS unsigned char* p = img + (32 * ks + 8 * g + (qi >> 2)) * CS + (16 * tile + 4 * (qi & 3)) * 2;
    return tr_pair(p, p + 4 * CS);
}
__device__ __forceinline__ void ch_store_bf16(LAS unsigned char* img, int tr, int tc, int qi, int g, const f32x4 v) {
#pragma unroll
    for (int jj = 0; jj < 4; ++jj) *(LAS bf16_t*)(img + (16 * tr + 4 * g + jj) * CS + (16 * tc + qi) * 2) = f2bf(v[jj]);
}
#define MFMA_BF(a, b, c) __builtin_amdgcn_mfma_f32_16x16x32_bf16(a, b, c, 0, 0, 0)
#define MFMA_F32(a, b, c) __builtin_amdgcn_mfma_f32_16x16x4f32(a, b, c, 0, 0, 0)

__device__ __forceinline__ void rwkvA_phase(const Frame& F, int l) {
    unsigned char* ws = F.ws;
    const float* Rf = (const float*)(ws + WS_RF); const float* Kf = (const float*)(ws + WS_KF); const float* Vf = (const float*)(ws + WS_VF);
    float* MN = (float*)(ws + WS_MN); bf16_t* RY = (bf16_t*)(ws + WS_RY);
    const int qi = F.lane & 15, g = F.lane >> 4, tr = F.wave >> 1, tcb = (F.wave & 1) * 2;
    LAS unsigned char* L = F.lds;
    LAS float* Af = (LAS float*)(L + O_AF); LAS float* Tf = (LAS float*)(L + O_TF); LAS float* tot = (LAS float*)(L + O_TOT); LAS float* gL = (LAS float*)(L + O_GL);
    float pk_[8], pv_[8], pr_[8], pza_[8], pzw_[8];
#define RA_LOAD(task_) do { const int hd_ = (task_) / CH_NCH, c_ = (task_) - hd_ * CH_NCH, dir_ = hd_ & 1; \
        const size_t o0_ = (size_t)scan_row(dir_, c_ * 64 + F.wave * 8) * AW + (hd_ >> 1) * 64 + F.lane; const int ds_ = dir_ ? -AW : AW;        \
        const float* kp_ = Kf + o0_; const float* vp_ = Vf + o0_; const float* rp_ = Rf + o0_; \
        const float* zw_ = (const float*)(ws + WS_WD) + (size_t)dir_ * MROWS * AW + o0_; const float* za_ = (const float*)(ws + WS_AD) + (size_t)dir_ * MROWS * AW + o0_; \
        _Pragma("unroll") for (int e = 0; e < 8; ++e) { pk_[e] = kp_[e * ds_]; pv_[e] = vp_[e * ds_]; pr_[e] = rp_[e * ds_]; pza_[e] = za_[e * ds_]; pzw_[e] = zw_[e * ds_]; } } while (0)
    if (F.bid < CH_NTASK) RA_LOAD(F.bid);
    for (int task = F.bid; task < CH_NTASK; task += F.nb) {
        const f32x4 z4 = zero4v();
        const int hd = task / CH_NCH, c = task - hd * CH_NCH, head = hd >> 1, dir = hd & 1;
        const int ch = head * 64 + F.lane;
        const float kkc = F.in[I_KK][(size_t)l * AW + ch], kac = F.in[I_KA][(size_t)l * AW + ch];
        {
            float kk_[8], b_[8], kd_[8], r_[8], lw_[8], cl_[8];
            float run = 0.f;
#pragma unroll
            for (int e = 0; e < 8; ++e) {
                const int i = F.wave * 8 + e;
                const float k = pk_[e], a = sigmoidf_(pza_[e]);
                lw_[e] = -0.6065306597126334f * sigmoidf_(pzw_[e]);
                r_[e] = pr_[e];
                const float kkr = k * kkc;
                const float nrm = sqrtf(wave_sum(kkr * kkr, F.lane));
                kk_[e] = kkr * __builtin_amdgcn_rcpf(fmaxf(nrm, 1e-12f));
                b_[e] = kk_[e] * a;
                kd_[e] = k * (1.0f + (a - 1.0f) * kac);
                run += lw_[e]; cl_[e] = run;
                *(LAS bf16_t*)(L + O_V + i * CS + F.lane * 2) = f2bf(pv_[e]);
            }
            if (task + F.nb < CH_NTASK) RA_LOAD(task + F.nb);
            tot[F.wave * 64 + F.lane] = run;
            lds_barrier();
            float off = 0.f, all = 0.f;
#pragma unroll
            for (int w = 0; w < 8; ++w) { const float t = tot[w * 64 + F.lane]; all += t; off += (w < F.wave) ? t : 0.f; }
            if (F.wave == 0) gL[F.lane] = __expf(all);
#pragma unroll
            for (int e = 0; e < 8; ++e) {
                const int i = F.wave * 8 + e;
                const float cum = off + cl_[e], cumm = cum - lw_[e];
                const float ec = __expf(cum), em = __expf(cumm), ei = __expf(-cum), eh = __expf(all - cum);
                const int o = i * CS + F.lane * 2;
                *(LAS bf16_t*)(L + O_KT + o) = f2bf(kk_[e] * em);
                *(LAS bf16_t*)(L + O_RT + o) = f2bf(r_[e] * ec);
                *(LAS bf16_t*)(L + O_BB + o) = f2bf(b_[e] * ei);
                *(LAS bf16_t*)(L + O_KB + o) = f2bf(kd_[e] * ei);
                *(LAS bf16_t*)(L + O_BH + o) = f2bf(b_[e] * eh);
                *(LAS bf16_t*)(L + O_KH + o) = f2bf(kd_[e] * eh);
            }
        }
        lds_barrier();
        {
            f32x4 ab[2] = {z4, z4}, ak[2] = {z4, z4}, rb[2] = {z4, z4}, rk[2] = {z4, z4};
#pragma unroll
            for (int ks = 0; ks < 2; ++ks) {
                const bf16x8 aK = ch_rowread(L + O_KT, tr, ks, qi, g), aR = ch_rowread(L + O_RT, tr, ks, qi, g);
#pragma unroll
                for (int t = 0; t < 2; ++t) {
                    const bf16x8 bB = ch_rowread(L + O_BB, tcb + t, ks, qi, g), bK = ch_rowread(L + O_KB, tcb + t, ks, qi, g);
                    ab[t] = MFMA_BF(aK, bB, ab[t]); ak[t] = MFMA_BF(aK, bK, ak[t]); rb[t] = MFMA_BF(aR, bB, rb[t]); rk[t] = MFMA_BF(aR, bK, rk[t]);
                }
            }
#pragma unroll
            for (int t = 0; t < 2; ++t) {
                const int col = 16 * (tcb + t) + qi;
#pragma unroll
                for (int jj = 0; jj < 4; ++jj) {
                    const int row = 16 * tr + 4 * g + jj;
                    const bool lo = col < row, le = col <= row;
                    Af[row * CF + col] = lo ? ab[t][jj] : 0.f;
                    ak[t][jj] = lo ? ak[t][jj] : 0.f; rb[t][jj] = le ? rb[t][jj] : 0.f; rk[t][jj] = le ? rk[t][jj] : 0.f;
                }
                ch_store_bf16(L + O_AAK, tr, tcb + t, qi, g, ak[t]); ch_store_bf16(L + O_ARB, tr, tcb + t, qi, g, rb[t]); ch_store_bf16(L + O_ARK, tr, tcb + t, qi, g, rk[t]);
            }
        }
        lds_barrier();
        if (F.wave == 0) {
            float t[16];
#pragma unroll
            for (int i = 0; i < 16; ++i) {
                float acc = (i == qi) ? 1.f : 0.f;
                f32x4 ar[4];
#pragma unroll
                for (int q = 0; q < (i + 3) / 4; ++q) ar[q] = *(const LAS f32x4*)(Af + (16 * g + i) * CF + 16 * g + 4 * q);
#pragma unroll
                for (int j = 0; j < i; ++j) acc -= ar[j >> 2][j & 3] * t[j];
                t[i] = acc;
            }
#pragma unroll
            for (int i = 0; i < 16; ++i) Tf[(16 * g + i) * CF + 16 * g + qi] = t[i];
        }
        lds_barrier();
#pragma unroll 1
        for (int d = 1; d < 4; ++d) {
            if (F.wave < 4 - d) {
                const int bp = F.wave, b = bp + d;
                f32x4 X = z4;
                for (int bb = bp; bb < b; ++bb) {
#pragma unroll
                    for (int s = 0; s < 4; ++s) X = MFMA_F32(Af[(16 * b + qi) * CF + 16 * bb + 4 * s + g], Tf[(16 * bb + 4 * s + g) * CF + 16 * bp + qi], X);
                }
                f32x4 R = z4;
#pragma unroll
                for (int s = 0; s < 4; ++s) R = MFMA_F32(Tf[(16 * b + qi) * CF + 16 * b + 4 * g + s], X[s], R);
#pragma unroll
                for (int jj = 0; jj < 4; ++jj) Tf[(16 * b + 4 * g + jj) * CF + 16 * bp + qi] = -R[jj];
            }
            lds_barrier();
        }
        for (int idx = F.tid; idx < 4096; idx += NTHREADS) { const int row = idx >> 6, col = idx & 63;
            *(LAS bf16_t*)(L + O_T + row * CS + col * 2) = f2bf(((col >> 4) > (row >> 4)) ? 0.f : Tf[row * CF + col]); }
        lds_barrier();
        {
            f32x4 av[2] = {z4, z4}, p[2] = {z4, z4};
#pragma unroll
            for (int ks = 0; ks < 2; ++ks) {
                const bf16x8 aA = ch_rowread(L + O_AAK, tr, ks, qi, g), aT = ch_rowread(L + O_T, tr, ks, qi, g);
#pragma unroll
                for (int t = 0; t < 2; ++t) { av[t] = MFMA_BF(aA, ch_trread(L + O_V, tcb + t, ks, qi, g), av[t]); p[t] = MFMA_BF(aT, ch_trread(L + O_KT, tcb + t, ks, qi, g), p[t]); }
            }
#pragma unroll
            for (int t = 0; t < 2; ++t) { ch_store_bf16(L + O_BB, tr, tcb + t, qi, g, av[t]); ch_store_bf16(L + O_KB, tr, tcb + t, qi, g, p[t]); }
        }
        lds_barrier();
        {
            f32x4 q[2] = {z4, z4};
#pragma unroll
            for (int ks = 0; ks < 2; ++ks) {
                const bf16x8 aT = ch_rowread(L + O_T, tr, ks, qi, g);
#pragma unroll
                for (int t = 0; t < 2; ++t) q[t] = MFMA_BF(aT, ch_trread(L + O_BB, tcb + t, ks, qi, g), q[t]);
            }
#pragma unroll
            for (int t = 0; t < 2; ++t) ch_store_bf16(L + O_AAK, tr, tcb + t, qi, g, q[t]);
        }
        lds_barrier();
        {
            f32x4 m[2] = {z4, z4}, n1[2] = {z4, z4}, n2[2] = {z4, z4}, ry[2] = {z4, z4}, y1[2] = {z4, z4}, y2[2] = {z4, z4};
#pragma unroll
            for (int ks = 0; ks < 2; ++ks) {
                const bf16x8 aPt = ch_trread(L + O_KB, tr, ks, qi, g), aVt = ch_trread(L + O_V, tr, ks, qi, g), aQt = ch_trread(L + O_AAK, tr, ks, qi, g);
                const bf16x8 aRb = ch_rowread(L + O_ARB, tr, ks, qi, g), aRk = ch_rowread(L + O_ARK, tr, ks, qi, g);
#pragma unroll
                for (int t = 0; t < 2; ++t) {
                    const bf16x8 bBh = ch_trread(L + O_BH, tcb + t, ks, qi, g), bKh = ch_trread(L + O_KH, tcb + t, ks, qi, g);
                    const bf16x8 bP = ch_trread(L + O_KB, tcb + t, ks, qi, g), bV = ch_trread(L + O_V, tcb + t, ks, qi, g), bQ = ch_trread(L + O_AAK, tcb + t, ks, qi, g);
                    m[t] = MFMA_BF(aPt, bBh, m[t]); n1[t] = MFMA_BF(aVt, bKh, n1[t]); n2[t] = MFMA_BF(aQt, bBh, n2[t]);
                    ry[t] = MFMA_BF(aRb, bP, ry[t]); y1[t] = MFMA_BF(aRk, bV, y1[t]); y2[t] = MFMA_BF(aRb, bQ, y2[t]);
                }
            }
            const int lo = (16 * tr + 4 * g) * 64 + 16 * tcb + qi;
            float* Np = MN + (size_t)task * 2 * 4096 + 4096 + lo;
            bf16_t* MTh = (bf16_t*)(MN + (size_t)task * 2 * 4096); bf16_t* MTl = MTh + 4096;
            bf16_t* Rp = RY + (size_t)task * 4096 + lo;
            const LAS bf16_t* Rt = (const LAS bf16_t*)(L + O_RT + (16 * tr + 4 * g) * CS + (16 * tcb + qi) * 2);
            const int dstep = (dir == 0) ? AW : -AW;
            float* Yp = (float*)(ws + WS_Y) + (size_t)dir * MROWS * AW + (size_t)scan_row(dir, c * 64 + 16 * tr + 4 * g) * AW + head * 64 + 16 * tcb + qi;
#pragma unroll
            for (int t = 0; t < 2; ++t) {
#pragma unroll
                for (int jj = 0; jj < 4; ++jj) {
                    const bool dg = (16 * tr + 4 * g + jj) == (16 * (tcb + t) + qi);
                    m[t][jj] = (dg ? gL[16 * (tcb + t) + qi] : 0.f) - m[t][jj];
                    Np[jj * 64 + t * 16] = n1[t][jj] - n2[t][jj];
                    Rp[jj * 64 + t * 16] = f2bf(bf2f(Rt[jj * (CS / 2) + t * 16]) - ry[t][jj]);
                    Yp[jj * dstep + t * 16] = y1[t][jj] - y2[t][jj];
                }
                float hi_[4];
#pragma unroll
                for (int jj = 0; jj < 4; ++jj) hi_[jj] = bf2f(f2bf(m[t][jj]));
                u32x2 wh, wl; wh.x = cvt_pk_bf16(hi_[0], hi_[1]); wh.y = cvt_pk_bf16(hi_[2], hi_[3]);
                wl.x = cvt_pk_bf16(m[t][0] - hi_[0], m[t][1] - hi_[1]); wl.y = cvt_pk_bf16(m[t][2] - hi_[2], m[t][3] - hi_[3]);
                const int mo_ = (16 * (tcb + t) + qi) * 64 + 32 * (tr >> 1) + 8 * g + 4 * (tr & 1);
                *(u32x2*)(MTh + mo_) = wh; *(u32x2*)(MTl + mo_) = wl;
            }
        }
        lds_barrier();
    }
}

#undef RA_LOAD
constexpr int RB_BLOCKS = 32;
constexpr int RB_SLOT = 32768;
__device__ __forceinline__ void rwkvB_phase(const Frame& F) {
    if (F.bid >= RB_BLOCKS) return;
    unsigned char* ws = F.ws;
    bf16_t* SC = (bf16_t*)(ws + WS_SC);
    const int qi = F.lane & 15, g = F.lane >> 4, hd = F.bid, vt = F.wave & 3;
    const bool loader = F.wave >= 4;
    const __amdgpu_buffer_rsrc_t rM = __builtin_amdgcn_make_buffer_rsrc((void*)(ws + WS_MN), 0, 0x7ffffff0, 0x00020000);
    const unsigned lo_ = (unsigned)(F.lane * 16);
#define RB_DMA(c_) do { const int so_ = (hd * CH_NCH + (c_)) * RB_SLOT; LAS unsigned char* sb_ = F.lds + ((c_) & 3) * RB_SLOT; \
        _Pragma("unroll") for (int i = 0; i < 8; ++i) __builtin_amdgcn_raw_ptr_buffer_load_lds(rM, (LAS void*)(sb_ + (vt + 4 * i) * 1024), 16, lo_ + (unsigned)((vt + 4 * i) * 1024), so_, 0, 0); } while (0)
    __syncthreads();
    if (loader) { RB_DMA(0); RB_DMA(1); RB_DMA(2); asm volatile("s_waitcnt vmcnt(16)" ::: "memory"); }
    lds_barrier();
    f32x4 T[4];
#pragma unroll
    for (int kt = 0; kt < 4; ++kt) T[kt] = zero4v();
    for (int c = 0; c < CH_NCH; ++c) {
        if (loader) {
            if (c + 3 < CH_NCH) { RB_DMA(c + 3); asm volatile("s_waitcnt vmcnt(16)" ::: "memory"); }
            else asm volatile("s_waitcnt vmcnt(0)" ::: "memory");
        } else {
            const LAS unsigned char* sb = F.lds + (c & 3) * RB_SLOT;
            bf16_t* Sg = SC + (size_t)(hd * CH_NCH + c) * 4096 + (16 * vt + qi) * 64 + 4 * g;
            bf16x8 bh[2], bl[2];
#pragma unroll
            for (int ks = 0; ks < 2; ++ks) {
                u32x4 wh, wl;
#pragma unroll
                for (int h = 0; h < 2; ++h) {
                    const f32x4 x = T[2 * ks + h];
                    float xh[4];
#pragma unroll
                    for (int j = 0; j < 4; ++j) xh[j] = bf2f(f2bf(x[j]));
                    const unsigned h0 = cvt_pk_bf16(xh[0], xh[1]), h1 = cvt_pk_bf16(xh[2], xh[3]);
                    const unsigned l0 = cvt_pk_bf16(x[0] - xh[0], x[1] - xh[1]), l1 = cvt_pk_bf16(x[2] - xh[2], x[3] - xh[3]);
                    if (h == 0) { wh.x = h0; wh.y = h1; wl.x = l0; wl.y = l1; } else { wh.z = h0; wh.w = h1; wl.z = l0; wl.w = l1; }
                    u32x2 sv; sv.x = h0; sv.y = h1; *(u32x2*)(Sg + 16 * (2 * ks + h)) = sv;
                }
                bh[ks] = __builtin_bit_cast(bf16x8, wh); bl[ks] = __builtin_bit_cast(bf16x8, wl);
            }
#pragma unroll
            for (int kt = 0; kt < 4; ++kt) {
                f32x4 acc = *(const LAS f32x4*)(sb + 16384 + ((16 * vt + qi) * 64 + 16 * kt + 4 * g) * 4);
#pragma unroll
                for (int ks = 0; ks < 2; ++ks) {
                    const bf16x8 ah = *(const LAS bf16x8*)(sb + ((16 * kt + qi) * 64 + 32 * ks + 8 * g) * 2);
                    const bf16x8 al = *(const LAS bf16x8*)(sb + 8192 + ((16 * kt + qi) * 64 + 32 * ks + 8 * g) * 2);
                    acc = MFMA_BF(ah, bh[ks], acc); acc = MFMA_BF(ah, bl[ks], acc); acc = MFMA_BF(al, bh[ks], acc);
                }
                T[kt] = acc;
            }
        }
        lds_barrier();
    }
#undef RB_DMA
}

__device__ __forceinline__ void rwkvC_readout_phase(const Frame& F, int l) {
    unsigned char* ws = F.ws;
    const bf16_t* RY = (const bf16_t*)(ws + WS_RY); const bf16_t* SC = (const bf16_t*)(ws + WS_SC);
    const float* Rf = (const float*)(ws + WS_RF); const float* Kf = (const float*)(ws + WS_KF); const float* Vf = (const float*)(ws + WS_VF);
    const float* Z0 = (const float*)(ws + WS_AD); const float* Z1 = Z0 + (size_t)MROWS * AW;
    const float* Y0 = (const float*)(ws + WS_Y); const float* Y1 = Y0 + (size_t)MROWS * AW;
    const float* G = (const float*)(ws + WS_G);
    bf16_t* YC = (bf16_t*)(ws + WS_YCAT);
    const int qi = F.lane & 15, g = F.lane >> 4;
    for (int qtask = F.bid * 8 + F.wave; qtask < CH_NCH * 16 * 4; qtask += F.nb * 8) {
        const int task = qtask >> 2, tr = qtask & 3;
        const int rb = task >> 4, head = task & 15, R0 = rb * 64;
        const int cf = (R0 >= SEQ) ? (R0 - SEQ) / 64 : (R0 + CTXL) / 64, cb = (MROWS - 64 - R0) / 64;
        const int tf = (head * 2) * CH_NCH + cf, tb = (head * 2 + 1) * CH_NCH + cb;
        f32x4 y[1][4];
        {
            bf16x8 bS[4][2];
#pragma unroll
            for (int tc = 0; tc < 4; ++tc)
#pragma unroll
                for (int ks = 0; ks < 2; ++ks) bS[tc][ks] = *(const bf16x8*)(SC + (size_t)tf * 4096 + (16 * tc + qi) * 64 + 32 * ks + 8 * g);
            {
                const bf16_t* ap = RY + (size_t)tf * 4096 + (16 * tr + qi) * 64 + 8 * g;
                const bf16x8 a0 = *(const bf16x8*)ap, a1 = *(const bf16x8*)(ap + 32);
#pragma unroll
                for (int tc = 0; tc < 4; ++tc) { f32x4 acc = zero4v(); acc = MFMA_BF(a0, bS[tc][0], acc); y[0][tc] = MFMA_BF(a1, bS[tc][1], acc); }
            }
#pragma unroll
            for (int tc = 0; tc < 4; ++tc)
#pragma unroll
                for (int ks = 0; ks < 2; ++ks) bS[tc][ks] = *(const bf16x8*)(SC + (size_t)tb * 4096 + (16 * tc + qi) * 64 + 32 * ks + 8 * g);
            {
                const bf16_t* ap = RY + (size_t)tb * 4096 + (63 - (16 * tr + qi)) * 64 + 8 * g;
                const bf16x8 a0 = *(const bf16x8*)ap, a1 = *(const bf16x8*)(ap + 32);
#pragma unroll
                for (int tc = 0; tc < 4; ++tc) { f32x4 acc = y[0][tc]; acc = MFMA_BF(a0, bS[tc][0], acc); y[0][tc] = MFMA_BF(a1, bS[tc][1], acc); }
            }
        }
        const float* lng = F.in[I_LNG] + (size_t)l * AW + head * 64; const float* lnb = F.in[I_LNB] + (size_t)l * AW + head * 64;
        const float* ka = F.in[I_KA] + (size_t)l * AW + head * 64; const float* rk = F.in[I_RK] + (size_t)l * AW + head * 64;
        float lg[4], lb[4], kav[4], rkv[4];
#pragma unroll
        for (int tc = 0; tc < 4; ++tc) { lg[tc] = lng[16 * tc + qi]; lb[tc] = lnb[16 * tc + qi]; kav[tc] = ka[16 * tc + qi]; rkv[tc] = rk[16 * tc + qi]; }
        {
            float a_y0[4][4], a_y1[4][4], a_k[4][4], a_z0[4][4], a_z1[4][4], a_r[4][4], a_v[4][4], a_g[4][4];
#pragma unroll
            for (int jj = 0; jj < 4; ++jj) {
                const size_t o = (size_t)(R0 + 16 * tr + 4 * g + jj) * AW + head * 64 + qi;
#pragma unroll
                for (int tc = 0; tc < 4; ++tc) { a_y0[jj][tc] = Y0[o + 16 * tc]; a_y1[jj][tc] = Y1[o + 16 * tc]; a_k[jj][tc] = Kf[o + 16 * tc]; a_z0[jj][tc] = Z0[o + 16 * tc];
                    a_z1[jj][tc] = Z1[o + 16 * tc]; a_r[jj][tc] = Rf[o + 16 * tc]; a_v[jj][tc] = Vf[o + 16 * tc]; a_g[jj][tc] = G[o + 16 * tc]; }
            }
            asm volatile("" ::: "memory");
#pragma unroll
            for (int jj = 0; jj < 4; ++jj) {
                const int row = R0 + 16 * tr + 4 * g + jj;
                float yv[4], s1 = 0.f, bs = 0.f;
#pragma unroll
                for (int tc = 0; tc < 4; ++tc) {
                    yv[tc] = y[0][tc][jj] + a_y0[jj][tc] + a_y1[jj][tc]; s1 += yv[tc];
                    const float kmean = a_k[jj][tc] * (1.0f + (0.5f * (sigmoidf_(a_z0[jj][tc]) + sigmoidf_(a_z1[jj][tc])) - 1.0f) * kav[tc]);
                    bs += a_r[jj][tc] * kmean * rkv[tc];
                }
                s1 = dpp_allsum16(s1); bs = dpp_allsum16(bs);
                const float mu = s1 * (1.0f / 64.0f);
                float s2 = 0.f;
#pragma unroll
                for (int tc = 0; tc < 4; ++tc) { yv[tc] -= mu; s2 += yv[tc] * yv[tc]; }
                s2 = dpp_allsum16(s2);
                const float rstd = rsqrtf(s2 * (1.0f / 64.0f) + GN_EPS);
#pragma unroll
                for (int tc = 0; tc < 4; ++tc) {
                    const float outv = (yv[tc] * rstd * lg[tc] + lb[tc] + bs * a_v[jj][tc]) * a_g[jj][tc];
                    YC[(size_t)row * 3072 + head * 64 + 16 * tc + qi] = f2bf(outv);
                }
            }
        }
    }
}


#ifndef PROBE_PHASE
#define PROBE_PHASE -1
#endif
#define REP(k) for (int rep_ = 0; rep_ < ((PROBE_PHASE == (k)) ? 2 : 1); ++rep_)
constexpr int NPH = 12;
constexpr int PH_TOTAL = 2 + DEPTH * NPH;

__global__ void __launch_bounds__(NTHREADS, 2) fwd_kernel(Args args) {
    extern __shared__ __attribute__((aligned(16))) unsigned char lds_raw[];
    Frame F;
    F.lds = (LAS unsigned char*)lds_raw;
    F.tid = threadIdx.x; F.lane = F.tid & 63; F.wave = __builtin_amdgcn_readfirstlane(F.tid >> 6);
    F.bid = blockIdx.x; F.nb = gridDim.x;
    F.in = args.in; F.ws = args.ws; F.out = args.out;
    unsigned char* ws = args.ws;
    const int lo = args.ph_lo, hi = args.ph_hi;
    const bool multi = (hi - lo) > 1;
    volatile LAS unsigned* bst = (volatile LAS unsigned*)(F.lds + LDS_BAR_OFF);
    if (F.tid < 4) bst[F.tid] = 0u;
    __syncthreads();
    XcdBarrier bar; bar.bar = (unsigned*)(ws + WS_CTL); bar.x = 0; bar.st = bst;
    if (multi) bar = xcd_barrier_post((unsigned*)(ws + WS_CTL), bst);
#define IN(k) (lo <= (k) && (k) < hi)
#define FRESH() do { asm volatile("v_mbcnt_lo_u32_b32 %0, -1, 0\n\tv_mbcnt_hi_u32_b32 %0, -1, %0" : "=v"(F.lane)); asm volatile("" : "+s"(F.wave), "+s"(F.bid), "+s"(F.nb)); \
    F.tid = F.wave * 64 + F.lane; asm volatile("" : "+s"(F.ws), "+s"(F.out)); ws = F.ws; } while (0)
#define SEAM(k) do { if (IN(k) && IN((k) + 1)) { asm volatile("" : "+s"(bar.x)); xcd_barrier(bar); } } while (0)

    if (IN(0)) { FRESH(); p0_prologue(F); }
    SEAM(0);

    for (int l = 0; l < DEPTH; ++l) {
        const int pb = 1 + l * NPH;
        if (IN(pb + 0)) REP(0) { FRESH(); norm_phase(F, l, 0, (const float*)(ws + WS_P2), l > 0 ? 32 : 0); }
        SEAM(pb + 0);
        if (IN(pb + 1)) REP(1) { FRESH();
            pg8::Gemm g{(const bf16_t*)(ws + WS_H), (const bf16_t*)(ws + WS_WIN) + (size_t)l * IN_COLS * D, MROWS, IN_COLS, D, D, D};
            pg8::StaticOrder S; S.init(MROWS, IN_COLS, F.nb, F.bid);
            pg8::EpiBf16<0> E{(bf16_t*)(ws + WS_U), IN_COLS};
            pg8::gemm_phase(F.lds, g, S, E, F.tid);
        }
        SEAM(pb + 1);
        if (IN(pb + 2)) REP(2) { FRESH(); prep1_phase(F, l); }
        SEAM(pb + 2);
        if (IN(pb + 3)) REP(3) { FRESH();
            {
                pg8::Gemm g{(const bf16_t*)(ws + WS_LA), (const bf16_t*)(ws + WS_WLORA) + (size_t)l * 5120 * 256, 5 * MROWS, 5120, 256, 256, 256};
                pg8::LoraOrder S; S.init(F.nb, F.bid);
                pg8::EpiLora E{(float*)(ws + WS_WD), (const float*)(ws + WS_LBIAS) + (size_t)l * 5 * AW};
                pg8::gemm_phase(F.lds, g, S, E, F.tid);
            }
            FRESH();
            {
                pg8::Gemm g{(const bf16_t*)(ws + WS_QL), (const bf16_t*)(ws + WS_WUQ) + (size_t)l * 1536 * 512, MROWS, 1536, 512, 512, 512};
                pg8::StaticOrder S; S.init(MROWS, 1536, F.nb, F.bid);
                pg8::EpiBf16<0> E{(bf16_t*)(ws + WS_Q), 1536};
                pg8::gemm_phase(F.lds, g, S, E, F.tid);
            }
            FRESH();
            {
                pg8::Gemm g{(const bf16_t*)(ws + WS_KVL), (const bf16_t*)(ws + WS_WUKV) + (size_t)l * 2048 * 256, MROWS, 2048, 256, 256, 256};
                pg8::StaticOrder S; S.init(MROWS, 2048, F.nb, F.bid);
                pg8::EpiKV E{(bf16_t*)(ws + WS_KC), (bf16_t*)(ws + WS_VC)};
                pg8::gemm_phase(F.lds, g, S, E, F.tid);
            }
        }
        SEAM(pb + 3);
        if (IN(pb + 4)) REP(4) { FRESH(); rwkvA_phase(F, l); }
        SEAM(pb + 4);
        if (IN(pb + 5)) REP(5) { FRESH(); if (!(args.flags & 1)) rwkvB_phase(F); FRESH(); attn_phase(F, l, args.flags); }
        SEAM(pb + 5);
        if (IN(pb + 6)) REP(6) { FRESH(); rwkvC_readout_phase(F, l); }
        SEAM(pb + 6);
        if (IN(pb + 7)) REP(7) { FRESH();
            { pg8::Gemm g{(const bf16_t*)(ws + WS_YCAT), (const bf16_t*)(ws + WS_WB) + (size_t)l * D * 3072, SEQ, D, 3072, 3072, 3072};
              pg8::StaticOrder S; S.init(SEQ, D, F.nb, F.bid);
              pg8::EpiMerge E{(bf16_t*)(ws + WS_MRGB), (const bf16_t*)(ws + WS_U) + GATE_OFF};
              pg8::gemm_phase<pg8::EpiMerge, pg8::StaticOrder, 16>(F.lds, g, S, E, F.tid); }
            FRESH();
            if (l < DEPTH - 1)
            { pg8::Gemm g{(const bf16_t*)(ws + WS_YCAT) + (size_t)SEQ * 3072, (const bf16_t*)(ws + WS_WB) + (size_t)l * D * 3072, 3 * 256, D, 1024, 3072, 3072, 2048, -1, 2048};
              pg8::StaticOrder S; S.init(3 * 256, D, F.nb, F.nb - 1 - F.bid);
              pg8::EpiPartial<1> E{(float*)(ws + WS_PM), nullptr, (const bf16_t*)(ws + WS_U) + (size_t)SEQ * IN_COLS + GATE_OFF};
              pg8::gemm_phase(F.lds, g, S, E, F.tid); }
        }
        SEAM(pb + 7);
        if (IN(pb + 8)) REP(8) { FRESH();
            const float* mod = (const float*)(ws + WS_MOD) + (size_t)l * 2 * 6 * D;
            { pg8::Gemm g{(const bf16_t*)(ws + WS_MRGB), (const bf16_t*)(ws + WS_WO) + (size_t)l * D * D, SEQ, D, D, D, D};
              pg8::StaticOrder S; S.init(SEQ, D, F.nb, F.bid);
              pg8::EpiResid E{(float*)(ws + ((args.flags & 8) ? WS_Y : WS_X)), mod + 2 * D, mod + 6 * D + 2 * D};
              pg8::gemm_phase(F.lds, g, S, E, F.tid); }
            FRESH();
            {
                const int cu = F.nb - 1 - F.bid;
                if (cu < 64 && l < DEPTH - 1) {
                    pg8::StaticOrder S; S.init(8 * 256, D, F.nb, cu);
                    pg8::Unit u0; S.next(0, u0);
                    bf16_t* scr = (bf16_t*)(ws + WS_CSCR) + (size_t)cu * 65536;
                    const float* src = (const float*)(ws + WS_PM) + u0.pm * 256;
                    for (int i = F.tid; i < 256 * 64; i += NTHREADS) { const int r = i >> 6, c4 = (i & 63) * 4; f32x4 v = *(const f32x4*)(src + (size_t)r * D + c4);
#pragma unroll
                        for (int s = 1; s < 3; ++s) v += *(const f32x4*)(src + (size_t)s * CTXL * D + (size_t)r * D + c4);
                        u32x2 w; w.x = cvt_pk_bf16(v[0], v[1]); w.y = cvt_pk_bf16(v[2], v[3]); *(u32x2*)(scr + r * 256 + c4) = w; }
                    __builtin_amdgcn_fence(__ATOMIC_RELEASE, "agent"); asm volatile("s_waitcnt vmcnt(0)" ::: "memory"); __syncthreads();
                    __builtin_amdgcn_fence(__ATOMIC_ACQUIRE, "agent"); asm volatile("s_waitcnt vmcnt(0)" ::: "memory");
                    pg8::Gemm g{scr, (const bf16_t*)(ws + WS_WO) + (size_t)l * D * D, 8 * 256, D, 256, 256, D, 0, -1, 512};
                    pg8::EpiPartial<0> E{(float*)(ws + WS_PO), mod + 6 * D + 2 * D, nullptr};
                    pg8::gemm_phase(F.lds, g, S, E, F.tid);
                }
            }
        }
        SEAM(pb + 8);
        if (IN(pb + 9)) REP(9) { FRESH(); norm_phase(F, l, 1, (const float*)(ws + WS_PO), l < DEPTH - 1 ? 8 : 0); }
        SEAM(pb + 9);
        if (IN(pb + 10)) REP(10) { FRESH();
            const int mrows = (l < DEPTH - 1) ? MROWS : SEQ;
            pg8::Gemm g{(const bf16_t*)(ws + WS_H), (const bf16_t*)(ws + WS_W1) + (size_t)l * DFF * D, mrows, DFF, D, D, D};
            pg8::StaticOrder S; S.init(mrows, DFF, F.nb, F.bid);
            pg8::EpiBf16<1> E{(bf16_t*)(ws + WS_U), DFF};
            pg8::gemm_phase(F.lds, g, S, E, F.tid);
        }
        SEAM(pb + 10);
        if (IN(pb + 11)) REP(11) { FRESH();
            const float* mod = (const float*)(ws + WS_MOD) + (size_t)l * 2 * 6 * D;
            { pg8::Gemm g{(const bf16_t*)(ws + WS_U), (const bf16_t*)(ws + WS_W2) + (size_t)l * D * DFF, SEQ, D, DFF, DFF, DFF};
              pg8::StaticOrder S; S.init(SEQ, D, F.nb, F.bid);
              pg8::EpiResid E{(float*)(ws + ((args.flags & 8) ? WS_Y : WS_X)), mod + 5 * D, mod + 6 * D + 5 * D};
              pg8::gemm_phase(F.lds, g, S, E, F.tid); }
            FRESH();
            if (l < DEPTH - 1)
            { pg8::Gemm g{(const bf16_t*)(ws + WS_U) + (size_t)SEQ * DFF, (const bf16_t*)(ws + WS_W2) + (size_t)l * D * DFF, 32 * 256, D, 256, DFF, DFF, 512, -1, 512};
              pg8::StaticOrder S; S.init(32 * 256, D, F.nb, F.nb - 1 - F.bid);
              pg8::EpiPartial<0> E{(float*)(ws + WS_P2), mod + 6 * D + 5 * D, nullptr};
              pg8::gemm_phase(F.lds, g, S, E, F.tid); }
        }
        SEAM(pb + 11);
    }
    if (IN(PH_TOTAL - 1)) { FRESH(); final_norm_phase(F); }
#undef IN
#undef SEAM
}

#ifndef HOST_PROBE_FLAGS
#define HOST_PROBE_FLAGS 0
#endif
#ifndef HOST_PROBE_PHASE
#define HOST_PROBE_PHASE -1
#endif
#ifndef N_LAUNCH_MODE
#define N_LAUNCH_MODE 1
#endif
extern "C" void kernel_launch(void* const* d_in, const int* in_sizes, int n_in, void* d_out, int out_size, void* d_ws, size_t ws_size, hipStream_t stream) {
    static int grid = 0;
    if (grid == 0) {
        if (n_in != 30 || out_size != SEQ * D || ws_size < WS_END) { fprintf(stderr, "kernel_launch: unexpected shapes (n_in %d out %d ws %zu need %zu)\n", n_in, out_size, ws_size, (size_t)WS_END); grid = -1; return; }
        int dev = 0, cus = 0, per_cu = 0;
        if (hipGetDevice(&dev) != hipSuccess || hipDeviceGetAttribute(&cus, hipDeviceAttributeMultiprocessorCount, dev) != hipSuccess) { grid = -1; return; }
        if (hipFuncSetAttribute((const void*)fwd_kernel, hipFuncAttributeMaxDynamicSharedMemorySize, LDS_BYTES) != hipSuccess) { fprintf(stderr, "kernel_launch: hipFuncSetAttribute failed\n"); grid = -1; return; }
        if (hipOccupancyMaxActiveBlocksPerMultiprocessor(&per_cu, (const void*)fwd_kernel, NTHREADS, LDS_BYTES) != hipSuccess || per_cu < 1) { fprintf(stderr, "kernel_launch: occupancy query says %d\n", per_cu); (void)hipGetLastError(); grid = -1; return; }
        grid = cus;
    }
    if (grid < 0) return;
    (void)hipMemsetAsync((char*)d_ws + WS_CTL, 0, CTL_BYTES, stream);
    Args a{};
    for (int i = 0; i < 30; ++i) a.in[i] = (const float*)d_in[i];
    a.out = (float*)d_out; a.ws = (unsigned char*)d_ws;
#if N_LAUNCH_MODE == 1
    a.ph_lo = 0; a.ph_hi = PH_TOTAL;
    hipLaunchKernelGGL(fwd_kernel, dim3(grid), dim3(NTHREADS), LDS_BYTES, stream, a);
#else
    for (int p = 0; p < PH_TOTAL; ++p) { a.ph_lo = p; a.ph_hi = p + 1;
        const int reps = ((p >= 1 && p < PH_TOTAL - 1 && ((p - 1) % NPH) == HOST_PROBE_PHASE) || (p == 0 && HOST_PROBE_PHASE == 100)) ? 2 : 1;
        for (int r = 0; r < reps; ++r) { a.flags = (r == 1) ? HOST_PROBE_FLAGS : 0; hipLaunchKernelGGL(fwd_kernel, dim3(grid), dim3(NTHREADS), LDS_BYTES, stream, a); } }
#endif
}
```

```cpp
#include <hip/hip_runtime.h>
#include <cstdio>
#include <cstdint>

#define LAS __attribute__((address_space(3)))
typedef unsigned short bf16_t;
typedef short bf16x8 __attribute__((ext_vector_type(8)));
typedef short bf16x4 __attribute__((ext_vector_type(4)));
typedef float f32x4 __attribute__((ext_vector_type(4)));
typedef float f32x2 __attribute__((ext_vector_type(2)));
typedef unsigned u32x4 __attribute__((ext_vector_type(4)));
typedef unsigned u32x2 __attribute__((ext_vector_type(2)));

constexpr int D = 2048, SEQ = 8192, CTXL = 256, MROWS = SEQ + CTXL, DEPTH = 4, GRIDW = 64;
constexpr int IN_COLS = 13568, RWKV_COLS = 3712, MLA_OFF = 3712, NA_OFF = 4352, GATE_OFF = 7424, DFF = 8192;
constexpr int AW = 1024;
constexpr int QLORA = 448, KVLORA = 128, QKROPE = 64, QKNOPE = 128, VDIM = 128, BHEADS = 8, QHD = 192;
constexpr float RMS_EPS = 1e-6f, GN_EPS = 64e-5f;
constexpr float LOG2E = 1.4426950408889634f;

constexpr size_t al256(size_t x) { return (x + 255) & ~(size_t)255; }
constexpr size_t WS_CTL = 0;
constexpr size_t CTL_BYTES = 65536;
constexpr size_t WS_MOD = WS_CTL + CTL_BYTES;
constexpr size_t WS_LBIAS = al256(WS_MOD + (size_t)DEPTH * 2 * 6 * D * 4);
constexpr size_t WS_ROPE = al256(WS_LBIAS + (size_t)DEPTH * 5 * AW * 4);
constexpr size_t WS_X = al256(WS_ROPE + (size_t)SEQ * 32 * 2 * 4);
constexpr size_t WS_H = al256(WS_X + (size_t)MROWS * D * 4);
constexpr size_t WS_U = al256(WS_H + (size_t)MROWS * D * 2);
constexpr size_t WS_WIN = al256(WS_U + (size_t)MROWS * IN_COLS * 2);
constexpr size_t WS_W1 = al256(WS_WIN + (size_t)DEPTH * IN_COLS * D * 2);
constexpr size_t WS_W2 = al256(WS_W1 + (size_t)DEPTH * DFF * D * 2);
constexpr size_t WS_WB = al256(WS_W2 + (size_t)DEPTH * DFF * D * 2);
constexpr size_t WS_WO = al256(WS_WB + (size_t)DEPTH * D * 3072 * 2);
constexpr size_t WS_WUQ = al256(WS_WO + (size_t)DEPTH * D * D * 2);
constexpr size_t WS_WUKV = al256(WS_WUQ + (size_t)DEPTH * 1536 * 512 * 2);
constexpr size_t WS_WLORA = al256(WS_WUKV + (size_t)DEPTH * 2048 * 256 * 2);
constexpr size_t WS_RF = al256(WS_WLORA + (size_t)DEPTH * 5120 * 256 * 2);
constexpr size_t WS_KF = al256(WS_RF + (size_t)MROWS * AW * 4);
constexpr size_t WS_VF = al256(WS_KF + (size_t)MROWS * AW * 4);
constexpr size_t WS_WD = al256(WS_VF + (size_t)MROWS * AW * 4);
constexpr size_t WS_AD = al256(WS_WD + (size_t)2 * MROWS * AW * 4);
constexpr size_t WS_G = al256(WS_AD + (size_t)2 * MROWS * AW * 4);
constexpr size_t WS_Y = al256(WS_G + (size_t)MROWS * AW * 4);
constexpr size_t WS_LA = al256(WS_Y + (size_t)2 * MROWS * AW * 4);
constexpr size_t WS_QL = al256(WS_LA + (size_t)MROWS * 1280 * 2);
constexpr size_t WS_KVL = al256(WS_QL + (size_t)MROWS * 512 * 2);
constexpr size_t WS_KPE = al256(WS_KVL + (size_t)MROWS * 256 * 2);
constexpr size_t WS_Q = WS_KPE;
constexpr size_t WS_KC = al256(WS_Q + (size_t)MROWS * 1536 * 2);
constexpr size_t WS_VC = al256(WS_KC + (size_t)MROWS * 1536 * 2);
constexpr size_t WS_YCAT = al256(WS_VC + (size_t)MROWS * 1024 * 2);
constexpr size_t WS_MRG = WS_RF;
constexpr size_t WS_MRGB = al256(WS_YCAT + (size_t)MROWS * 3072 * 2);
constexpr size_t WS_MN = al256(WS_MRGB + (size_t)MROWS * D * 2);
constexpr size_t WS_RY = al256(WS_MN + (size_t)4224 * 2 * 4096 * 4);
constexpr size_t WS_SC = al256(WS_RY + (size_t)4224 * 4096 * 2);
constexpr size_t WS_CSCR = al256(WS_SC + (size_t)4224 * 4096 * 2);
constexpr size_t WS_PM = WS_MN;
constexpr size_t WS_PO = WS_PM + (size_t)12 * CTXL * D * 4;
constexpr size_t WS_P2 = WS_PO + (size_t)8 * CTXL * D * 4;
static_assert(WS_P2 + (size_t)32 * CTXL * D * 4 <= WS_RY, "partial slabs must fit the MN buffer");
constexpr size_t WS_MLAST = al256(WS_CSCR + (size_t)64 * 65536 * 2);
constexpr size_t WS_END = al256(WS_MLAST + (size_t)32 * 8 * 66 * 64 * 4);
static_assert(WS_KF == WS_RF + (size_t)MROWS * AW * 4, "MRG alias needs r|k contiguous");

constexpr int LDS_BYTES = 147456;
constexpr int LDS_BAR_OFF = LDS_BYTES - 16;
constexpr int NTHREADS = 512;

typedef __bf16 bf16x2n __attribute__((ext_vector_type(2)));
__device__ __forceinline__ unsigned cvt_pk_bf16(float lo, float hi) { return __builtin_bit_cast(unsigned, __builtin_convertvector((f32x2){lo, hi}, bf16x2n)); }
__device__ __forceinline__ bf16_t f2bf(float f) { return __builtin_bit_cast(bf16_t, (__bf16)f); }
__device__ __forceinline__ float bf2f(bf16_t h) { return __uint_as_float(((unsigned)h) << 16); }
__device__ __forceinline__ float bflo(unsigned w) { return __uint_as_float(w << 16); }
__device__ __forceinline__ float bfhi(unsigned w) { return __uint_as_float(w & 0xFFFF0000u); }
__device__ __forceinline__ float sigmoidf_(float x) { return __builtin_amdgcn_rcpf(1.0f + __expf(-x)); }
__device__ __forceinline__ void unpack8(const u32x4 w, float (&f)[8]) { f[0] = bflo(w.x); f[1] = bfhi(w.x); f[2] = bflo(w.y); f[3] = bfhi(w.y); f[4] = bflo(w.z); f[5] = bfhi(w.z); f[6] = bflo(w.w); f[7] = bfhi(w.w); }
__device__ __forceinline__ u32x4 pack8(const float (&f)[8]) { u32x4 w; w.x = cvt_pk_bf16(f[0], f[1]); w.y = cvt_pk_bf16(f[2], f[3]); w.z = cvt_pk_bf16(f[4], f[5]); w.w = cvt_pk_bf16(f[6], f[7]); return w; }

__device__ __forceinline__ void lds_barrier() { asm volatile("s_waitcnt lgkmcnt(0)\n\ts_barrier" ::: "memory"); }
__device__ __forceinline__ f32x4 zero4v() { f32x4 z = (f32x4){0.f, 0.f, 0.f, 0.f}; asm volatile("" : "+v"(z)); return z; }
__device__ __forceinline__ float shx(float v, int m, int lane) { return __int_as_float(__builtin_amdgcn_ds_bpermute((lane ^ m) << 2, __float_as_int(v))); }
__device__ __forceinline__ float rows_max(float x) {
    const auto r = __builtin_amdgcn_permlane16_swap(__float_as_uint(x), __float_as_uint(x), false, false); x = fmaxf(__uint_as_float(r[0]), __uint_as_float(r[1]));
    const auto q = __builtin_amdgcn_permlane32_swap(__float_as_uint(x), __float_as_uint(x), false, false); return fmaxf(__uint_as_float(q[0]), __uint_as_float(q[1]));
}
__device__ __forceinline__ float rows_sum(float x) {
    const auto r = __builtin_amdgcn_permlane16_swap(__float_as_uint(x), __float_as_uint(x), false, false); x = __uint_as_float(r[0]) + __uint_as_float(r[1]);
    const auto q = __builtin_amdgcn_permlane32_swap(__float_as_uint(x), __float_as_uint(x), false, false); return __uint_as_float(q[0]) + __uint_as_float(q[1]);
}
__device__ __forceinline__ float wave_sum(float x, int  ) {
    x += __int_as_float(__builtin_amdgcn_update_dpp(0, __float_as_int(x), 0xB1, 0xF, 0xF, true));
    x += __int_as_float(__builtin_amdgcn_update_dpp(0, __float_as_int(x), 0x4E, 0xF, 0xF, true));
    x += __int_as_float(__builtin_amdgcn_update_dpp(0, __float_as_int(x), 0x141, 0xF, 0xF, true));
    x += __int_as_float(__builtin_amdgcn_update_dpp(0, __float_as_int(x), 0x140, 0xF, 0xF, true));
    const int xi = __float_as_int(x);
    return (__int_as_float(__builtin_amdgcn_readlane(xi, 0)) + __int_as_float(__builtin_amdgcn_readlane(xi, 16))) +
           (__int_as_float(__builtin_amdgcn_readlane(xi, 32)) + __int_as_float(__builtin_amdgcn_readlane(xi, 48)));
}

#define XB_TMO      128
#define XB_XCNT(j)  (256  + 64 * (j))
#define XB_XSUB(j)  (1280 + 64 * (j))
#define XB_XGEN(j)  (2304 + 64 * (j))
#define XB_TOP      3328
#define XB_TOPGEN   3392
#define XCD_BAR_WORDS 3456
#define XB_SPIN_CAP (1u << 22)

__device__ __forceinline__ unsigned xb_ld(unsigned* p)              { return __hip_atomic_load(p, __ATOMIC_RELAXED, __HIP_MEMORY_SCOPE_AGENT); }
__device__ __forceinline__ unsigned xb_add(unsigned* p, unsigned v) { return __hip_atomic_fetch_add(p, v, __ATOMIC_RELAXED, __HIP_MEMORY_SCOPE_AGENT); }
__device__ __forceinline__ unsigned xb_xcc_id() { return (unsigned)__builtin_amdgcn_s_getreg((3 << 11) | 20) & 0xFu; }
#define XB_SPIN(cond, bar) do { unsigned _sp = 0; while (cond) { __builtin_amdgcn_s_sleep(1); \
    if ((++_sp & 255u) == 0u) { if (xb_ld(&(bar)[XB_TMO])) break; if (_sp > XB_SPIN_CAP) { atomicAdd(&(bar)[XB_TMO], 1u); break; } } } } while (0)

struct XcdBarrier { unsigned* bar; unsigned x; volatile LAS unsigned* st; };

__device__ __forceinline__ XcdBarrier xcd_barrier_post(unsigned* bar, volatile LAS unsigned* st) {
    XcdBarrier b; b.bar = bar; b.x = xb_xcc_id(); b.st = st;
    if (threadIdx.x == 0) (void)xb_add(&bar[XB_XCNT(b.x)], 1u);
    return b;
}
__device__ __forceinline__ void xcd_barrier_complete(unsigned* bar, unsigned x, unsigned& nloc, unsigned& nx) {
    const unsigned G = gridDim.x * gridDim.y * gridDim.z;
    unsigned sum, cnt, mine, sp = 0u;
    for (;;) {
        sum = 0u; cnt = 0u; mine = 0u;
#pragma unroll
        for (unsigned j = 0; j < 16; ++j) { const unsigned c = xb_ld(&bar[XB_XCNT(j)]); sum += c; cnt += (c > 0u) ? 1u : 0u; mine = (j == x) ? c : mine; }
        if (sum == G) break;
        __builtin_amdgcn_s_sleep(1);
        if ((++sp & 255u) == 0u) { if (xb_ld(&bar[XB_TMO])) break; if (sp > XB_SPIN_CAP) { atomicAdd(&bar[XB_TMO], 1u); break; } }
    }
    nloc = mine > 0u ? mine : 1u; nx = cnt > 0u ? cnt : 1u;
}
__device__ __forceinline__ void xcd_barrier(const XcdBarrier& b) {
    asm volatile("s_waitcnt vmcnt(0)" ::: "memory");
    __syncthreads();
    if (threadIdx.x == 0) {
        unsigned* bar = b.bar;
        __builtin_amdgcn_s_waitcnt(0);
        unsigned nloc = b.st[0], nx = b.st[1];
        if (nloc == 0u) { xcd_barrier_complete(bar, b.x, nloc, nx); b.st[0] = nloc; b.st[1] = nx; }
        const unsigned old = xb_add(&bar[XB_XSUB(b.x)], 1u);
        const unsigned gen = old / nloc;
        if (old + 1u == (gen + 1u) * nloc) {
            __builtin_amdgcn_fence(__ATOMIC_RELEASE, "agent");
            asm volatile("s_waitcnt vmcnt(0)" ::: "memory");
            const unsigned og = xb_add(&bar[XB_TOP], 1u);
            const unsigned tg = og / nx;
            if (og + 1u == (tg + 1u) * nx) xb_add(&bar[XB_TOPGEN], 1u);
            else XB_SPIN(xb_ld(&bar[XB_TOPGEN]) == tg, bar);
            __builtin_amdgcn_fence(__ATOMIC_ACQUIRE, "agent");
            xb_add(&bar[XB_XGEN(b.x)], 1u);
            asm volatile("s_waitcnt vmcnt(0)" ::: "memory");
        } else {
            XB_SPIN(xb_ld(&bar[XB_XGEN(b.x)]) == gen, bar);
            __builtin_amdgcn_fence(__ATOMIC_ACQUIRE, "agent");
            asm volatile("s_waitcnt vmcnt(0)" ::: "memory");
        }
    }
    __syncthreads();
}

namespace pg8 {
constexpr int BM = 256, BK = 64, HALF = 128, HTB = HALF * BK * 2, STAGE_BYTES = 8 * HTB, NXCD = 8, WGM = 4;
__host__ __device__ __forceinline__ int lds_byte(int r, int c) { const int st = (r >> 4) * 2 + (c >> 5), rr = r & 15, cc = c & 31, ob = rr * 64 + cc * 2; return st * 1024 + (ob ^ (((ob >> 9) & 1) << 5)); }
__host__ __device__ __forceinline__ void stage_rc(int b, int& R, int& C) { const int st = b / 1024, sb = b % 1024, swz = sb ^ (((sb >> 9) & 1) << 5); R = (st >> 1) * 16 + swz / 64; C = (st & 1) * 32 + (swz % 64) / 2; }
__host__ __device__ __forceinline__ int perm32(int rho) { const int n = rho >> 4, i = rho & 15; return 8 * (i >> 2) + 4 * n + (i & 3); }

struct Unit { int pm, pn; };
struct Gemm { const bf16_t* A; const bf16_t* Bt; int M, N, K, lda, ldb;
    long pstepA = -1, pstepB = -1, qstepB = 0; };

struct StaticOrder {
    int nM, nN, nwg, G, c;
    __device__ __forceinline__ void init(int M, int N, int G_, int c_) { nM = M / BM; nN = N / BM; nwg = nM * nN; G = G_; c = c_; }
    __device__ __forceinline__ bool next(int i, Unit& u) const {
        const long L = (long)i * G + c; if (L >= nwg) return false;
        int wgid = (int)L; { const int q = nwg / NXCD, r = nwg % NXCD, xcd = wgid % NXCD, off = wgid / NXCD; wgid = (xcd < r ? xcd * (q + 1) : r * (q + 1) + (xcd - r) * q) + off; }
        const int nig = WGM * nN, gid = wgid / nig, fm = gid * WGM, gsz = (nM - fm) < WGM ? (nM - fm) : WGM;
        u.pm = fm + ((wgid % nig) % gsz); u.pn = (wgid % nig) / gsz; return true;
    }
};

struct LoraOrder {
    int G, c;
    __device__ __forceinline__ void init(int G_, int c_) { G = G_; c = c_; }
    __device__ __forceinline__ bool next(int i, Unit& u) const {
        const int L = i * G + c; if (L >= 5 * 132) return false;
        const int grp = L / 132, r = L - grp * 132;
        u.pm = grp * (MROWS / 256) + (r % (MROWS / 256)); u.pn = grp * 4 + r / (MROWS / 256); return true;
    }
};

template <class Epi, class Sched, int MIDK = 0, bool ALIGN_EPI = true>
__device__ __forceinline__ void gemm_phase(LAS unsigned char* lds, const Gemm g, const Sched& S, const Epi& E, const int tid) {
    const int wid = __builtin_amdgcn_readfirstlane(tid >> 6), lane = tid & 63, wr = wid >> 2, wc = wid & 3, fr = lane & 15, fq = lane >> 4;
    int nt = g.K / BK; asm volatile("" : "+s"(nt));
    unsigned voffA[2], voffB[2];
#pragma unroll
    for (int i = 0; i < 2; ++i) { int R, C; stage_rc(tid * 16 + i * 8192, R, C); const int Rb = Epi::PERM ? ((R & ~31) + perm32(R & 31)) : R;
        voffA[i] = (unsigned)(R * g.lda + C) * 2u; voffB[i] = (unsigned)(Rb * g.ldb + C) * 2u; }
    const size_t kstep = (size_t)(BK * 2);
    const size_t hstepA = (size_t)HALF * g.lda * 2, hstepB = (size_t)HALF * g.ldb * 2;
    const size_t tstepA = g.pstepA < 0 ? 2 * hstepA : (size_t)g.pstepA, tstepB = g.pstepB < 0 ? 2 * hstepB : (size_t)g.pstepB, qB = (size_t)g.qstepB;
    const unsigned ldsw = (unsigned)wid * 1024u;
    const int aoff = lds_byte(wr * 64 + fr, fq * 8), boff = lds_byte(wc * 32 + fr, fq * 8);
#define PG8_SA(b, h) (((b) * 2 + (h)) * HTB)
#define PG8_SB(b, h) ((4 + (b) * 2 + (h)) * HTB)
#define PG8_STAGE(bufoff, gbase, voff) do { _Pragma("unroll") for (int _i = 0; _i < 2; ++_i) \
        __builtin_amdgcn_global_load_lds((const unsigned*)((const char*)(gbase) + (voff)[_i]), (LAS unsigned*)(lds + (bufoff) + ldsw + _i * 8192), 16, 0, 0); } while (0)
#define PG8_LDA(dst, b, h) do { _Pragma("unroll") for (int m = 0; m < 4; ++m) _Pragma("unroll") for (int k = 0; k < 2; ++k) dst[m][k] = *(const LAS bf16x8*)(lds + PG8_SA(b, h) + aoff + m * 2048 + k * 1024); } while (0)
#define PG8_LDB(dst, b, h) do { _Pragma("unroll") for (int n = 0; n < 2; ++n) _Pragma("unroll") for (int k = 0; k < 2; ++k) dst[n][k] = *(const LAS bf16x8*)(lds + PG8_SB(b, h) + boff + n * 2048 + k * 1024); } while (0)
#define PG8_MMA(ai, bj, At, Bt) do { __builtin_amdgcn_s_setprio(1); _Pragma("unroll") for (int m = 0; m < 4; ++m) _Pragma("unroll") for (int n = 0; n < 2; ++n) _Pragma("unroll") for (int k = 0; k < 2; ++k) \
        acc[ai][bj][m][n] = __builtin_amdgcn_mfma_f32_16x16x32_bf16(Bt[n][k], At[m][k], acc[ai][bj][m][n], 0, 0, 0); __builtin_amdgcn_s_setprio(0); } while (0)
#define PG8_WAIT_V(n) asm volatile("s_waitcnt vmcnt(" #n ")" ::: "memory")
#define PG8_WAIT_L(n) asm volatile("s_waitcnt lgkmcnt(" #n ")" ::: "memory")
#define PG8_BAR __builtin_amdgcn_s_barrier()
#define PG8_SCHED __builtin_amdgcn_sched_barrier(0)
    Unit cur, nxt; int ui = 0;
    if (!S.next(0, cur)) return;
    f32x4 acc[2][2][4][2];
#pragma unroll
    for (int a = 0; a < 2; ++a)
#pragma unroll
        for (int b = 0; b < 2; ++b)
#pragma unroll
            for (int m = 0; m < 4; ++m)
#pragma unroll
                for (int n = 0; n < 2; ++n) acc[a][b][m][n] = zero4v();
    bf16x8 At[4][2], B0[2][2], B1[2][2];
    const char* cA = (const char*)g.A + (size_t)cur.pm * tstepA; const char* cB = (const char*)g.Bt + (size_t)cur.pn * tstepB + (size_t)cur.pm * qB;
    PG8_STAGE(PG8_SB(0, 0), cB, voffB); PG8_STAGE(PG8_SB(0, 1), cB + hstepB, voffB); PG8_STAGE(PG8_SA(0, 0), cA, voffA); PG8_STAGE(PG8_SA(0, 1), cA + hstepA, voffA);
    if (wr == 1) PG8_BAR;
    PG8_WAIT_V(2); PG8_BAR;
    PG8_STAGE(PG8_SB(1, 0), cB + kstep, voffB); PG8_STAGE(PG8_SA(1, 0), cA + kstep, voffA); PG8_STAGE(PG8_SB(1, 1), cB + hstepB + kstep, voffB);
    PG8_WAIT_V(6); PG8_BAR;
    for (;;) {
        const bool has_next = S.next(ui + 1, nxt);
        const char* nA = has_next ? (const char*)g.A + (size_t)nxt.pm * tstepA : cA; const char* nB = has_next ? (const char*)g.Bt + (size_t)nxt.pn * tstepB + (size_t)nxt.pm * qB : cB;
        for (int t = 0; t < nt; t += 2) {
            const bool last = (t == nt - 2);
            const char* a1 = cA + (size_t)(t + 1) * kstep;
            const char* a2 = last ? nA : cA + (size_t)(t + 2) * kstep; const char* b2 = last ? nB : cB + (size_t)(t + 2) * kstep;
            const char* a3 = a2 + kstep; const char* b3 = b2 + kstep;
            PG8_LDB(B0, 0, 0); PG8_LDB(B1, 0, 1); PG8_SCHED; PG8_LDA(At, 0, 0); PG8_STAGE(PG8_SA(1, 1), a1 + hstepA, voffA);
            PG8_WAIT_V(8); PG8_WAIT_L(0); PG8_BAR; PG8_MMA(0, 0, At, B0); PG8_MMA(0, 1, At, B1); PG8_BAR; PG8_SCHED;
            PG8_LDA(At, 0, 1); PG8_STAGE(PG8_SB(0, 0), b2, voffB); PG8_STAGE(PG8_SB(0, 1), b2 + hstepB, voffB); PG8_STAGE(PG8_SA(0, 0), a2, voffA);
            PG8_WAIT_V(8); PG8_WAIT_L(0); PG8_BAR; PG8_MMA(1, 0, At, B0); PG8_MMA(1, 1, At, B1); PG8_BAR; PG8_SCHED;
            PG8_LDB(B0, 1, 0); PG8_LDB(B1, 1, 1); PG8_SCHED; PG8_LDA(At, 1, 0); PG8_STAGE(PG8_SA(0, 1), a2 + hstepA, voffA);
            PG8_WAIT_V(8); PG8_WAIT_L(0); PG8_BAR; PG8_MMA(0, 0, At, B0); PG8_MMA(0, 1, At, B1); PG8_BAR; PG8_SCHED;
            PG8_LDA(At, 1, 1); PG8_STAGE(PG8_SB(1, 0), b3, voffB); PG8_STAGE(PG8_SB(1, 1), b3 + hstepB, voffB); PG8_STAGE(PG8_SA(1, 0), a3, voffA);
            PG8_WAIT_V(8); PG8_WAIT_L(0); PG8_BAR; PG8_MMA(1, 0, At, B0); PG8_MMA(1, 1, At, B1); PG8_BAR; PG8_SCHED;
            if constexpr (MIDK > 0) { if (((t + 2) % MIDK) == 0 && t + 2 < nt) { int ln_; asm volatile("v_mbcnt_lo_u32_b32 %0, -1, 0\n\tv_mbcnt_hi_u32_b32 %0, -1, %0" : "=v"(ln_)); E.mid(acc, cur, (t + 2) / MIDK - 1, wr, wc, ln_ & 15, ln_ >> 4); } }
        }
        if constexpr (ALIGN_EPI) { if (wr == 0) PG8_BAR; }
        { int ln_; asm volatile("v_mbcnt_lo_u32_b32 %0, -1, 0\n\tv_mbcnt_hi_u32_b32 %0, -1, %0" : "=v"(ln_)); E(acc, cur, wr, wc, ln_ & 15, ln_ >> 4); }
        if (!has_next) break;
#pragma unroll
        for (int a = 0; a < 2; ++a)
#pragma unroll
            for (int b = 0; b < 2; ++b)
#pragma unroll
                for (int m = 0; m < 4; ++m)
#pragma unroll
                    for (int n = 0; n < 2; ++n) acc[a][b][m][n] = zero4v();
        cur = nxt; cA = nA; cB = nB; ++ui;
        if constexpr (ALIGN_EPI) { if (wr == 1) PG8_BAR; }
    }
    PG8_WAIT_V(0);
    if constexpr (!ALIGN_EPI) { if (wr == 0) PG8_BAR; }
    PG8_BAR;
#undef PG8_SA
#undef PG8_SB
#undef PG8_STAGE
#undef PG8_LDA
#undef PG8_LDB
#undef PG8_MMA
#undef PG8_WAIT_V
#undef PG8_WAIT_L
#undef PG8_BAR
#undef PG8_SCHED
}

template <int ACT  > struct EpiBf16 {
    static constexpr bool PERM = true;
    bf16_t* O; int ldc;
    __device__ __forceinline__ void operator()(const f32x4 (&acc)[2][2][4][2], const Unit& u, int wr, int wc, int fr, int fq) const {
        const int row0 = u.pm * BM + wr * 64 + fr, col0 = u.pn * BM + wc * 32 + 8 * fq;
#pragma unroll
        for (int ai = 0; ai < 2; ++ai)
#pragma unroll
            for (int m = 0; m < 4; ++m) { bf16_t* rowp = O + (size_t)(row0 + ai * HALF + m * 16) * ldc + col0;
#pragma unroll
                for (int bj = 0; bj < 2; ++bj) { f32x4 v0 = acc[ai][bj][m][0], v1 = acc[ai][bj][m][1];
                    if (ACT == 1) {
#pragma unroll
                        for (int j = 0; j < 4; ++j) { const float a = fmaxf(v0[j], 0.f), b = fmaxf(v1[j], 0.f); v0[j] = a * a; v1[j] = b * b; } }
                    u32x4 w; w.x = cvt_pk_bf16(v0[0], v0[1]); w.y = cvt_pk_bf16(v0[2], v0[3]); w.z = cvt_pk_bf16(v1[0], v1[1]); w.w = cvt_pk_bf16(v1[2], v1[3]);
                    *(u32x4*)(rowp + bj * HALF) = w; } }
    }
};

struct EpiKV {
    static constexpr bool PERM = true;
    bf16_t* KC; bf16_t* VC;
    __device__ __forceinline__ void operator()(const f32x4 (&acc)[2][2][4][2], const Unit& u, int wr, int wc, int fr, int fq) const {
        const int row0 = u.pm * BM + wr * 64 + fr, c0 = wc * 32 + 8 * fq;
#pragma unroll
        for (int ai = 0; ai < 2; ++ai)
#pragma unroll
            for (int m = 0; m < 4; ++m) { const size_t row = (size_t)(row0 + ai * HALF + m * 16);
#pragma unroll
                for (int bj = 0; bj < 2; ++bj) { const f32x4 v0 = acc[ai][bj][m][0], v1 = acc[ai][bj][m][1];
                    u32x4 w; w.x = cvt_pk_bf16(v0[0], v0[1]); w.y = cvt_pk_bf16(v0[2], v0[3]); w.z = cvt_pk_bf16(v1[0], v1[1]); w.w = cvt_pk_bf16(v1[2], v1[3]);
                    bf16_t* dst = (bj == 0) ? KC + row * 1536 + u.pn * 192 + c0 : VC + row * 1024 + u.pn * 128 + c0;
                    *(u32x4*)dst = w; } }
    }
};

struct EpiLora {
    static constexpr bool PERM = false;
    float* Z; const float* bias;
    __device__ __forceinline__ void operator()(const f32x4 (&acc)[2][2][4][2], const Unit& u, int wr, int wc, int fr, int fq) const {
        const int grp = u.pn >> 2;
        const int row0 = (u.pm - grp * (MROWS / 256)) * BM + wr * 64 + fr, col0 = (u.pn & 3) * BM + wc * 32 + 4 * fq;
        float* base = Z + (size_t)grp * MROWS * AW; const float* bp = bias + grp * AW + col0;
        f32x4 bv[2][2];
#pragma unroll
        for (int bj = 0; bj < 2; ++bj)
#pragma unroll
            for (int n = 0; n < 2; ++n) bv[bj][n] = *(const f32x4*)(bp + bj * HALF + n * 16);
#pragma unroll
        for (int ai = 0; ai < 2; ++ai)
#pragma unroll
            for (int m = 0; m < 4; ++m) { float* rowp = base + (size_t)(row0 + ai * HALF + m * 16) * AW + col0;
#pragma unroll
                for (int bj = 0; bj < 2; ++bj)
#pragma unroll
                    for (int n = 0; n < 2; ++n) *(f32x4*)(rowp + bj * HALF + n * 16) = acc[ai][bj][m][n] + bv[bj][n]; }
    }
};

struct EpiMerge {
    static constexpr bool PERM = true;
    bf16_t* Mb; const bf16_t* Ug;
    __device__ __forceinline__ void mid(f32x4 (&acc)[2][2][4][2], const Unit& u, int seg, int wr, int wc, int fr, int fq) const {
        const int row0 = u.pm * BM + wr * 64 + fr, col0 = u.pn * BM + wc * 32 + 8 * fq;
#pragma unroll
        for (int ai = 0; ai < 2; ++ai) {
            u32x4 ga[4][2], gb[4][2];
#pragma unroll
            for (int m = 0; m < 4; ++m) { const bf16_t* gp = Ug + (size_t)(row0 + ai * HALF + m * 16) * IN_COLS + seg * 2048 + col0;
#pragma unroll
                for (int bj = 0; bj < 2; ++bj) { ga[m][bj] = *(const u32x4*)(gp + bj * HALF); gb[m][bj] = *(const u32x4*)(gp + 2048 + bj * HALF); } }
            asm volatile("" ::: "memory");
#pragma unroll
            for (int m = 0; m < 4; ++m)
#pragma unroll
                for (int bj = 0; bj < 2; ++bj) {
                    float a[8], b[8]; unpack8(ga[m][bj], a); unpack8(gb[m][bj], b);
#pragma unroll
                    for (int e = 0; e < 8; ++e) { const float ea = __expf(-fminf(fmaxf(a[e], -30.f), 30.f)), eb = __expf(-fminf(fmaxf(b[e], -30.f), 30.f));
                        const float ratio = (1.0f + eb) * __builtin_amdgcn_rcpf(1.0f + ea);
                        acc[ai][bj][m][e >> 2][e & 3] *= ratio; }
                }
        }
    }
    __device__ __forceinline__ void operator()(const f32x4 (&acc)[2][2][4][2], const Unit& u, int wr, int wc, int fr, int fq) const {
        const int row0 = u.pm * BM + wr * 64 + fr, col0 = u.pn * BM + wc * 32 + 8 * fq;
#pragma unroll
        for (int ai = 0; ai < 2; ++ai) {
            u32x4 gq_[4][2];
#pragma unroll
            for (int m = 0; m < 4; ++m)
#pragma unroll
                for (int bj = 0; bj < 2; ++bj) gq_[m][bj] = *(const u32x4*)(Ug + (size_t)(row0 + ai * HALF + m * 16) * IN_COLS + 4096 + col0 + bj * HALF);
            asm volatile("" ::: "memory");
#pragma unroll
            for (int m = 0; m < 4; ++m) { const size_t row = (size_t)(row0 + ai * HALF + m * 16);
#pragma unroll
                for (int bj = 0; bj < 2; ++bj) { const int col = col0 + bj * HALF;
                    float gq[8]; unpack8(gq_[m][bj], gq);
                    f32x4 v0 = acc[ai][bj][m][0], v1 = acc[ai][bj][m][1];
#pragma unroll
                    for (int e = 0; e < 4; ++e) { v0[e] *= sigmoidf_(gq[e]); v1[e] *= sigmoidf_(gq[4 + e]); }
                    u32x4 w; w.x = cvt_pk_bf16(v0[0], v0[1]); w.y = cvt_pk_bf16(v0[2], v0[3]); w.z = cvt_pk_bf16(v1[0], v1[1]); w.w = cvt_pk_bf16(v1[2], v1[3]);
                    *(u32x4*)(Mb + row * D + col) = w; } }
        }
    }
};

struct EpiResid {
    static constexpr bool PERM = false;
    float* X; const float* gl; const float* gc;
    __device__ __forceinline__ void operator()(const f32x4 (&acc)[2][2][4][2], const Unit& u, int wr, int wc, int fr, int fq) const {
        const int row0 = u.pm * BM + wr * 64 + fr, col0 = u.pn * BM + wc * 32 + 4 * fq;
        const float* gate = (u.pm * BM < SEQ) ? gl : gc;
        f32x4 gv[2][2];
#pragma unroll
        for (int bj = 0; bj < 2; ++bj)
#pragma unroll
            for (int n = 0; n < 2; ++n) gv[bj][n] = *(const f32x4*)(gate + col0 + bj * HALF + n * 16);
#pragma unroll
        for (int ai = 0; ai < 2; ++ai) {
            f32x4 xv[4][2][2];
#pragma unroll
            for (int m = 0; m < 4; ++m)
#pragma unroll
                for (int bj = 0; bj < 2; ++bj)
#pragma unroll
                    for (int n = 0; n < 2; ++n) xv[m][bj][n] = *(const f32x4*)(X + (size_t)(row0 + ai * HALF + m * 16) * D + col0 + bj * HALF + n * 16);
            asm volatile("" ::: "memory");
#pragma unroll
            for (int m = 0; m < 4; ++m)
#pragma unroll
                for (int bj = 0; bj < 2; ++bj)
#pragma unroll
                    for (int n = 0; n < 2; ++n) *(f32x4*)(X + (size_t)(row0 + ai * HALF + m * 16) * D + col0 + bj * HALF + n * 16) = xv[m][bj][n] + acc[ai][bj][m][n] * gv[bj][n];
            asm volatile("" ::: "memory");
        }
    }
};

template <int GATE> struct EpiPartial {
    static constexpr bool PERM = false;
    float* P; const float* gate; const bf16_t* Ugc;
    __device__ __forceinline__ void operator()(const f32x4 (&acc)[2][2][4][2], const Unit& u, int wr, int wc, int fr, int fq) const {
        const int row0 = wr * 64 + fr, col0 = u.pn * BM + wc * 32 + 4 * fq;
        float* base = P + (size_t)u.pm * CTXL * D;
#pragma unroll
        for (int ai = 0; ai < 2; ++ai)
#pragma unroll
            for (int m = 0; m < 4; ++m) { const int row = row0 + ai * HALF + m * 16;
#pragma unroll
                for (int bj = 0; bj < 2; ++bj)
#pragma unroll
                    for (int n = 0; n < 2; ++n) { const int col = col0 + bj * HALF + n * 16;
                        f32x4 gv;
                        if (GATE == 0) gv = *(const f32x4*)(gate + col);
                        else { const u32x2 gw = *(const u32x2*)(Ugc + (size_t)row * IN_COLS + u.pm * 2048 + col);
                            gv[0] = sigmoidf_(bflo(gw.x)); gv[1] = sigmoidf_(bfhi(gw.x)); gv[2] = sigmoidf_(bflo(gw.y)); gv[3] = sigmoidf_(bfhi(gw.y)); }
                        *(f32x4*)(base + (size_t)row * D + col) = acc[ai][bj][m][n] * gv; } }
    }
};
}

struct Args { const float* in[30]; float* out; unsigned char* ws; int ph_lo, ph_hi, flags, pad_; };
enum { I_X = 0, I_C, I_CTX, I_CCTX, I_ADAW, I_ADAB, I_NMIXG, I_NMLPG, I_WIN, I_CONV, I_W0, I_WUP, I_A0, I_AUP, I_GUP, I_KK, I_KA, I_RK, I_LNG, I_LNB,
       I_QNG, I_WUQ, I_KVNG, I_WUKV, I_RPB, I_WBR, I_WOUT, I_W1, I_W2, I_FNG };

struct Frame {
    LAS unsigned char* lds; int tid, lane, wave, bid, nb;
    const float* const* in; unsigned char* ws; float* out;
};

struct TJob { const float* src; bf16_t* dst; int K, Kpad, N, ldd; };

__device__ __forceinline__ TJob make_job(const Frame& F, int l, int j) {
    TJob t; unsigned char* ws = F.ws;
    switch (j) {
    case 0: t.src = F.in[I_WIN] + (size_t)l * D * IN_COLS; t.dst = (bf16_t*)(ws + WS_WIN) + (size_t)l * IN_COLS * D; t.K = D; t.Kpad = D; t.N = IN_COLS; t.ldd = D; break;
    case 1: t.src = F.in[I_W1] + (size_t)l * D * DFF; t.dst = (bf16_t*)(ws + WS_W1) + (size_t)l * DFF * D; t.K = D; t.Kpad = D; t.N = DFF; t.ldd = D; break;
    case 2: t.src = F.in[I_W2] + (size_t)l * DFF * D; t.dst = (bf16_t*)(ws + WS_W2) + (size_t)l * D * DFF; t.K = DFF; t.Kpad = DFF; t.N = D; t.ldd = DFF; break;
    case 3: case 4: case 5: t.src = F.in[I_WBR] + ((size_t)l * 3 + (j - 3)) * 1024 * D; t.dst = (bf16_t*)(ws + WS_WB) + (size_t)l * D * 3072 + (j - 3) * 1024; t.K = 1024; t.Kpad = 1024; t.N = D; t.ldd = 3072; break;
    case 6: t.src = F.in[I_WOUT] + (size_t)l * D * D; t.dst = (bf16_t*)(ws + WS_WO) + (size_t)l * D * D; t.K = D; t.Kpad = D; t.N = D; t.ldd = D; break;
    case 7: t.src = F.in[I_WUQ] + (size_t)l * QLORA * 1536; t.dst = (bf16_t*)(ws + WS_WUQ) + (size_t)l * 1536 * 512; t.K = QLORA; t.Kpad = 512; t.N = 1536; t.ldd = 512; break;
    case 8: t.src = F.in[I_WUKV] + (size_t)l * KVLORA * 2048; t.dst = (bf16_t*)(ws + WS_WUKV) + (size_t)l * 2048 * 256; t.K = KVLORA; t.Kpad = 256; t.N = 2048; t.ldd = 256; break;
    case 9: case 10: t.src = F.in[I_WUP] + ((size_t)l * 2 + (j - 9)) * 96 * AW; t.dst = (bf16_t*)(ws + WS_WLORA) + ((size_t)l * 5 + (j - 9)) * 1024 * 256; t.K = 96; t.Kpad = 256; t.N = AW; t.ldd = 256; break;
    case 11: case 12: t.src = F.in[I_AUP] + ((size_t)l * 2 + (j - 11)) * 96 * AW; t.dst = (bf16_t*)(ws + WS_WLORA) + ((size_t)l * 5 + 2 + (j - 11)) * 1024 * 256; t.K = 96; t.Kpad = 256; t.N = AW; t.ldd = 256; break;
    default: t.src = F.in[I_GUP] + (size_t)l * 256 * AW; t.dst = (bf16_t*)(ws + WS_WLORA) + ((size_t)l * 5 + 4) * 1024 * 256; t.K = 256; t.Kpad = 256; t.N = AW; t.ldd = 256; break;
    }
    return t;
}

__device__ __forceinline__ void transpose_job(const Frame& F, const TJob& J, int rot) {
    LAS float* tile = (LAS float*)F.lds;
    const int ntk = J.Kpad / 128, ntn = J.N / 64, ntiles = ntk * ntn;
    const int kr = F.tid >> 4, c4 = (F.tid & 15) * 4;
    const int sn = F.tid >> 3, k16 = (F.tid & 7) * 16;
    int start = F.bid - rot; if (start < 0) start += F.nb;
    f32x4 nx[4];
#define TJ_LOAD(ti_) do { const int tk_ = (ti_) / ntn, tn_ = (ti_) % ntn; \
        _Pragma("unroll") for (int it = 0; it < 4; ++it) { const int k = tk_ * 128 + kr + 32 * it; nx[it] = zero4v(); \
            if (k < J.K) nx[it] = *(const f32x4*)(J.src + (size_t)k * J.N + tn_ * 64 + c4); } } while (0)
    if (start < ntiles) TJ_LOAD(start);
    for (int ti = start; ti < ntiles; ti += F.nb) {
        const int tk = ti / ntn, tn = ti % ntn;
        f32x4 v[4];
#pragma unroll
        for (int it = 0; it < 4; ++it) v[it] = nx[it];
        if (ti + F.nb < ntiles) TJ_LOAD(ti + F.nb);
#pragma unroll
        for (int it = 0; it < 4; ++it) { LAS float* tp = tile + (kr + 32 * it) * 65 + c4; tp[0] = v[it][0]; tp[1] = v[it][1]; tp[2] = v[it][2]; tp[3] = v[it][3]; }
        lds_barrier();
        float e[16];
#pragma unroll
        for (int j = 0; j < 16; ++j) e[j] = tile[(k16 + j) * 65 + sn];
        u32x4 w0, w1; w0.x = cvt_pk_bf16(e[0], e[1]); w0.y = cvt_pk_bf16(e[2], e[3]); w0.z = cvt_pk_bf16(e[4], e[5]); w0.w = cvt_pk_bf16(e[6], e[7]);
        w1.x = cvt_pk_bf16(e[8], e[9]); w1.y = cvt_pk_bf16(e[10], e[11]); w1.z = cvt_pk_bf16(e[12], e[13]); w1.w = cvt_pk_bf16(e[14], e[15]);
        bf16_t* dp = J.dst + (size_t)(tn * 64 + sn) * J.ldd + tk * 128 + k16;
        *(u32x4*)dp = w0; *(u32x4*)(dp + 8) = w1;
        lds_barrier();
    }
#undef TJ_LOAD
}

__device__ __forceinline__ void p0_prologue(const Frame& F) {
    unsigned char* ws = F.ws;
    int rot = 0;
    for (int l = 0; l < DEPTH; ++l)
        for (int j = 0; j < 14; ++j) { const TJob J = make_job(F, l, j); transpose_job(F, J, rot); rot = (rot + ((J.Kpad / 128) * (J.N / 64)) % F.nb) % F.nb; }
    {
        LAS float* sv = (LAS float*)F.lds;
        LAS float* red = (LAS float*)(F.lds + 16384);
        for (int i = F.tid; i < 2 * D; i += NTHREADS) { const float x = (i < D) ? F.in[I_C][i] : F.in[I_CCTX][i - D]; sv[i] = x * sigmoidf_(x); }
        __syncthreads();
        const int cg = F.tid & 15, ks = F.tid >> 4;
        for (int u = F.bid; u < DEPTH * 192; u += F.nb) {
            const int l = u / 192, cb = (u % 192) * 64;
            const float* wp = F.in[I_ADAW] + (size_t)l * D * (6 * D) + cb + cg * 4;
            f32x4 a0 = zero4v(), a1 = a0;
#pragma unroll 4
            for (int k = ks; k < D; k += 32) { const f32x4 w = *(const f32x4*)(wp + (size_t)k * (6 * D)); a0 += w * sv[k]; a1 += w * sv[D + k]; }
            LAS float* rp = red + (ks * 16 + cg) * 8;
#pragma unroll
            for (int j = 0; j < 4; ++j) { rp[j] = a0[j]; rp[4 + j] = a1[j]; }
            __syncthreads();
            if (F.tid < 128) {
                const int g2 = F.tid >> 3, e = F.tid & 7; float s = 0.f;
#pragma unroll 8
                for (int q = 0; q < 32; ++q) s += red[(q * 16 + g2) * 8 + e];
                const int col = cb + g2 * 4 + (e & 3), sidx = e >> 2;
                ((float*)(ws + WS_MOD))[((size_t)l * 2 + sidx) * (6 * D) + col] = s + F.in[I_ADAB][(size_t)l * (6 * D) + col];
            }
            __syncthreads();
        }
    }
    {
        float* rt = (float*)(ws + WS_ROPE);
        for (int i = F.bid * NTHREADS + F.tid; i < SEQ * 32; i += F.nb * NTHREADS) {
            const int t = i >> 5, j = i & 31;
            const float inv = powf(10000.0f, -(float)(j & 15) / 16.0f);
            const float pos = (j < 16) ? (float)(t / GRIDW) : (float)(t % GRIDW);
            const float ang = pos * inv;
            rt[2 * i] = cosf(ang); rt[2 * i + 1] = sinf(ang);
        }
    }
    {
        float* lb = (float*)(ws + WS_LBIAS);
        for (int i = F.bid * NTHREADS + F.tid; i < DEPTH * 5 * AW; i += F.nb * NTHREADS) { const int l = i / (5 * AW), r = i % (5 * AW), grp = r / AW, c = r % AW;
            lb[i] = grp < 2 ? F.in[I_W0][((size_t)l * 2 + grp) * AW + c] : (grp < 4 ? F.in[I_A0][((size_t)l * 2 + grp - 2) * AW + c] : 0.f); }
        f32x4* X = (f32x4*)(ws + WS_X);
        const f32x4* x = (const f32x4*)F.in[I_X]; const f32x4* cx = (const f32x4*)F.in[I_CTX];
        const size_t n1 = (size_t)SEQ * D / 4, n2 = (size_t)CTXL * D / 4;
        for (size_t i = (size_t)F.bid * NTHREADS + F.tid; i < n1 + n2; i += (size_t)F.nb * NTHREADS) X[i] = (i < n1) ? x[i] : cx[i - n1];
        u32x4* z = (u32x4*)(ws + WS_LA); const size_t nz = (WS_KPE - WS_LA) / 16;
        for (size_t i = (size_t)F.bid * NTHREADS + F.tid; i < nz; i += (size_t)F.nb * NTHREADS) z[i] = __builtin_bit_cast(u32x4, zero4v());
    }
}

__device__ __forceinline__ void norm_phase(const Frame& F, int l, int which, const float* parts, int nparts) {
    float* X = (float*)(F.ws + WS_X); bf16_t* H = (bf16_t*)(F.ws + WS_H);
    const float* g = F.in[which ? I_NMLPG : I_NMIXG] + (size_t)l * D;
    const float* mod = (const float*)(F.ws + WS_MOD) + (size_t)l * 2 * 6 * D;
    f32x4 ga[8], sh[8];
    for (int c = F.bid; c < CTXL; c += F.nb) {
        LAS float* lp = (LAS float*)F.lds;
        float* xr = X + (size_t)(SEQ + c) * D;
        f32x4 v[8];
        if (F.wave == 0) {
#pragma unroll
            for (int i = 0; i < 8; ++i) v[i] = *(const f32x4*)(xr + i * 256 + F.lane * 4);
        } else {
            const f32x4 z = zero4v();
#pragma unroll
            for (int i = 0; i < 8; ++i) v[i] = z;
        }
        const float* pp = parts + (size_t)c * D + F.lane * 4;
        for (int s = F.wave; s < nparts; s += 16) {
            const int s1 = s + 8; const bool two = s1 < nparts;
            f32x4 t[2][8];
#pragma unroll
            for (int i = 0; i < 8; ++i) { t[0][i] = *(const f32x4*)(pp + (size_t)s * CTXL * D + i * 256); t[1][i] = two ? *(const f32x4*)(pp + (size_t)s1 * CTXL * D + i * 256) : zero4v(); }
#pragma unroll
            for (int i = 0; i < 8; ++i) v[i] += t[0][i] + t[1][i];
        }
#pragma unroll
        for (int i = 0; i < 8; ++i) *(LAS f32x4*)(lp + F.wave * D + i * 256 + F.lane * 4) = v[i];
        __syncthreads();
        if (F.wave == 0) {
            const float* m = mod + 6 * D + which * 3 * D;
#pragma unroll
            for (int i = 0; i < 8; ++i) { const int cc = i * 256 + F.lane * 4; ga[i] = *(const f32x4*)(g + cc) * (*(const f32x4*)(m + D + cc) + 1.0f); sh[i] = *(const f32x4*)(m + cc); }
            float ss = 0.f;
#pragma unroll
            for (int i = 0; i < 8; ++i) {
#pragma unroll
                for (int w = 1; w < 8; ++w) v[i] += *(const LAS f32x4*)(lp + w * D + i * 256 + F.lane * 4);
                ss += v[i][0] * v[i][0] + v[i][1] * v[i][1] + v[i][2] * v[i][2] + v[i][3] * v[i][3];
            }
            if (nparts > 0) {
#pragma unroll
                for (int i = 0; i < 8; ++i) *(f32x4*)(xr + i * 256 + F.lane * 4) = v[i];
            }
            ss = wave_sum(ss, F.lane);
            const float rstd = rsqrtf(ss * (1.0f / D) + RMS_EPS);
#pragma unroll
            for (int i = 0; i < 8; ++i) {
                const f32x4 h = (v[i] * rstd) * ga[i] + sh[i];
                u32x2 w; w.x = cvt_pk_bf16(h[0], h[1]); w.y = cvt_pk_bf16(h[2], h[3]);
                *(u32x2*)(H + (size_t)(SEQ + c) * D + i * 256 + F.lane * 4) = w;
            }
        }
        __syncthreads();
    }
#pragma unroll
    for (int i = 0; i < 8; ++i) { const int c = i * 256 + F.lane * 4; const float* m = mod + which * 3 * D;
        ga[i] = *(const f32x4*)(g + c) * (*(const f32x4*)(m + D + c) + 1.0f); sh[i] = *(const f32x4*)(m + c); }
    const int row0 = F.bid * 8 + F.wave, rstep = F.nb * 8;
    f32x4 nx[8];
    if (row0 < SEQ) {
#pragma unroll
        for (int i = 0; i < 8; ++i) nx[i] = *(const f32x4*)(X + (size_t)row0 * D + i * 256 + F.lane * 4);
    }
    for (int row = row0; row < SEQ; row += rstep) {
        float* xr = X + (size_t)row * D;
        f32x4 v[8]; float ss = 0.f;
#pragma unroll
        for (int i = 0; i < 8; ++i) v[i] = nx[i];
        if (row + rstep < SEQ) {
#pragma unroll
            for (int i = 0; i < 8; ++i) nx[i] = *(const f32x4*)(xr + (size_t)rstep * D + i * 256 + F.lane * 4);
        }
#pragma unroll
        for (int i = 0; i < 8; ++i) ss += v[i][0] * v[i][0] + v[i][1] * v[i][1] + v[i][2] * v[i][2] + v[i][3] * v[i][3];
        ss = wave_sum(ss, F.lane);
        const float rstd = rsqrtf(ss * (1.0f / D) + RMS_EPS);
#pragma unroll
        for (int i = 0; i < 8; ++i) {
            const f32x4 h = (v[i] * rstd) * ga[i] + sh[i];
            u32x2 w; w.x = cvt_pk_bf16(h[0], h[1]); w.y = cvt_pk_bf16(h[2], h[3]);
            *(u32x2*)(H + (size_t)row * D + i * 256 + F.lane * 4) = w;
        }
    }
}

__device__ __forceinline__ void final_norm_phase(const Frame& F) {
    const float* X = (const float*)(F.ws + WS_X); const float* g = F.in[I_FNG];
    const int frow0 = F.bid * 8 + F.wave, fstep = F.nb * 8;
    f32x4 nx[8];
    if (frow0 < SEQ) {
#pragma unroll
        for (int i = 0; i < 8; ++i) nx[i] = *(const f32x4*)(X + (size_t)frow0 * D + i * 256 + F.lane * 4);
    }
    for (int row = frow0; row < SEQ; row += fstep) {
        const float* xr = X + (size_t)row * D;
        f32x4 v[8]; float ss = 0.f;
#pragma unroll
        for (int i = 0; i < 8; ++i) v[i] = nx[i];
        if (row + fstep < SEQ) {
#pragma unroll
            for (int i = 0; i < 8; ++i) nx[i] = *(const f32x4*)(xr + (size_t)fstep * D + i * 256 + F.lane * 4);
        }
#pragma unroll
        for (int i = 0; i < 8; ++i) ss += v[i][0] * v[i][0] + v[i][1] * v[i][1] + v[i][2] * v[i][2] + v[i][3] * v[i][3];
        ss = wave_sum(ss, F.lane);
        const float rstd = rsqrtf(ss * (1.0f / D) + RMS_EPS);
#pragma unroll
        for (int i = 0; i < 8; ++i) { const int c = i * 256 + F.lane * 4; *(f32x4*)(F.out + (size_t)row * D + c) = (v[i] * rstd) * *(const f32x4*)(g + c); }
    }
}

__device__ __forceinline__ void prep1_phase(const Frame& F, int l) {
    unsigned char* ws = F.ws;
    const bf16_t* U = (const bf16_t*)(ws + WS_U);
    float* Rf = (float*)(ws + WS_RF); float* Kf = (float*)(ws + WS_KF); float* Vf = (float*)(ws + WS_VF);
    bf16_t* LA = (bf16_t*)(ws + WS_LA); bf16_t* QL = (bf16_t*)(ws + WS_QL); bf16_t* KVL = (bf16_t*)(ws + WS_KVL); bf16_t* KC = (bf16_t*)(ws + WS_KC);
    const float* conv = F.in[I_CONV] + (size_t)l * 3 * RWKV_COLS;
    const float* qg = F.in[I_QNG] + (size_t)l * QLORA; const float* kvg = F.in[I_KVNG] + (size_t)l * KVLORA;
    const float* rope = (const float*)(ws + WS_ROPE);
    const u32x4 zero4 = __builtin_bit_cast(u32x4, zero4v());
    LAS float* cw = (LAS float*)F.lds;
    __syncthreads();
    for (int i = F.tid; i < 3 * RWKV_COLS / 4; i += NTHREADS) *(LAS f32x4*)(cw + 4 * i) = *(const f32x4*)(conv + 4 * i);
    __syncthreads();
    for (int row = F.bid * 8 + F.wave; row < MROWS; row += F.nb * 8) {
        const bool lat = row < SEQ; const int rr = lat ? row : row - SEQ, slen = lat ? SEQ : CTXL;
        const bool hp = rr > 0, hn = rr < slen - 1;
        const bf16_t* uc = U + (size_t)row * IN_COLS;
        u32x4 wc_[8], wp_[8], wn_[8];
#pragma unroll
        for (int it = 0; it < 8; ++it) {
            const int gi = it * 64 + F.lane, col = (gi < RWKV_COLS / 8 ? gi : 0) * 8;
            wc_[it] = *(const u32x4*)(uc + col);
            wp_[it] = hp ? *(const u32x4*)(uc - IN_COLS + col) : zero4;
            wn_[it] = hn ? *(const u32x4*)(uc + IN_COLS + col) : zero4;
        }
        u32x4 xq_ = zero4, yk_ = zero4;
        if (F.lane < 56) xq_ = *(const u32x4*)(uc + MLA_OFF + F.lane * 8);
        if (F.lane < 16) yk_ = *(const u32x4*)(uc + MLA_OFF + QLORA + F.lane * 8);
        const bf16_t xv_ = uc[MLA_OFF + QLORA + KVLORA + F.lane];
        float cs_ = 1.f, sn_ = 0.f;
        if (lat) { const int ai = (F.lane < 32 ? 0 : 16) + (F.lane & 15); const float* rp = rope + ((size_t)row * 32 + ai) * 2; cs_ = rp[0]; sn_ = rp[1]; }
        asm volatile("" ::: "memory");
#pragma unroll
        for (int it = 0; it < 8; ++it) {
            const int gi = it * 64 + F.lane;
            if (gi < RWKV_COLS / 8) {
                const int col = gi * 8;
                float c[8], p[8], n[8], o[8]; unpack8(wc_[it], c); unpack8(wp_[it], p); unpack8(wn_[it], n);
                const f32x4 k0a = *(const LAS f32x4*)(cw + col), k0b = *(const LAS f32x4*)(cw + col + 4);
                const f32x4 k1a = *(const LAS f32x4*)(cw + RWKV_COLS + col), k1b = *(const LAS f32x4*)(cw + RWKV_COLS + col + 4);
                const f32x4 k2a = *(const LAS f32x4*)(cw + 2 * RWKV_COLS + col), k2b = *(const LAS f32x4*)(cw + 2 * RWKV_COLS + col + 4);
#pragma unroll
                for (int j = 0; j < 4; ++j) { o[j] = k0a[j] * p[j] + k1a[j] * c[j] + k2a[j] * n[j]; o[4 + j] = k0b[j] * p[4 + j] + k1b[j] * c[4 + j] + k2b[j] * n[4 + j]; }
                if (it < 6) {
                    float* dst = (it < 2 ? Rf : (it < 4 ? Kf : Vf)) + (size_t)row * AW + (it & 1) * 512 + F.lane * 8;
                    *(f32x4*)dst = (f32x4){o[0], o[1], o[2], o[3]}; *(f32x4*)(dst + 4) = (f32x4){o[4], o[5], o[6], o[7]};
                } else if (col < 3264) {
                    const int d = (col - 3072) >= 96 ? 1 : 0, cc = (col - 3072) - 96 * d;
#pragma unroll
                    for (int j = 0; j < 8; ++j) o[j] = tanhf(o[j]);
                    *(u32x4*)(LA + ((size_t)d * MROWS + row) * 256 + cc) = pack8(o);
                } else if (col < 3456) {
                    const int d = (col - 3264) >= 96 ? 1 : 0, cc = (col - 3264) - 96 * d;
                    *(u32x4*)(LA + ((size_t)(2 + d) * MROWS + row) * 256 + cc) = pack8(o);
                } else {
#pragma unroll
                    for (int j = 0; j < 8; ++j) o[j] = sigmoidf_(o[j]);
                    *(u32x4*)(LA + ((size_t)4 * MROWS + row) * 256 + (col - 3456)) = pack8(o);
                }
            }
        }
        {
            float x[8]; float ss = 0.f;
            if (F.lane < 56) { unpack8(xq_, x);
#pragma unroll
                for (int j = 0; j < 8; ++j) ss += x[j] * x[j]; }
            ss = wave_sum(ss, F.lane);
            const float rstd = rsqrtf(ss * (1.0f / QLORA) + RMS_EPS);
            if (F.lane < 56) {
#pragma unroll
                for (int j = 0; j < 8; ++j) x[j] = x[j] * rstd * qg[F.lane * 8 + j];
                *(u32x4*)(QL + (size_t)row * 512 + F.lane * 8) = pack8(x);
            }
            float y[8]; float s2 = 0.f;
            if (F.lane < 16) { unpack8(yk_, y);
#pragma unroll
                for (int j = 0; j < 8; ++j) s2 += y[j] * y[j]; }
            s2 = wave_sum(s2, F.lane);
            const float rstd2 = rsqrtf(s2 * (1.0f / KVLORA) + RMS_EPS);
            if (F.lane < 16) {
#pragma unroll
                for (int j = 0; j < 8; ++j) y[j] = y[j] * rstd2 * kvg[F.lane * 8 + j];
                *(u32x4*)(KVL + (size_t)row * 256 + F.lane * 8) = pack8(y);
            }
        }
        {
            const float xv = bf2f(xv_);
            const float pv = shx(xv, 16, F.lane);
            float o = xv;
            if (lat) o = ((F.lane & 16) == 0) ? (xv * cs_ - pv * sn_) : (pv * sn_ + xv * cs_);
            const bf16_t ob = f2bf(o);
#pragma unroll
            for (int hh = 0; hh < 8; ++hh) KC[(size_t)row * 1536 + hh * 192 + 128 + F.lane] = ob;
        }
    }
}

constexpr int SC_TC = 32;
constexpr int SC_STEP_FLOATS = 6 * 64;
constexpr int SC_BUF_BYTES = SC_TC * SC_STEP_FLOATS * 4;
constexpr int SC_CS_OFF = 2 * SC_BUF_BYTES;
constexpr int SC_Y_OFF = SC_CS_OFF + 2 * SC_TC * 2 * 4;

__device__ __forceinline__ float dpp_allsum16(float x) {
    x += __int_as_float(__builtin_amdgcn_update_dpp(0, __float_as_int(x), 0xB1, 0xF, 0xF, true));
    x += __int_as_float(__builtin_amdgcn_update_dpp(0, __float_as_int(x), 0x4E, 0xF, 0xF, true));
    x += __int_as_float(__builtin_amdgcn_update_dpp(0, __float_as_int(x), 0x141, 0xF, 0xF, true));
    x += __int_as_float(__builtin_amdgcn_update_dpp(0, __float_as_int(x), 0x140, 0xF, 0xF, true));
    return x;
}

__device__ __forceinline__ int scan_row(int dir, int s) {
    if (dir == 0) return s < CTXL ? SEQ + s : s - CTXL;
    return s < CTXL ? SEQ + (CTXL - 1) - s : (SEQ - 1) - (s - CTXL);
}

__device__ __forceinline__ void readout_phase(const Frame& F, int l) {
    unsigned char* ws = F.ws;
    const float* Rf = (const float*)(ws + WS_RF); const float* Kf = (const float*)(ws + WS_KF); const float* Vf = (const float*)(ws + WS_VF);
    const float* A0 = (const float*)(ws + WS_AD); const float* A1 = A0 + (size_t)MROWS * AW;
    const float* Y0 = (const float*)(ws + WS_Y); const float* Y1 = Y0 + (size_t)MROWS * AW;
    const float* G = (const float*)(ws + WS_G);
    bf16_t* YC = (bf16_t*)(ws + WS_YCAT);
    const float* lng = F.in[I_LNG] + (size_t)l * AW; const float* lnb = F.in[I_LNB] + (size_t)l * AW;
    const float* ka = F.in[I_KA] + (size_t)l * AW; const float* rk = F.in[I_RK] + (size_t)l * AW;
    for (int it = F.bid * 8 + F.wave; it < MROWS * 16; it += F.nb * 8) {
        const int row = it >> 4, head = it & 15, c = head * 64 + F.lane;
        const size_t o = (size_t)row * AW + c;
        const float y = Y0[o] + Y1[o];
        const float mu = wave_sum(y, F.lane) * (1.0f / 64.0f);
        const float dv = y - mu;
        const float var = wave_sum(dv * dv, F.lane) * (1.0f / 64.0f);
        const float yn = dv * rsqrtf(var + GN_EPS) * lng[c] + lnb[c];
        const float k = Kf[o], kac = ka[c];
        const float kmean = 0.5f * (k * (1.0f + (sigmoidf_(A0[o]) - 1.0f) * kac) + k * (1.0f + (sigmoidf_(A1[o]) - 1.0f) * kac));
        const float bsum = wave_sum(Rf[o] * kmean * rk[c], F.lane);
        const float outv = (yn + bsum * Vf[o]) * G[o];
        YC[(size_t)row * 3072 + c] = f2bf(outv);
    }
}

constexpr float NEG_BIG = -1.0e30f;
__device__ __forceinline__ float fexp2(float x) { return __builtin_amdgcn_exp2f(x); }
__device__ __forceinline__ bf16x8 tr_pair(const LAS unsigned char* p0, const LAS unsigned char* p1) {
    const bf16x4 a = __builtin_amdgcn_ds_read_tr16_b64_v4i16((LAS bf16x4*)p0), b = __builtin_amdgcn_ds_read_tr16_b64_v4i16((LAS bf16x4*)p1);
    return (bf16x8){a[0], a[1], a[2], a[3], b[0], b[1], b[2], b[3]};
}
template <int NKS> __device__ __forceinline__ void sm_update(f32x4 (&s)[NKS], float& m, float& l, float& alpha, int lane, float sc) {
    float mx = fmaxf(fmaxf(s[0][0], s[0][1]), fmaxf(s[0][2], s[0][3]));
#pragma unroll
    for (int k = 1; k < NKS; ++k) mx = fmaxf(fmaxf(mx, s[k][0]), fmaxf(fmaxf(s[k][1], s[k][2]), s[k][3]));
    mx = rows_max(mx);
    const float mn = fmaxf(m, mx * sc); alpha = fexp2(m - mn); m = mn;
    float sum = 0.f;
#pragma unroll
    for (int k = 0; k < NKS; ++k) {
#pragma unroll
        for (int j = 0; j < 4; ++j) { const float p = fexp2(__builtin_fmaf(s[k][j], sc, -mn)); s[k][j] = p; sum += p; } }
    l = l * alpha + sum;
}
__device__ __forceinline__ bf16x8 pack_p(const f32x4 a, const f32x4 b) {
    u32x4 w; w.x = cvt_pk_bf16(a[0], a[1]); w.y = cvt_pk_bf16(a[2], a[3]); w.z = cvt_pk_bf16(b[0], b[1]); w.w = cvt_pk_bf16(b[2], b[3]);
    return __builtin_bit_cast(bf16x8, w);
}

typedef float f32x16 __attribute__((ext_vector_type(16)));
constexpr int MA_KSTR = 400, MA_VSTR = 320, MA_KBUF = 64 * MA_KSTR, MA_VBUF = 64 * MA_VSTR;
constexpr int MA_K_OFF = 0, MA_V_OFF = 3 * MA_KBUF;
static_assert(MA_V_OFF + 3 * MA_VBUF <= LDS_BAR_OFF - 64, "MLA LDS map");
#define MFMA32(a, b, c) __builtin_amdgcn_mfma_f32_32x32x16_bf16(a, b, c, 0, 0, 0)
constexpr int RB_BLOCKS = 32;
constexpr int MLA_SPLIT = 66;
constexpr int RA_BTASKS = 6;

__device__ __forceinline__ void mla_unit(const Frame& F, int h, int q0, int key0, int ntiles, int mode, int su) {
    unsigned char* ws = F.ws;
    const bf16_t* Q = (const bf16_t*)(ws + WS_Q); const bf16_t* KC = (const bf16_t*)(ws + WS_KC); const bf16_t* VC = (const bf16_t*)(ws + WS_VC);
    const float* rope = (const float*)(ws + WS_ROPE);
    bf16_t* YC = (bf16_t*)(ws + WS_YCAT);
    const int ql = F.lane & 31, hh = F.lane >> 5, qr = q0 + F.wave * 32 + ql;
    constexpr float SC = 0.07216878364870322f * LOG2E;
    bf16x8 Qf[12];
    {
        const bf16_t* qp = Q + (size_t)qr * 1536 + h * QHD;
#pragma unroll
        for (int ks = 0; ks < 8; ++ks) { float x[8]; unpack8(*(const u32x4*)(qp + 16 * ks + 8 * hh), x);
#pragma unroll
            for (int j = 0; j < 8; ++j) x[j] *= SC;
            Qf[ks] = __builtin_bit_cast(bf16x8, pack8(x)); }
#pragma unroll
        for (int ks = 8; ks < 12; ++ks) {
            const int d0 = 16 * ks + 8 * hh;
            const u32x4 own = *(const u32x4*)(qp + d0);
            if (qr < SEQ) {
                const u32x4 par = *(const u32x4*)(qp + d0 + ((ks & 1) ? -16 : 16));
                float xo[8], xp[8], o[8]; unpack8(own, xo); unpack8(par, xp);
                const float* rp = rope + ((size_t)qr * 32 + ((ks - 8) >> 1) * 16 + 8 * hh) * 2;
#pragma unroll
                for (int j = 0; j < 8; ++j) { const float cs = rp[2 * j], sn = rp[2 * j + 1]; o[j] = SC * ((ks & 1) ? (xp[j] * sn + xo[j] * cs) : (xo[j] * cs - xp[j] * sn)); }
                Qf[ks] = __builtin_bit_cast(bf16x8, pack8(o));
            } else { float x[8]; unpack8(own, x);
#pragma unroll
                for (int j = 0; j < 8; ++j) x[j] *= SC;
                Qf[ks] = __builtin_bit_cast(bf16x8, pack8(x)); }
        }
    }
    f32x16 O[4];
#pragma unroll
    for (int dt = 0; dt < 4; ++dt) { const f32x4 z = zero4v();
#pragma unroll
        for (int r = 0; r < 16; ++r) O[dt][r] = z[r & 3]; }
    float m = 0.f, l = 0.f;
    float* stp = (float*)(ws + WS_MLAST) + ((size_t)(su * 8 + F.wave) * 66) * 64 + F.lane;
    if (mode == 2) { m = stp[0]; l = stp[64];
#pragma unroll
        for (int dt = 0; dt < 4; ++dt)
#pragma unroll
            for (int r = 0; r < 16; ++r) O[dt][r] = stp[(2 + dt * 16 + r) * 64]; }
    const int tfirst = (mode == 2) ? -1 : 0;
    unsigned ko[4], vo[3];
#pragma unroll
    for (int i = 0; i < 4; ++i) { const int sl = ((i < 3) ? (F.wave + 8 * i) : 24) * 64 + F.lane, key = sl / 25, part = sl - key * 25;
        ko[i] = (unsigned)((key0 + key) * 1536 + h * 192 + ((part < 24) ? part : 0) * 8) * 2u; }
#pragma unroll
    for (int i = 0; i < 3; ++i) { const int sl = ((i < 2) ? (F.wave + 8 * i) : (16 + (F.wave & 3))) * 64 + F.lane, key = sl / 20, part = sl - key * 20;
        vo[i] = (unsigned)((key0 + key) * 1024 + h * 128 + ((part < 16) ? part : 0) * 8) * 2u; }
    const __amdgpu_buffer_rsrc_t rK = __builtin_amdgcn_make_buffer_rsrc((void*)KC, 0, 0x7ffffff0, 0x00020000), rV = __builtin_amdgcn_make_buffer_rsrc((void*)VC, 0, 0x7ffffff0, 0x00020000);
#define MLA_DMA(t_, slot_) do { const int ks_ = (t_) * (64 * 1536 * 2), vs_ = (t_) * (64 * 1024 * 2); \
        LAS unsigned char* kb_ = F.lds + MA_K_OFF + (slot_) * MA_KBUF; LAS unsigned char* vb_ = F.lds + MA_V_OFF + (slot_) * MA_VBUF; \
        _Pragma("unroll") for (int i = 0; i < 3; ++i) __builtin_amdgcn_raw_ptr_buffer_load_lds(rK, (LAS void*)(kb_ + (F.wave + 8 * i) * 1024), 16, ko[i], ks_, 0, 0); \
        if (F.wave == 0) __builtin_amdgcn_raw_ptr_buffer_load_lds(rK, (LAS void*)(kb_ + 24 * 1024), 16, ko[3], ks_, 0, 0); \
        _Pragma("unroll") for (int i = 0; i < 2; ++i) __builtin_amdgcn_raw_ptr_buffer_load_lds(rV, (LAS void*)(vb_ + (F.wave + 8 * i) * 1024), 16, vo[i], vs_, 0, 0); \
        if (F.wave >= 4) __builtin_amdgcn_raw_ptr_buffer_load_lds(rV, (LAS void*)(vb_ + (16 + (F.wave & 3)) * 1024), 16, vo[2], vs_, 0, 0); } while (0)
    __syncthreads();
    MLA_DMA(0, 0); MLA_DMA(1, 1);
    asm volatile("s_waitcnt vmcnt(0)" ::: "memory");
    lds_barrier();
    const int krd = ql * MA_KSTR + 16 * hh;
    const int vrd = (4 * hh + ((F.lane & 15) >> 2)) * MA_VSTR + (((F.lane >> 4) & 1) * 16 + (F.lane & 3) * 4) * 2;
    f32x16 sA[2], sB[2];
    {   const LAS unsigned char* kb = F.lds + MA_K_OFF + krd;
#pragma unroll
        for (int kt = 0; kt < 2; ++kt) { { const float nm = -m;
#pragma unroll
            for (int r = 0; r < 16; ++r) sA[kt][r] = nm; }
#pragma unroll
            for (int ks = 0; ks < 12; ++ks) { const bf16x8 kf = *(const LAS bf16x8*)(kb + kt * 32 * MA_KSTR + ks * 32); sA[kt] = MFMA32(kf, Qf[ks], sA[kt]); } } }
    int c0 = 0, c1 = 1, c2 = 2;
    static_assert(((SEQ + CTXL) / 64) % 2 == 0, "tile loop is unrolled by two");
#define MLA_KOFF(i_) (((i_) / 12) * 32 * MA_KSTR + ((i_) % 12) * 32)
#define MLA_STEP(s, sn, t) do { \
        const int tl_ = ((t) + 2 < ntiles) ? (t) + 2 : ntiles - 1;                               \
        const int ks_ = tl_ * (64 * 1536 * 2), vs_ = tl_ * (64 * 1024 * 2); \
        LAS unsigned char* kd_ = F.lds + MA_K_OFF + c2 * MA_KBUF; LAS unsigned char* vd_ = F.lds + MA_V_OFF + c2 * MA_VBUF; \
        if (F.wave == 0) __builtin_amdgcn_raw_ptr_buffer_load_lds(rK, (LAS void*)(kd_ + 24 * 1024), 16, ko[3], ks_, 0, 0); \
        if (F.wave >= 4) __builtin_amdgcn_raw_ptr_buffer_load_lds(rV, (LAS void*)(vd_ + (16 + (F.wave & 3)) * 1024), 16, vo[2], vs_, 0, 0); \
        const LAS unsigned char* kb = F.lds + MA_K_OFF + c1 * MA_KBUF + krd; \
        const LAS unsigned char* vb = F.lds + MA_V_OFF + c0 * MA_VBUF + vrd; \
        bf16x8 kq[3]; kq[0] = *(const LAS bf16x8*)(kb + MLA_KOFF(0)); kq[1] = *(const LAS bf16x8*)(kb + MLA_KOFF(1)); \
        f32x16 nc; { const float nm = -m; _Pragma("unroll") for (int r = 0; r < 16; ++r) nc[r] = nm; }     \
        float mx = s[0][0], alpha = 1.f, delta = 0.f, sum = 0.f; bool resc = false; \
        u32x4 Pw[2][2]; \
        _Pragma("unroll") for (int i = 0; i < 24; ++i) { \
            if (i + 2 < 24) kq[(i + 2) % 3] = *(const LAS bf16x8*)(kb + MLA_KOFF(i + 2)); \
            sn[i / 12] = MFMA32(kq[i % 3], Qf[i % 12], (i % 12 == 0) ? nc : sn[i / 12]);                      \
            if (i < 3) __builtin_amdgcn_raw_ptr_buffer_load_lds(rK, (LAS void*)(kd_ + (F.wave + 8 * i) * 1024), 16, ko[i], ks_, 0, 0); \
            if (i == 3 || i == 5) __builtin_amdgcn_raw_ptr_buffer_load_lds(rV, (LAS void*)(vd_ + (F.wave + 8 * (i == 5)) * 1024), 16, vo[i == 5], vs_, 0, 0); \
            if (i < 4) { _Pragma("unroll") for (int r = 0; r < 8; ++r) mx = fmaxf(mx, s[i >> 1][8 * (i & 1) + r]); } \
            else if (i == 4) { const auto q2 = __builtin_amdgcn_permlane32_swap(__float_as_uint(mx), __float_as_uint(mx), false, false); mx = fmaxf(__uint_as_float(q2[0]), __uint_as_float(q2[1])); \
                  \
                resc = (__builtin_amdgcn_ballot_w64(mx > 8.0f) != 0ull) || ((t) == tfirst); \
                if (resc) { delta = ((t) == tfirst) ? mx : fmaxf(mx, 0.f); alpha = ((t) == tfirst) ? 1.f : fexp2(-delta); m += delta; l *= alpha; \
                    _Pragma("unroll") for (int kt = 0; kt < 2; ++kt) _Pragma("unroll") for (int r = 0; r < 16; ++r) s[kt][r] -= delta; } } \
            else if (i < 21) { const int j = i - 5, kt = j >> 3, r0 = 2 * (j & 7); \
                const float p0 = fexp2(s[kt][r0]), p1 = fexp2(s[kt][r0 + 1]); sum += p0 + p1; \
                Pw[kt][(j & 7) >> 2][j & 3] = cvt_pk_bf16(p0, p1); } \
            else if (i == 21) { l += sum; asm volatile("" : "+v"(l)); } \
            __builtin_amdgcn_sched_barrier(0); \
        } \
        if (resc) { _Pragma("unroll") for (int dt = 0; dt < 4; ++dt) O[dt] = O[dt] * alpha; \
            _Pragma("unroll") for (int kt = 0; kt < 2; ++kt) _Pragma("unroll") for (int r = 0; r < 16; ++r) sn[kt][r] -= delta; }         \
          \
        _Pragma("unroll") for (int kt = 0; kt < 2; ++kt) \
            _Pragma("unroll") for (int s2 = 0; s2 < 2; ++s2) \
                _Pragma("unroll") for (int dt = 0; dt < 4; ++dt) { const LAS unsigned char* vp = vb + (32 * kt + 16 * s2) * MA_VSTR + dt * 64; \
                    const bf16x8 vf = tr_pair(vp, vp + 8 * MA_VSTR); \
                    O[dt] = MFMA32(vf, __builtin_bit_cast(bf16x8, Pw[kt][s2]), O[dt]); } \
        asm volatile("s_waitcnt vmcnt(0)" ::: "memory");                                         \
        lds_barrier(); \
        { const int x = c0; c0 = c1; c1 = c2; c2 = x; } } while (0)
    for (int t = 0; t < ntiles; t += 2) { MLA_STEP(sA, sB, t); MLA_STEP(sB, sA, t + 1); }
#undef MLA_STEP
#undef MLA_KOFF
#undef MLA_DMA
    if (mode == 1) { stp[0] = m; stp[64] = l;
#pragma unroll
        for (int dt = 0; dt < 4; ++dt)
#pragma unroll
            for (int r = 0; r < 16; ++r) stp[(2 + dt * 16 + r) * 64] = O[dt][r];
    } else {
        float lt = l;
        { const auto q2 = __builtin_amdgcn_permlane32_swap(__float_as_uint(lt), __float_as_uint(lt), false, false); lt = __uint_as_float(q2[0]) + __uint_as_float(q2[1]); }
        const float inv = 1.0f / lt;
        bf16_t* op = YC + (size_t)qr * 3072 + 1024 + h * VDIM + 4 * hh;
#pragma unroll
        for (int dt = 0; dt < 4; ++dt)
#pragma unroll
            for (int rg = 0; rg < 4; ++rg) { u32x2 w; w.x = cvt_pk_bf16(O[dt][4 * rg] * inv, O[dt][4 * rg + 1] * inv); w.y = cvt_pk_bf16(O[dt][4 * rg + 2] * inv, O[dt][4 * rg + 3] * inv);
                *(u32x2*)(op + 32 * dt + 8 * rg) = w; }
    }
}

constexpr int NA_KSTR = 288, NA_VSTR = 288, NA_KBUF = 64 * NA_KSTR, NA_VBUF = 64 * NA_VSTR;
constexpr int NA_K_OFF = 0, NA_V_OFF = 3 * NA_KBUF, NA_RPB_OFF = NA_V_OFF + 3 * NA_VBUF;
static_assert(NA_RPB_OFF + 4096 <= LDS_BAR_OFF - 64, "NA LDS map");

__device__ __forceinline__ void na_unit(const Frame& F, int l, int gi, int hp) {
    unsigned char* ws = F.ws;
    const bf16_t* U = (const bf16_t*)(ws + WS_U);
    bf16_t* YC = (bf16_t*)(ws + WS_YCAT);
    const int qi = F.lane & 15, g = F.lane >> 4, g4 = F.wave & 3, hh = F.wave >> 2, h = hp * 2 + hh;
    const bool lat = gi < 128;
    const int r0 = lat ? min(max(gi - 4, 0), 120) : 0;
    const int np = lat ? 12 : 4;
    const int qr = (lat ? gi * 64 : SEQ + (gi - 128) * 64) + 16 * g4 + qi;
    constexpr float SC = 0.125f * LOG2E;
    bf16x8 Qf[2];
#pragma unroll
    for (int kk = 0; kk < 2; ++kk) Qf[kk] = *(const bf16x8*)(U + (size_t)qr * IN_COLS + NA_OFF + h * 64 + 32 * kk + 8 * g);
    f32x4 O[4];
#pragma unroll
    for (int dt = 0; dt < 4; ++dt) O[dt] = zero4v();
    float m = NEG_BIG, lsum = 0.f;
    unsigned ko[3], vo[3];
#pragma unroll
    for (int i = 0; i < 3; ++i) { const int sl = ((i < 2) ? (F.wave + 8 * i) : (16 + (F.wave & 1))) * 64 + F.lane, key = sl / 18, part = sl - key * 18;
        const unsigned e = (unsigned)(key * IN_COLS + NA_OFF + hp * 128 + ((part < 16) ? part : 0) * 8);
        ko[i] = (e + 1024u) * 2u; vo[i] = (e + 2048u) * 2u; }
    const __amdgpu_buffer_rsrc_t rU = __builtin_amdgcn_make_buffer_rsrc((void*)U, 0, 0x7ffffff0, 0x00020000);
#define NA_PIECE_ROW(p) ((lat && (p) < 8) ? (r0 + (p)) * 64 : SEQ + ((p) - (lat ? 8 : 0)) * 64)
#define NA_DMA(p_, slot_) do { const int so_ = NA_PIECE_ROW(p_) * (IN_COLS * 2); \
        LAS unsigned char* kb_ = F.lds + NA_K_OFF + (slot_) * NA_KBUF; LAS unsigned char* vb_ = F.lds + NA_V_OFF + (slot_) * NA_VBUF; \
        _Pragma("unroll") for (int i = 0; i < 2; ++i) { __builtin_amdgcn_raw_ptr_buffer_load_lds(rU, (LAS void*)(kb_ + (F.wave + 8 * i) * 1024), 16, ko[i], so_, 0, 0); \
            __builtin_amdgcn_raw_ptr_buffer_load_lds(rU, (LAS void*)(vb_ + (F.wave + 8 * i) * 1024), 16, vo[i], so_, 0, 0); } \
        if (F.wave < 2) { __builtin_amdgcn_raw_ptr_buffer_load_lds(rU, (LAS void*)(kb_ + (16 + F.wave) * 1024), 16, ko[2], so_, 0, 0); \
            __builtin_amdgcn_raw_ptr_buffer_load_lds(rU, (LAS void*)(vb_ + (16 + F.wave) * 1024), 16, vo[2], so_, 0, 0); } } while (0)
    __syncthreads();
    if (lat) { LAS float* rp = (LAS float*)(F.lds + NA_RPB_OFF); const float* src = F.in[I_RPB] + ((size_t)l * 16 + hp * 2) * 465;
        for (int i = F.tid; i < 930; i += NTHREADS) rp[i] = src[i] * LOG2E; }
    NA_DMA(0, 0); NA_DMA(1, 1);
    asm volatile("s_waitcnt vmcnt(0)" ::: "memory");
    lds_barrier();
    const int c0 = (g4 == 0) ? 0 : (g4 == 1 ? 8 : (g4 == 2 ? 24 : 32));
    const int qc = 16 * g4 + qi, cs_ = min(max(qc - 8, 0), 48);
    const int krd = qi * NA_KSTR + hh * 128 + 16 * g;
    const int vrd = (4 * g + (qi >> 2)) * NA_VSTR + hh * 128 + (qi & 3) * 8;
    const LAS float* rpb = (const LAS float*)(F.lds + NA_RPB_OFF) + hh * 465;
    int sc = 0, sn2 = 2;
    for (int p = 0; p < np; ++p) {
        if (p + 2 < np) NA_DMA(p + 2, sn2);
        const LAS unsigned char* kb = F.lds + NA_K_OFF + sc * NA_KBUF;
        const LAS unsigned char* vb = F.lds + NA_V_OFF + sc * NA_VBUF;
        const bool win = lat && p < 8;
        const int ntl = win ? 1 : 2;
        for (int tl = 0; tl < ntl; ++tl) {
            const int kbase = win ? c0 : tl * 32;
            f32x4 s[2];
#pragma unroll
            for (int ks = 0; ks < 2; ++ks) {
                s[ks] = zero4v();
#pragma unroll
                for (int kk = 0; kk < 2; ++kk) {
                    const bf16x8 kf = *(const LAS bf16x8*)(kb + krd + (kbase + ks * 16) * NA_KSTR + kk * 64);
                    s[ks] = __builtin_amdgcn_mfma_f32_16x16x32_bf16(kf, Qf[kk], s[ks], 0, 0, 0);
                }
            }
            if (win) {
                const int dr = (r0 + p) - gi + 7;
#pragma unroll
                for (int ks = 0; ks < 2; ++ks)
#pragma unroll
                    for (int j = 0; j < 4; ++j) {
                        const int cc = c0 + 16 * ks + 4 * g + j, rel = cc - cs_;
                        const bool valid = (rel >= 0) && (rel < 16);
                        const int bi = min(max(cc - qc + 15, 0), 30);
                        const float bias = rpb[dr * 31 + bi];
                        s[ks][j] = valid ? (s[ks][j] * SC + bias) : NEG_BIG;
                    }
            } else {
#pragma unroll
                for (int ks = 0; ks < 2; ++ks) s[ks] = s[ks] * SC;
            }
            float alpha; sm_update<2>(s, m, lsum, alpha, F.lane, 1.0f);
#pragma unroll
            for (int dt = 0; dt < 4; ++dt) O[dt] = O[dt] * alpha;
            const bf16x8 P = pack_p(s[0], s[1]);
#pragma unroll
            for (int dt = 0; dt < 4; ++dt) {
                const LAS unsigned char* vp = vb + vrd + kbase * NA_VSTR + dt * 32;
                const bf16x8 vf = tr_pair(vp, vp + 16 * NA_VSTR);
                O[dt] = __builtin_amdgcn_mfma_f32_16x16x32_bf16(vf, P, O[dt], 0, 0, 0);
            }
        }
        if (p + 2 < np) { if (F.wave < 2) asm volatile("s_waitcnt vmcnt(6)" ::: "memory"); else asm volatile("s_waitcnt vmcnt(4)" ::: "memory"); }
        else asm volatile("s_waitcnt vmcnt(0)" ::: "memory");
        lds_barrier();
        sc = (sc == 2) ? 0 : sc + 1; sn2 = (sn2 == 2) ? 0 : sn2 + 1;
    }
#undef NA_DMA
#undef NA_PIECE_ROW
    const float lt = rows_sum(lsum);
    const float inv = 1.0f / lt;
    bf16_t* op = YC + (size_t)qr * 3072 + 2048 + h * 64 + 4 * g;
#pragma unroll
    for (int dt = 0; dt < 4; ++dt) { const f32x4 o = O[dt] * inv; u32x2 w; w.x = cvt_pk_bf16(o[0], o[1]); w.y = cvt_pk_bf16(o[2], o[3]); *(u32x2*)(op + dt * 16) = w; }
}

__device__ __forceinline__ void attn_phase(const Frame& F, int l, int flags) {
    if (!(flags & 2)) {
        { const int u = F.bid; if (u < 256) { const bool rs = (u < RB_BLOCKS) && (F.nb == 256);
            mla_unit(F, u & 7, (u >> 3) * 256, rs ? 64 * MLA_SPLIT : 0, rs ? MROWS / 64 - MLA_SPLIT : MROWS / 64, rs ? 2 : 0, u); } }
        for (int v = F.nb - 1 - F.bid; v < 8; v += F.nb) mla_unit(F, v, SEQ, SEQ, CTXL / 64, 0, 0);
    }
    if (!(flags & 4)) {
        unsigned* q = (unsigned*)(F.ws + WS_CTL) + 8192 + l * 64;
        volatile LAS unsigned* slot = (volatile LAS unsigned*)(F.lds + LDS_BAR_OFF - 64);
        for (;;) {
            __syncthreads();
            if (F.tid == 0) *slot = __hip_atomic_fetch_add(q, 1u, __ATOMIC_RELAXED, __HIP_MEMORY_SCOPE_AGENT);
            __syncthreads();
            const int u = (int)*slot;
            if (u >= 1056) break;
            na_unit(F, l, u >> 3, u & 7);
        }
    }
}

constexpr int CH_NCH = MROWS / 64;
constexpr int CH_NTASK = 32 * CH_NCH;
constexpr int CS = 144;
constexpr int CF = 68;
constexpr int CIMG = 64 * CS;
constexpr int O_KT = 0, O_RT = CIMG, O_BH = 2 * CIMG, O_KH = 3 * CIMG, O_V = 4 * CIMG, O_BB = 5 * CIMG  , O_KB = 6 * CIMG  ,
              O_AAK = 7 * CIMG  , O_ARB = 8 * CIMG, O_ARK = 9 * CIMG, O_T = 10 * CIMG, O_AF = 11 * CIMG, O_TF = O_AF + 64 * CF * 4, O_TOT = O_TF + 64 * CF * 4,
              O_GL = O_TOT + 8 * 64 * 4, O_CHEND = O_GL + 256;
static_assert(O_CHEND <= LDS_BAR_OFF, "chunk LDS map");

__device__ __forceinline__ bf16x8 ch_rowread(const LAS unsigned char* img, int tile, int ks, int qi, int g) {
    return *(const LAS bf16x8*)(img + (16 * tile + qi) * CS + (32 * ks + 8 * g) * 2);
}
__device__ __forceinline__ bf16x8 ch_trread(const LAS unsigned char* img, int tile, int ks, int qi, int g) {
    const LAS unsigned char* p = img + (32 * ks + 8 * g + (qi >> 2)) * CS + (16 * tile + 4 * (qi & 3)) * 2;
    return tr_pair(p, p + 4 * CS);
}
__device__ __forceinline__ void ch_store_bf16(LAS unsigned char* img, int tr, int tc, int qi, int g, const f32x4 v) {
#pragma unroll
    for (int jj = 0; jj < 4; ++jj) *(LAS bf16_t*)(img + (16 * tr + 4 * g + jj) * CS + (16 * tc + qi) * 2) = f2bf(v[jj]);
}
#define MFMA_BF(a, b, c) __builtin_amdgcn_mfma_f32_16x16x32_bf16(a, b, c, 0, 0, 0)
#define MFMA_F32(a, b, c) __builtin_amdgcn_mfma_f32_16x16x4f32(a, b, c, 0, 0, 0)

__device__ __forceinline__ void rwkvA_phase(const Frame& F, int l) {
    unsigned char* ws = F.ws;
    const float* Rf = (const float*)(ws + WS_RF); const float* Kf = (const float*)(ws + WS_KF); const float* Vf = (const float*)(ws + WS_VF);
    float* MN = (float*)(ws + WS_MN); bf16_t* RY = (bf16_t*)(ws + WS_RY);
    const int qi = F.lane & 15, g = F.lane >> 4, tr = F.wave >> 1, tcb = (F.wave & 1) * 2;
    LAS unsigned char* L = F.lds;
    LAS float* Af = (LAS float*)(L + O_AF); LAS float* Tf = (LAS float*)(L + O_TF); LAS float* tot = (LAS float*)(L + O_TOT); LAS float* gL = (LAS float*)(L + O_GL);
    float pk_[8], pv_[8], pr_[8], pza_[8], pzw_[8];
#define RA_LOAD(task_) do { const int hd_ = (task_) / CH_NCH, c_ = (task_) - hd_ * CH_NCH, dir_ = hd_ & 1; \
        const size_t o0_ = (size_t)scan_row(dir_, c_ * 64 + F.wave * 8) * AW + (hd_ >> 1) * 64 + F.lane; const int ds_ = dir_ ? -AW : AW;        \
        const float* kp_ = Kf + o0_; const float* vp_ = Vf + o0_; const float* rp_ = Rf + o0_; \
        const float* zw_ = (const float*)(ws + WS_WD) + (size_t)dir_ * MROWS * AW + o0_; const float* za_ = (const float*)(ws + WS_AD) + (size_t)dir_ * MROWS * AW + o0_; \
        _Pragma("unroll") for (int e = 0; e < 8; ++e) { pk_[e] = kp_[e * ds_]; pv_[e] = vp_[e * ds_]; pr_[e] = rp_[e * ds_]; pza_[e] = za_[e * ds_]; pzw_[e] = zw_[e * ds_]; } } while (0)
    constexpr int RA_NONB = 256 - RB_BLOCKS, RA_NT0 = CH_NTASK - RB_BLOCKS * RA_BTASKS;
    static_assert(RA_NT0 % RA_NONB == 0, "chunk task split");
    const bool split = (F.nb == 256);
    int t0 = F.bid, tstride = F.nb, tend = CH_NTASK;
    if (split) { if (F.bid < RB_BLOCKS) { t0 = RA_NT0 + F.bid; tstride = RB_BLOCKS; } else { t0 = F.bid - RB_BLOCKS; tstride = RA_NONB; tend = RA_NT0; } }
    if (split && F.bid < RB_BLOCKS) { mla_unit(F, F.bid & 7, (F.bid >> 3) * 256, 0, MLA_SPLIT, 1, F.bid); __syncthreads(); }
    if (t0 < tend) RA_LOAD(t0);
    for (int task = t0; task < tend; task += tstride) {
        const f32x4 z4 = zero4v();
        const int hd = task / CH_NCH, c = task - hd * CH_NCH, head = hd >> 1, dir = hd & 1;
        const int ch = head * 64 + F.lane;
        const float kkc = F.in[I_KK][(size_t)l * AW + ch], kac = F.in[I_KA][(size_t)l * AW + ch];
        {
            float kk_[8], b_[8], kd_[8], r_[8], lw_[8], cl_[8];
            float run = 0.f;
#pragma unroll
            for (int e = 0; e < 8; ++e) {
                const int i = F.wave * 8 + e;
                const float k = pk_[e], a = sigmoidf_(pza_[e]);
                lw_[e] = -0.6065306597126334f * sigmoidf_(pzw_[e]);
                r_[e] = pr_[e];
                const float kkr = k * kkc;
                const float nrm = sqrtf(wave_sum(kkr * kkr, F.lane));
                kk_[e] = kkr * __builtin_amdgcn_rcpf(fmaxf(nrm, 1e-12f));
                b_[e] = kk_[e] * a;
                kd_[e] = k * (1.0f + (a - 1.0f) * kac);
                run += lw_[e]; cl_[e] = run;
                *(LAS bf16_t*)(L + O_V + i * CS + F.lane * 2) = f2bf(pv_[e]);
            }
            if (task + tstride < tend) RA_LOAD(task + tstride);
            tot[F.wave * 64 + F.lane] = run;
            lds_barrier();
            float off = 0.f, all = 0.f;
#pragma unroll
            for (int w = 0; w < 8; ++w) { const float t = tot[w * 64 + F.lane]; all += t; off += (w < F.wave) ? t : 0.f; }
            if (F.wave == 0) gL[F.lane] = __expf(all);
#pragma unroll
            for (int e = 0; e < 8; ++e) {
                const int i = F.wave * 8 + e;
                const float cum = off + cl_[e], cumm = cum - lw_[e];
                const float ec = __expf(cum), em = __expf(cumm), ei = __expf(-cum), eh = __expf(all - cum);
                const int o = i * CS + F.lane * 2;
                *(LAS bf16_t*)(L + O_KT + o) = f2bf(kk_[e] * em);
                *(LAS bf16_t*)(L + O_RT + o) = f2bf(r_[e] * ec);
                *(LAS bf16_t*)(L + O_BB + o) = f2bf(b_[e] * ei);
                *(LAS bf16_t*)(L + O_KB + o) = f2bf(kd_[e] * ei);
                *(LAS bf16_t*)(L + O_BH + o) = f2bf(b_[e] * eh);
                *(LAS bf16_t*)(L + O_KH + o) = f2bf(kd_[e] * eh);
            }
        }
        lds_barrier();
        {
            f32x4 ab[2] = {z4, z4}, ak[2] = {z4, z4}, rb[2] = {z4, z4}, rk[2] = {z4, z4};
#pragma unroll
            for (int ks = 0; ks < 2; ++ks) {
                const bf16x8 aK = ch_rowread(L + O_KT, tr, ks, qi, g), aR = ch_rowread(L + O_RT, tr, ks, qi, g);
#pragma unroll
                for (int t = 0; t < 2; ++t) {
                    const bf16x8 bB = ch_rowread(L + O_BB, tcb + t, ks, qi, g), bK = ch_rowread(L + O_KB, tcb + t, ks, qi, g);
                    ab[t] = MFMA_BF(aK, bB, ab[t]); ak[t] = MFMA_BF(aK, bK, ak[t]); rb[t] = MFMA_BF(aR, bB, rb[t]); rk[t] = MFMA_BF(aR, bK, rk[t]);
                }
            }
#pragma unroll
            for (int t = 0; t < 2; ++t) {
                const int col = 16 * (tcb + t) + qi;
#pragma unroll
                for (int jj = 0; jj < 4; ++jj) {
                    const int row = 16 * tr + 4 * g + jj;
                    const bool lo = col < row, le = col <= row;
                    Af[row * CF + col] = lo ? ab[t][jj] : 0.f;
                    ak[t][jj] = lo ? ak[t][jj] : 0.f; rb[t][jj] = le ? rb[t][jj] : 0.f; rk[t][jj] = le ? rk[t][jj] : 0.f;
                }
                ch_store_bf16(L + O_AAK, tr, tcb + t, qi, g, ak[t]); ch_store_bf16(L + O_ARB, tr, tcb + t, qi, g, rb[t]); ch_store_bf16(L + O_ARK, tr, tcb + t, qi, g, rk[t]);
            }
        }
        lds_barrier();
        if (F.wave == 0) {
            float t[16];
#pragma unroll
            for (int i = 0; i < 16; ++i) {
                float acc = (i == qi) ? 1.f : 0.f;
                f32x4 ar[4];
#pragma unroll
                for (int q = 0; q < (i + 3) / 4; ++q) ar[q] = *(const LAS f32x4*)(Af + (16 * g + i) * CF + 16 * g + 4 * q);
#pragma unroll
                for (int j = 0; j < i; ++j) acc -= ar[j >> 2][j & 3] * t[j];
                t[i] = acc;
            }
#pragma unroll
            for (int i = 0; i < 16; ++i) Tf[(16 * g + i) * CF + 16 * g + qi] = t[i];
        }
        lds_barrier();
#pragma unroll 1
        for (int d = 1; d < 4; ++d) {
            if (F.wave < 4 - d) {
                const int bp = F.wave, b = bp + d;
                f32x4 X = z4;
                for (int bb = bp; bb < b; ++bb) {
#pragma unroll
                    for (int s = 0; s < 4; ++s) X = MFMA_F32(Af[(16 * b + qi) * CF + 16 * bb + 4 * s + g], Tf[(16 * bb + 4 * s + g) * CF + 16 * bp + qi], X);
                }
                f32x4 R = z4;
#pragma unroll
                for (int s = 0; s < 4; ++s) R = MFMA_F32(Tf[(16 * b + qi) * CF + 16 * b + 4 * g + s], X[s], R);
#pragma unroll
                for (int jj = 0; jj < 4; ++jj) Tf[(16 * b + 4 * g + jj) * CF + 16 * bp + qi] = -R[jj];
            }
            lds_barrier();
        }
        for (int idx = F.tid; idx < 4096; idx += NTHREADS) { const int row = idx >> 6, col = idx & 63;
            *(LAS bf16_t*)(L + O_T + row * CS + col * 2) = f2bf(((col >> 4) > (row >> 4)) ? 0.f : Tf[row * CF + col]); }
        lds_barrier();
        {
            f32x4 av[2] = {z4, z4}, p[2] = {z4, z4};
#pragma unroll
            for (int ks = 0; ks < 2; ++ks) {
                const bf16x8 aA = ch_rowread(L + O_AAK, tr, ks, qi, g), aT = ch_rowread(L + O_T, tr, ks, qi, g);
#pragma unroll
                for (int t = 0; t < 2; ++t) { av[t] = MFMA_BF(aA, ch_trread(L + O_V, tcb + t, ks, qi, g), av[t]); p[t] = MFMA_BF(aT, ch_trread(L + O_KT, tcb + t, ks, qi, g), p[t]); }
            }
#pragma unroll
            for (int t = 0; t < 2; ++t) { ch_store_bf16(L + O_BB, tr, tcb + t, qi, g, av[t]); ch_store_bf16(L + O_KB, tr, tcb + t, qi, g, p[t]); }
        }
        lds_barrier();
        {
            f32x4 q[2] = {z4, z4};
#pragma unroll
            for (int ks = 0; ks < 2; ++ks) {
                const bf16x8 aT = ch_rowread(L + O_T, tr, ks, qi, g);
#pragma unroll
                for (int t = 0; t < 2; ++t) q[t] = MFMA_BF(aT, ch_trread(L + O_BB, tcb + t, ks, qi, g), q[t]);
            }
#pragma unroll
            for (int t = 0; t < 2; ++t) ch_store_bf16(L + O_AAK, tr, tcb + t, qi, g, q[t]);
        }
        lds_barrier();
        {
            f32x4 m[2] = {z4, z4}, n1[2] = {z4, z4}, n2[2] = {z4, z4}, ry[2] = {z4, z4}, y1[2] = {z4, z4}, y2[2] = {z4, z4};
#pragma unroll
            for (int ks = 0; ks < 2; ++ks) {
                const bf16x8 aPt = ch_trread(L + O_KB, tr, ks, qi, g), aVt = ch_trread(L + O_V, tr, ks, qi, g), aQt = ch_trread(L + O_AAK, tr, ks, qi, g);
                const bf16x8 aRb = ch_rowread(L + O_ARB, tr, ks, qi, g), aRk = ch_rowread(L + O_ARK, tr, ks, qi, g);
#pragma unroll
                for (int t = 0; t < 2; ++t) {
                    const bf16x8 bBh = ch_trread(L + O_BH, tcb + t, ks, qi, g), bKh = ch_trread(L + O_KH, tcb + t, ks, qi, g);
                    const bf16x8 bP = ch_trread(L + O_KB, tcb + t, ks, qi, g), bV = ch_trread(L + O_V, tcb + t, ks, qi, g), bQ = ch_trread(L + O_AAK, tcb + t, ks, qi, g);
                    m[t] = MFMA_BF(aPt, bBh, m[t]); n1[t] = MFMA_BF(aVt, bKh, n1[t]); n2[t] = MFMA_BF(aQt, bBh, n2[t]);
                    ry[t] = MFMA_BF(aRb, bP, ry[t]); y1[t] = MFMA_BF(aRk, bV, y1[t]); y2[t] = MFMA_BF(aRb, bQ, y2[t]);
                }
            }
            const int lo = (16 * tr + 4 * g) * 64 + 16 * tcb + qi;
            float* Np = MN + (size_t)task * 2 * 4096 + 4096 + lo;
            bf16_t* MTh = (bf16_t*)(MN + (size_t)task * 2 * 4096); bf16_t* MTl = MTh + 4096;
            bf16_t* Rp = RY + (size_t)task * 4096 + lo;
            const LAS bf16_t* Rt = (const LAS bf16_t*)(L + O_RT + (16 * tr + 4 * g) * CS + (16 * tcb + qi) * 2);
            const int dstep = (dir == 0) ? AW : -AW;
            float* Yp = (float*)(ws + WS_Y) + (size_t)dir * MROWS * AW + (size_t)scan_row(dir, c * 64 + 16 * tr + 4 * g) * AW + head * 64 + 16 * tcb + qi;
#pragma unroll
            for (int t = 0; t < 2; ++t) {
#pragma unroll
                for (int jj = 0; jj < 4; ++jj) {
                    const bool dg = (16 * tr + 4 * g + jj) == (16 * (tcb + t) + qi);
                    m[t][jj] = (dg ? gL[16 * (tcb + t) + qi] : 0.f) - m[t][jj];
                    Np[jj * 64 + t * 16] = n1[t][jj] - n2[t][jj];
                    Rp[jj * 64 + t * 16] = f2bf(bf2f(Rt[jj * (CS / 2) + t * 16]) - ry[t][jj]);
                    Yp[jj * dstep + t * 16] = y1[t][jj] - y2[t][jj];
                }
                float hi_[4];
#pragma unroll
                for (int jj = 0; jj < 4; ++jj) hi_[jj] = bf2f(f2bf(m[t][jj]));
                u32x2 wh, wl; wh.x = cvt_pk_bf16(hi_[0], hi_[1]); wh.y = cvt_pk_bf16(hi_[2], hi_[3]);
                wl.x = cvt_pk_bf16(m[t][0] - hi_[0], m[t][1] - hi_[1]); wl.y = cvt_pk_bf16(m[t][2] - hi_[2], m[t][3] - hi_[3]);
                const int mo_ = (16 * (tcb + t) + qi) * 64 + 32 * (tr >> 1) + 8 * g + 4 * (tr & 1);
                *(u32x2*)(MTh + mo_) = wh; *(u32x2*)(MTl + mo_) = wl;
            }
        }
        lds_barrier();
    }
}

#undef RA_LOAD
constexpr int RB_SLOT = 32768;
__device__ __forceinline__ void rwkvB_phase(const Frame& F) {
    if (F.bid >= RB_BLOCKS) return;
    unsigned char* ws = F.ws;
    bf16_t* SC = (bf16_t*)(ws + WS_SC);
    const int qi = F.lane & 15, g = F.lane >> 4, hd = F.bid, vt = F.wave & 3;
    const bool loader = F.wave >= 4;
    const __amdgpu_buffer_rsrc_t rM = __builtin_amdgcn_make_buffer_rsrc((void*)(ws + WS_MN), 0, 0x7ffffff0, 0x00020000);
    const unsigned lo_ = (unsigned)(F.lane * 16);
#define RB_DMA(c_) do { const int so_ = (hd * CH_NCH + (c_)) * RB_SLOT; LAS unsigned char* sb_ = F.lds + ((c_) & 3) * RB_SLOT; \
        _Pragma("unroll") for (int i = 0; i < 8; ++i) __builtin_amdgcn_raw_ptr_buffer_load_lds(rM, (LAS void*)(sb_ + (vt + 4 * i) * 1024), 16, lo_ + (unsigned)((vt + 4 * i) * 1024), so_, 0, 0); } while (0)
    __syncthreads();
    if (loader) { RB_DMA(0); RB_DMA(1); RB_DMA(2); asm volatile("s_waitcnt vmcnt(16)" ::: "memory"); }
    lds_barrier();
    f32x4 T[4];
#pragma unroll
    for (int kt = 0; kt < 4; ++kt) T[kt] = zero4v();
    for (int c = 0; c < CH_NCH; ++c) {
        if (loader) {
            if (c + 3 < CH_NCH) { RB_DMA(c + 3); asm volatile("s_waitcnt vmcnt(16)" ::: "memory"); }
            else asm volatile("s_waitcnt vmcnt(0)" ::: "memory");
        } else {
            const LAS unsigned char* sb = F.lds + (c & 3) * RB_SLOT;
            bf16_t* Sg = SC + (size_t)(hd * CH_NCH + c) * 4096 + (16 * vt + qi) * 64 + 4 * g;
            bf16x8 bh[2], bl[2];
#pragma unroll
            for (int ks = 0; ks < 2; ++ks) {
                u32x4 wh, wl;
#pragma unroll
                for (int h = 0; h < 2; ++h) {
                    const f32x4 x = T[2 * ks + h];
                    float xh[4];
#pragma unroll
                    for (int j = 0; j < 4; ++j) xh[j] = bf2f(f2bf(x[j]));
                    const unsigned h0 = cvt_pk_bf16(xh[0], xh[1]), h1 = cvt_pk_bf16(xh[2], xh[3]);
                    const unsigned l0 = cvt_pk_bf16(x[0] - xh[0], x[1] - xh[1]), l1 = cvt_pk_bf16(x[2] - xh[2], x[3] - xh[3]);
                    if (h == 0) { wh.x = h0; wh.y = h1; wl.x = l0; wl.y = l1; } else { wh.z = h0; wh.w = h1; wl.z = l0; wl.w = l1; }
                    u32x2 sv; sv.x = h0; sv.y = h1; *(u32x2*)(Sg + 16 * (2 * ks + h)) = sv;
                }
                bh[ks] = __builtin_bit_cast(bf16x8, wh); bl[ks] = __builtin_bit_cast(bf16x8, wl);
            }
#pragma unroll
            for (int kt = 0; kt < 4; ++kt) {
                f32x4 acc = *(const LAS f32x4*)(sb + 16384 + ((16 * vt + qi) * 64 + 16 * kt + 4 * g) * 4);
#pragma unroll
                for (int ks = 0; ks < 2; ++ks) {
                    const bf16x8 ah = *(const LAS bf16x8*)(sb + ((16 * kt + qi) * 64 + 32 * ks + 8 * g) * 2);
                    const bf16x8 al = *(const LAS bf16x8*)(sb + 8192 + ((16 * kt + qi) * 64 + 32 * ks + 8 * g) * 2);
                    acc = MFMA_BF(ah, bh[ks], acc); acc = MFMA_BF(ah, bl[ks], acc); acc = MFMA_BF(al, bh[ks], acc);
                }
                T[kt] = acc;
            }
        }
        lds_barrier();
    }
#undef RB_DMA
}

__device__ __forceinline__ void rwkvC_readout_phase(const Frame& F, int l) {
    unsigned char* ws = F.ws;
    const bf16_t* RY = (const bf16_t*)(ws + WS_RY); const bf16_t* SC = (const bf16_t*)(ws + WS_SC);
    const float* Rf = (const float*)(ws + WS_RF); const float* Kf = (const float*)(ws + WS_KF); const float* Vf = (const float*)(ws + WS_VF);
    const float* Z0 = (const float*)(ws + WS_AD); const float* Z1 = Z0 + (size_t)MROWS * AW;
    const float* Y0 = (const float*)(ws + WS_Y); const float* Y1 = Y0 + (size_t)MROWS * AW;
    const float* G = (const float*)(ws + WS_G);
    bf16_t* YC = (bf16_t*)(ws + WS_YCAT);
    const int qi = F.lane & 15, g = F.lane >> 4;
    for (int qtask = F.bid * 8 + F.wave; qtask < CH_NCH * 16 * 4; qtask += F.nb * 8) {
        const int task = qtask >> 2, tr = qtask & 3;
        const int rb = task >> 4, head = task & 15, R0 = rb * 64;
        const int cf = (R0 >= SEQ) ? (R0 - SEQ) / 64 : (R0 + CTXL) / 64, cb = (MROWS - 64 - R0) / 64;
        const int tf = (head * 2) * CH_NCH + cf, tb = (head * 2 + 1) * CH_NCH + cb;
        f32x4 y[1][4];
        {
            bf16x8 bS[4][2];
#pragma unroll
            for (int tc = 0; tc < 4; ++tc)
#pragma unroll
                for (int ks = 0; ks < 2; ++ks) bS[tc][ks] = *(const bf16x8*)(SC + (size_t)tf * 4096 + (16 * tc + qi) * 64 + 32 * ks + 8 * g);
            {
                const bf16_t* ap = RY + (size_t)tf * 4096 + (16 * tr + qi) * 64 + 8 * g;
                const bf16x8 a0 = *(const bf16x8*)ap, a1 = *(const bf16x8*)(ap + 32);
#pragma unroll
                for (int tc = 0; tc < 4; ++tc) { f32x4 acc = zero4v(); acc = MFMA_BF(a0, bS[tc][0], acc); y[0][tc] = MFMA_BF(a1, bS[tc][1], acc); }
            }
#pragma unroll
            for (int tc = 0; tc < 4; ++tc)
#pragma unroll
                for (int ks = 0; ks < 2; ++ks) bS[tc][ks] = *(const bf16x8*)(SC + (size_t)tb * 4096 + (16 * tc + qi) * 64 + 32 * ks + 8 * g);
            {
                const bf16_t* ap = RY + (size_t)tb * 4096 + (63 - (16 * tr + qi)) * 64 + 8 * g;
                const bf16x8 a0 = *(const bf16x8*)ap, a1 = *(const bf16x8*)(ap + 32);
#pragma unroll
                for (int tc = 0; tc < 4; ++tc) { f32x4 acc = y[0][tc]; acc = MFMA_BF(a0, bS[tc][0], acc); y[0][tc] = MFMA_BF(a1, bS[tc][1], acc); }
            }
        }
        const float* lng = F.in[I_LNG] + (size_t)l * AW + head * 64; const float* lnb = F.in[I_LNB] + (size_t)l * AW + head * 64;
        const float* ka = F.in[I_KA] + (size_t)l * AW + head * 64; const float* rk = F.in[I_RK] + (size_t)l * AW + head * 64;
        float lg[4], lb[4], kav[4], rkv[4];
#pragma unroll
        for (int tc = 0; tc < 4; ++tc) { lg[tc] = lng[16 * tc + qi]; lb[tc] = lnb[16 * tc + qi]; kav[tc] = ka[16 * tc + qi]; rkv[tc] = rk[16 * tc + qi]; }
        {
            float a_y0[4][4], a_y1[4][4], a_k[4][4], a_z0[4][4], a_z1[4][4], a_r[4][4], a_v[4][4], a_g[4][4];
#pragma unroll
            for (int jj = 0; jj < 4; ++jj) {
                const size_t o = (size_t)(R0 + 16 * tr + 4 * g + jj) * AW + head * 64 + qi;
#pragma unroll
                for (int tc = 0; tc < 4; ++tc) { a_y0[jj][tc] = Y0[o + 16 * tc]; a_y1[jj][tc] = Y1[o + 16 * tc]; a_k[jj][tc] = Kf[o + 16 * tc]; a_z0[jj][tc] = Z0[o + 16 * tc];
                    a_z1[jj][tc] = Z1[o + 16 * tc]; a_r[jj][tc] = Rf[o + 16 * tc]; a_v[jj][tc] = Vf[o + 16 * tc]; a_g[jj][tc] = G[o + 16 * tc]; }
            }
            asm volatile("" ::: "memory");
#pragma unroll
            for (int jj = 0; jj < 4; ++jj) {
                const int row = R0 + 16 * tr + 4 * g + jj;
                float yv[4], s1 = 0.f, bs = 0.f;
#pragma unroll
                for (int tc = 0; tc < 4; ++tc) {
                    yv[tc] = y[0][tc][jj] + a_y0[jj][tc] + a_y1[jj][tc]; s1 += yv[tc];
                    const float kmean = a_k[jj][tc] * (1.0f + (0.5f * (sigmoidf_(a_z0[jj][tc]) + sigmoidf_(a_z1[jj][tc])) - 1.0f) * kav[tc]);
                    bs += a_r[jj][tc] * kmean * rkv[tc];
                }
                s1 = dpp_allsum16(s1); bs = dpp_allsum16(bs);
                const float mu = s1 * (1.0f / 64.0f);
                float s2 = 0.f;
#pragma unroll
                for (int tc = 0; tc < 4; ++tc) { yv[tc] -= mu; s2 += yv[tc] * yv[tc]; }
                s2 = dpp_allsum16(s2);
                const float rstd = rsqrtf(s2 * (1.0f / 64.0f) + GN_EPS);
#pragma unroll
                for (int tc = 0; tc < 4; ++tc) {
                    const float outv = (yv[tc] * rstd * lg[tc] + lb[tc] + bs * a_v[jj][tc]) * a_g[jj][tc];
                    YC[(size_t)row * 3072 + head * 64 + 16 * tc + qi] = f2bf(outv);
                }
            }
        }
    }
}


#ifndef PROBE_PHASE
#define PROBE_PHASE -1
#endif
#define REP(k) for (int rep_ = 0; rep_ < ((PROBE_PHASE == (k)) ? 2 : 1); ++rep_)
constexpr int NPH = 12;
constexpr int PH_TOTAL = 2 + DEPTH * NPH;

__global__ void __launch_bounds__(NTHREADS, 2) fwd_kernel(Args args) {
    extern __shared__ __attribute__((aligned(16))) unsigned char lds_raw[];
    Frame F;
    F.lds = (LAS unsigned char*)lds_raw;
    F.tid = threadIdx.x; F.lane = F.tid & 63; F.wave = __builtin_amdgcn_readfirstlane(F.tid >> 6);
    F.bid = blockIdx.x; F.nb = gridDim.x;
    F.in = args.in; F.ws = args.ws; F.out = args.out;
    unsigned char* ws = args.ws;
    const int lo = args.ph_lo, hi = args.ph_hi;
    const bool multi = (hi - lo) > 1;
    volatile LAS unsigned* bst = (volatile LAS unsigned*)(F.lds + LDS_BAR_OFF);
    if (F.tid < 4) bst[F.tid] = 0u;
    __syncthreads();
    XcdBarrier bar; bar.bar = (unsigned*)(ws + WS_CTL); bar.x = 0; bar.st = bst;
    if (multi) bar = xcd_barrier_post((unsigned*)(ws + WS_CTL), bst);
#define IN(k) (lo <= (k) && (k) < hi)
#define FRESH() do { asm volatile("v_mbcnt_lo_u32_b32 %0, -1, 0\n\tv_mbcnt_hi_u32_b32 %0, -1, %0" : "=v"(F.lane)); asm volatile("" : "+s"(F.wave), "+s"(F.bid), "+s"(F.nb)); \
    F.tid = F.wave * 64 + F.lane; asm volatile("" : "+s"(F.ws), "+s"(F.out)); ws = F.ws; } while (0)
#define SEAM(k) do { if (IN(k) && IN((k) + 1)) { asm volatile("" : "+s"(bar.x)); xcd_barrier(bar); } } while (0)

    if (IN(0)) { FRESH(); p0_prologue(F); }
    SEAM(0);

    for (int l = 0; l < DEPTH; ++l) {
        const int pb = 1 + l * NPH;
        if (IN(pb + 0)) REP(0) { FRESH(); norm_phase(F, l, 0, (const float*)(ws + WS_P2), l > 0 ? 32 : 0); }
        SEAM(pb + 0);
        if (IN(pb + 1)) REP(1) { FRESH();
            pg8::Gemm g{(const bf16_t*)(ws + WS_H), (const bf16_t*)(ws + WS_WIN) + (size_t)l * IN_COLS * D, MROWS, IN_COLS, D, D, D};
            pg8::StaticOrder S; S.init(MROWS, IN_COLS, F.nb, F.bid);
            pg8::EpiBf16<0> E{(bf16_t*)(ws + WS_U), IN_COLS};
            pg8::gemm_phase(F.lds, g, S, E, F.tid);
        }
        SEAM(pb + 1);
        if (IN(pb + 2)) REP(2) { FRESH(); prep1_phase(F, l); }
        SEAM(pb + 2);
        if (IN(pb + 3)) REP(3) { FRESH();
            {
                pg8::Gemm g{(const bf16_t*)(ws + WS_LA), (const bf16_t*)(ws + WS_WLORA) + (size_t)l * 5120 * 256, 5 * MROWS, 5120, 256, 256, 256};
                pg8::LoraOrder S; S.init(F.nb, F.bid);
                pg8::EpiLora E{(float*)(ws + WS_WD), (const float*)(ws + WS_LBIAS) + (size_t)l * 5 * AW};
                pg8::gemm_phase(F.lds, g, S, E, F.tid);
            }
            FRESH();
            {
                pg8::Gemm g{(const bf16_t*)(ws + WS_QL), (const bf16_t*)(ws + WS_WUQ) + (size_t)l * 1536 * 512, MROWS, 1536, 512, 512, 512};
                pg8::StaticOrder S; S.init(MROWS, 1536, F.nb, F.bid);
                pg8::EpiBf16<0> E{(bf16_t*)(ws + WS_Q), 1536};
                pg8::gemm_phase(F.lds, g, S, E, F.tid);
            }
            FRESH();
            {
                pg8::Gemm g{(const bf16_t*)(ws + WS_KVL), (const bf16_t*)(ws + WS_WUKV) + (size_t)l * 2048 * 256, MROWS, 2048, 256, 256, 256};
                pg8::StaticOrder S; S.init(MROWS, 2048, F.nb, F.bid);
                pg8::EpiKV E{(bf16_t*)(ws + WS_KC), (bf16_t*)(ws + WS_VC)};
                pg8::gemm_phase(F.lds, g, S, E, F.tid);
            }
        }
        SEAM(pb + 3);
        if (IN(pb + 4)) REP(4) { FRESH(); rwkvA_phase(F, l); }
        SEAM(pb + 4);
        if (IN(pb + 5)) REP(5) { FRESH(); if (!(args.flags & 1)) rwkvB_phase(F); FRESH(); attn_phase(F, l, args.flags); }
        SEAM(pb + 5);
        if (IN(pb + 6)) REP(6) { FRESH(); rwkvC_readout_phase(F, l); }
        SEAM(pb + 6);
        if (IN(pb + 7)) REP(7) { FRESH();
            { pg8::Gemm g{(const bf16_t*)(ws + WS_YCAT), (const bf16_t*)(ws + WS_WB) + (size_t)l * D * 3072, SEQ, D, 3072, 3072, 3072};
              pg8::StaticOrder S; S.init(SEQ, D, F.nb, F.bid);
              pg8::EpiMerge E{(bf16_t*)(ws + WS_MRGB), (const bf16_t*)(ws + WS_U) + GATE_OFF};
              pg8::gemm_phase<pg8::EpiMerge, pg8::StaticOrder, 16>(F.lds, g, S, E, F.tid); }
            FRESH();
            if (l < DEPTH - 1)
            { pg8::Gemm g{(const bf16_t*)(ws + WS_YCAT) + (size_t)SEQ * 3072, (const bf16_t*)(ws + WS_WB) + (size_t)l * D * 3072, 3 * 256, D, 1024, 3072, 3072, 2048, -1, 2048};
              pg8::StaticOrder S; S.init(3 * 256, D, F.nb, F.nb - 1 - F.bid);
              pg8::EpiPartial<1> E{(float*)(ws + WS_PM), nullptr, (const bf16_t*)(ws + WS_U) + (size_t)SEQ * IN_COLS + GATE_OFF};
              pg8::gemm_phase(F.lds, g, S, E, F.tid); }
        }
        SEAM(pb + 7);
        if (IN(pb + 8)) REP(8) { FRESH();
            const float* mod = (const float*)(ws + WS_MOD) + (size_t)l * 2 * 6 * D;
            bf16_t* MC = (bf16_t*)(ws + WS_CSCR);
            unsigned* cnt = (unsigned*)(ws + WS_CTL) + 8192 + 512 + l * 64;
            if (l < DEPTH - 1) {
                const float* src = (const float*)(ws + WS_PM);
                for (int i = F.bid * NTHREADS + F.tid; i < CTXL * (D / 4); i += F.nb * NTHREADS) {
                    const f32x4 a = *(const f32x4*)(src + (size_t)i * 4), b = *(const f32x4*)(src + (size_t)CTXL * D + (size_t)i * 4), c = *(const f32x4*)(src + (size_t)2 * CTXL * D + (size_t)i * 4);
                    const f32x4 x = (a + b) + c;
                    u32x2 w; w.x = cvt_pk_bf16(x[0], x[1]); w.y = cvt_pk_bf16(x[2], x[3]); *(u32x2*)(MC + (size_t)i * 4) = w; }
                asm volatile("s_waitcnt vmcnt(0)" ::: "memory");
                __syncthreads();
                if (F.tid == 0) { __builtin_amdgcn_fence(__ATOMIC_RELEASE, "agent"); asm volatile("s_waitcnt vmcnt(0)" ::: "memory"); (void)xb_add(cnt, 1u); }
            }
            { pg8::Gemm g{(const bf16_t*)(ws + WS_MRGB), (const bf16_t*)(ws + WS_WO) + (size_t)l * D * D, SEQ, D, D, D, D};
              pg8::StaticOrder S; S.init(SEQ, D, F.nb, F.bid);
              pg8::EpiResid E{(float*)(ws + ((args.flags & 8) ? WS_Y : WS_X)), mod + 2 * D, mod + 6 * D + 2 * D};
              pg8::gemm_phase(F.lds, g, S, E, F.tid); }
            FRESH();
            {
                const int cu = F.nb - 1 - F.bid;
                if (cu < 64 && l < DEPTH - 1) {
                    __syncthreads();
                    if (F.tid == 0) { unsigned* barw = (unsigned*)(ws + WS_CTL); XB_SPIN(xb_ld(cnt) < (unsigned)F.nb, barw); __builtin_amdgcn_fence(__ATOMIC_ACQUIRE, "agent"); asm volatile("s_waitcnt vmcnt(0)" ::: "memory"); }
                    __syncthreads();
                    pg8::StaticOrder S; S.init(8 * 256, D, F.nb, cu);
                    pg8::Gemm g{MC, (const bf16_t*)(ws + WS_WO) + (size_t)l * D * D, 8 * 256, D, 256, D, D, 512, -1, 512};
                    pg8::EpiPartial<0> E{(float*)(ws + WS_PO), mod + 6 * D + 2 * D, nullptr};
                    pg8::gemm_phase(F.lds, g, S, E, F.tid);
                }
            }
        }
        SEAM(pb + 8);
        if (IN(pb + 9)) REP(9) { FRESH(); norm_phase(F, l, 1, (const float*)(ws + WS_PO), l < DEPTH - 1 ? 8 : 0); }
        SEAM(pb + 9);
        if (IN(pb + 10)) REP(10) { FRESH();
            const int mrows = (l < DEPTH - 1) ? MROWS : SEQ;
            pg8::Gemm g{(const bf16_t*)(ws + WS_H), (const bf16_t*)(ws + WS_W1) + (size_t)l * DFF * D, mrows, DFF, D, D, D};
            pg8::StaticOrder S; S.init(mrows, DFF, F.nb, F.bid);
            pg8::EpiBf16<1> E{(bf16_t*)(ws + WS_U), DFF};
            pg8::gemm_phase(F.lds, g, S, E, F.tid);
        }
        SEAM(pb + 10);
        if (IN(pb + 11)) REP(11) { FRESH();
            const float* mod = (const float*)(ws + WS_MOD) + (size_t)l * 2 * 6 * D;
            { pg8::Gemm g{(const bf16_t*)(ws + WS_U), (const bf16_t*)(ws + WS_W2) + (size_t)l * D * DFF, SEQ, D, DFF, DFF, DFF};
              pg8::StaticOrder S; S.init(SEQ, D, F.nb, F.bid);
              pg8::EpiResid E{(float*)(ws + ((args.flags & 8) ? WS_Y : WS_X)), mod + 5 * D, mod + 6 * D + 5 * D};
              pg8::gemm_phase(F.lds, g, S, E, F.tid); }
            FRESH();
            if (l < DEPTH - 1)
            { pg8::Gemm g{(const bf16_t*)(ws + WS_U) + (size_t)SEQ * DFF, (const bf16_t*)(ws + WS_W2) + (size_t)l * D * DFF, 32 * 256, D, 256, DFF, DFF, 512, -1, 512};
              pg8::StaticOrder S; S.init(32 * 256, D, F.nb, F.nb - 1 - F.bid);
              pg8::EpiPartial<0> E{(float*)(ws + WS_P2), mod + 6 * D + 5 * D, nullptr};
              pg8::gemm_phase(F.lds, g, S, E, F.tid); }
        }
        SEAM(pb + 11);
    }
    if (IN(PH_TOTAL - 1)) { FRESH(); final_norm_phase(F); }
#undef IN
#undef SEAM
}

#ifndef HOST_PROBE_FLAGS
#define HOST_PROBE_FLAGS 0
#endif
#ifndef HOST_PROBE_PHASE
#define HOST_PROBE_PHASE -1
#endif
#ifndef N_LAUNCH_MODE
#define N_LAUNCH_MODE 1
#endif
extern "C" void kernel_launch(void* const* d_in, const int* in_sizes, int n_in, void* d_out, int out_size, void* d_ws, size_t ws_size, hipStream_t stream) {
    static int grid = 0;
    if (grid == 0) {
        if (n_in != 30 || out_size != SEQ * D || ws_size < WS_END) { fprintf(stderr, "kernel_launch: unexpected shapes (n_in %d out %d ws %zu need %zu)\n", n_in, out_size, ws_size, (size_t)WS_END); grid = -1; return; }
        int dev = 0, cus = 0, per_cu = 0;
        if (hipGetDevice(&dev) != hipSuccess || hipDeviceGetAttribute(&cus, hipDeviceAttributeMultiprocessorCount, dev) != hipSuccess) { grid = -1; return; }
        if (hipFuncSetAttribute((const void*)fwd_kernel, hipFuncAttributeMaxDynamicSharedMemorySize, LDS_BYTES) != hipSuccess) { fprintf(stderr, "kernel_launch: hipFuncSetAttribute failed\n"); grid = -1; return; }
        if (hipOccupancyMaxActiveBlocksPerMultiprocessor(&per_cu, (const void*)fwd_kernel, NTHREADS, LDS_BYTES) != hipSuccess || per_cu < 1) { fprintf(stderr, "kernel_launch: occupancy query says %d\n", per_cu); (void)hipGetLastError(); grid = -1; return; }
        grid = cus;
    }
    if (grid < 0) return;
    (void)hipMemsetAsync((char*)d_ws + WS_CTL, 0, CTL_BYTES, stream);
    Args a{};
    for (int i = 0; i < 30; ++i) a.in[i] = (const float*)d_in[i];
    a.out = (float*)d_out; a.ws = (unsigned char*)d_ws;
#if N_LAUNCH_MODE == 1
    a.ph_lo = 0; a.ph_hi = PH_TOTAL;
    hipLaunchKernelGGL(fwd_kernel, dim3(grid), dim3(NTHREADS), LDS_BYTES, stream, a);
#else
    for (int p = 0; p < PH_TOTAL; ++p) { a.ph_lo = p; a.ph_hi = p + 1;
        const int reps = ((p >= 1 && p < PH_TOTAL - 1 && ((p - 1) % NPH) == HOST_PROBE_PHASE) || (p == 0 && HOST_PROBE_PHASE == 100)) ? 2 : 1;
        for (int r = 0; r < reps; ++r) { a.flags = (r == 1) ? HOST_PROBE_FLAGS : 0; hipLaunchKernelGGL(fwd_kernel, dim3(grid), dim3(NTHREADS), LDS_BYTES, stream, a); } }
#endif
}
```
